# Optimizing an MI355X kernel written in HIP

```python
import jax, jax.numpy as jnp
from jax import lax
import numpy as np

D_MODEL = 1024
BATCH = 16
SEQ = 4096
DEPTH = 1

D_MIX = D_MODEL
ROPE_THETA = 500000.0
EPS = 1e-6
NEG = -1e30
FORCE = 1e4
MLA_HEADS = 8
MLA_Q_LORA = 256
MLA_KV_LORA = 128
MLA_NOPE = 64
MLA_ROPE = 32
MLA_V = 64
MLA_QK = MLA_NOPE + MLA_ROPE
MLA_WIDTH = MLA_HEADS * MLA_V
MLA_QBLOCK = 128
NSA_HEADS = 8
NSA_GROUPS = 2
NSA_REP = NSA_HEADS // NSA_GROUPS
NSA_DK = 64
NSA_DV = 64
NSA_WIDTH = NSA_HEADS * NSA_DV
NSA_ROT = NSA_DK // 4
CMP_LEN = 32
CMP_STRIDE = 16
CMP_HIDDEN = 128
SEL_LEN = 64
N_SEL = 16
WIN = 512
NSA_QBLOCK = 32
MEM_TOKENS = 256
XA_HEADS = 4
XA_DH = 128
PEER_HEADS = 8
PEER_KEYS = 128
PEER_EXPERTS = PEER_KEYS * PEER_KEYS
PEER_QDIM = 128
PEER_HALF = PEER_QDIM // 2
PEER_TOPK = 16
PEER_CHUNK = 128

IN_SIZES = (MLA_Q_LORA, MLA_KV_LORA, MLA_ROPE,
            NSA_HEADS * NSA_DK,
            NSA_GROUPS * NSA_DK, NSA_GROUPS * NSA_DV,
            NSA_GROUPS * NSA_DK, NSA_GROUPS * NSA_DV,
            NSA_GROUPS * NSA_DK, NSA_GROUPS * NSA_DV,
            NSA_HEADS * 3)
IN_COLS = sum(IN_SIZES)

kernel_name = "hybrid_mla_nsa_memxattn_peer"


def rms_norm(x, g):
    xf = x.astype(jnp.float32)
    y = xf * lax.rsqrt(jnp.mean(xf * xf, axis=-1, keepdims=True) + EPS)
    return (y * g.astype(jnp.float32)).astype(x.dtype)


def rope_tables(pos, rot_dim):
    inv = 1.0 / (ROPE_THETA ** (jnp.arange(0, rot_dim, 2, dtype=jnp.float32) / rot_dim))
    ang = pos.astype(jnp.float32)[:, None] * inv[None, :]
    return jnp.cos(ang), jnp.sin(ang)


def rotate(x, cos, sin):
    x1, x2 = jnp.split(x.astype(jnp.float32), 2, axis=-1)
    c = cos[None, :, None, :]
    s = sin[None, :, None, :]
    return jnp.concatenate([x1 * c - x2 * s, x2 * c + x1 * s], axis=-1).astype(x.dtype)


def partial_rope(x, cos, sin):
    r = 2 * cos.shape[-1]
    return jnp.concatenate([rotate(x[..., :r], cos, sin), x[..., r:]], axis=-1)


def masked_softmax(s, mask):
    p = jax.nn.softmax(jnp.where(mask, s.astype(jnp.float32), NEG), axis=-1)
    return p * mask


def mla_mixer(c_q, c_kv, k_pe, q_norm, kv_norm, w_uq, w_ukv, qk_norm):
    B, S, _ = c_q.shape
    cos, sin = rope_tables(jnp.arange(S), MLA_ROPE)
    q = (rms_norm(c_q, q_norm) @ w_uq).reshape(B, S, MLA_HEADS, MLA_QK)
    kv = (rms_norm(c_kv, kv_norm) @ w_ukv).reshape(B, S, MLA_HEADS, MLA_NOPE + MLA_V)
    k_nope, v = kv[..., :MLA_NOPE], kv[..., MLA_NOPE:]
    k = jnp.concatenate([k_nope, jnp.broadcast_to(k_pe[:, :, None, :], (B, S, MLA_HEADS, MLA_ROPE))], axis=-1)
    q = rms_norm(q, qk_norm[0])
    k = rms_norm(k, qk_norm[1])
    q = jnp.concatenate([q[..., :MLA_NOPE], rotate(q[..., MLA_NOPE:], cos, sin)], axis=-1)
    k = jnp.concatenate([k[..., :MLA_NOPE], rotate(k[..., MLA_NOPE:], cos, sin)], axis=-1)
    scale = MLA_QK ** -0.5
    kpos = jnp.arange(S)

    def block(i):
        s0 = i * MLA_QBLOCK
        qb = lax.dynamic_slice_in_dim(q, s0, MLA_QBLOCK, axis=1)
        sc = jnp.einsum('bqhd,bkhd->bhqk', qb, k).astype(jnp.float32) * scale
        mask = kpos[None, :] <= (s0 + jnp.arange(MLA_QBLOCK))[:, None]
        p = masked_softmax(sc, mask)
        return jnp.einsum('bhqk,bkhd->bqhd', p.astype(v.dtype), v)

    o = lax.map(block, jnp.arange(S // MLA_QBLOCK))
    return o.transpose(1, 0, 2, 3, 4).reshape(B, S, MLA_WIDTH)


def compress(t, pe, w1, w2):
    B, S, G, d = t.shape
    n_cmp = (S - CMP_LEN) // CMP_STRIDE + 1
    idx = jnp.arange(n_cmp)[:, None] * CMP_STRIDE + jnp.arange(CMP_LEN)[None, :]
    blk = t[:, idx] + pe[None, None, :, None, :]
    blk = blk.transpose(0, 1, 3, 2, 4).reshape(B, n_cmp, G, CMP_LEN * d)
    return jax.nn.gelu(blk @ w1) @ w2


def nsa_mixer(q_in, kc_in, vc_in, ks_in, vs_in, kw_in, vw_in, gate_in, q_norm, k_norm, cmp_pe, cmp_w1, cmp_w2):
    B, S, _ = q_in.shape
    G, R = NSA_GROUPS, NSA_REP
    n_cmp = (S - CMP_LEN) // CMP_STRIDE + 1
    n_blk = S // SEL_LEN
    n_sel = min(N_SEL, n_blk)
    cos, sin = rope_tables(jnp.arange(S), NSA_ROT)
    cmp_end = jnp.arange(n_cmp) * CMP_STRIDE + CMP_LEN - 1
    cos_c, sin_c = rope_tables(cmp_end, NSA_ROT)

    def grp(t, d):
        return t.reshape(B, S, G, d)

    q = partial_rope(rms_norm(q_in.reshape(B, S, NSA_HEADS, NSA_DK), q_norm), cos, sin).reshape(B, S, G, R, NSA_DK)
    kc = compress(grp(kc_in, NSA_DK), cmp_pe[0], cmp_w1[0], cmp_w2[0])
    vc = compress(grp(vc_in, NSA_DV), cmp_pe[1], cmp_w1[1], cmp_w2[1])
    kc = partial_rope(rms_norm(kc, k_norm[0]), cos_c, sin_c)
    ks = partial_rope(rms_norm(grp(ks_in, NSA_DK), k_norm[1]), cos, sin)
    vs = grp(vs_in, NSA_DV)
    kw = partial_rope(rms_norm(grp(kw_in, NSA_DK), k_norm[2]), cos, sin)
    vw = grp(vw_in, NSA_DV)
    gates = jax.nn.sigmoid(gate_in.astype(jnp.float32)).reshape(B, S, G, R, 3).astype(q_in.dtype)

    ks_blk = ks.reshape(B, n_blk, SEL_LEN, G, NSA_DK).transpose(0, 3, 1, 2, 4).reshape(B, G, n_blk, SEL_LEN * NSA_DK)
    vs_blk = vs.reshape(B, n_blk, SEL_LEN, G, NSA_DV).transpose(0, 3, 1, 2, 4).reshape(B, G, n_blk, SEL_LEN * NSA_DV)
    cmp_start = jnp.arange(n_cmp) * CMP_STRIDE
    blk_ids = jnp.arange(n_blk)
    blk_start = blk_ids * SEL_LEN
    overlap = ((cmp_start[:, None] < blk_start[None, :] + SEL_LEN)
               & (cmp_start[:, None] + CMP_LEN > blk_start[None, :])).astype(jnp.float32)
    kw_pad = jnp.pad(kw, ((0, 0), (WIN, 0), (0, 0), (0, 0)))
    vw_pad = jnp.pad(vw, ((0, 0), (WIN, 0), (0, 0), (0, 0)))
    scale = NSA_DK ** -0.5
    QB = NSA_QBLOCK

    def block(i):
        s0 = i * QB
        qpos = s0 + jnp.arange(QB)
        qb = lax.dynamic_slice_in_dim(q, s0, QB, axis=1)
        sc = jnp.einsum('bqgrd,bngd->bgrqn', qb, kc).astype(jnp.float32) * scale
        p_c = masked_softmax(sc, cmp_end[None, :] <= qpos[:, None])
        o_c = jnp.einsum('bgrqn,bngd->bqgrd', p_c.astype(vc.dtype), vc)
        imp = jnp.einsum('bgrqn,nm->bgqm', p_c, overlap)
        cur = qpos // SEL_LEN
        forced = (blk_ids[None, :] == 0) | (blk_ids[None, :] == cur[:, None]) | (blk_ids[None, :] == cur[:, None] - 1)
        score = jnp.where(blk_ids[None, :] <= cur[:, None], jnp.where(forced, FORCE, imp), NEG)
        top_val, top_idx = lax.top_k(score, n_sel)
        flat = top_idx.reshape(B, G, QB * n_sel, 1)
        ks_g = jnp.take_along_axis(ks_blk, flat, axis=2).reshape(B, G, QB, n_sel * SEL_LEN, NSA_DK)
        vs_g = jnp.take_along_axis(vs_blk, flat, axis=2).reshape(B, G, QB, n_sel * SEL_LEN, NSA_DV)
        tok = (top_idx[..., None] * SEL_LEN + jnp.arange(SEL_LEN)).reshape(B, G, QB, n_sel * SEL_LEN)
        ok = jnp.repeat(top_val > 0.5 * NEG, SEL_LEN, axis=-1)
        smask = ok & (tok <= qpos[None, None, :, None])
        ss = jnp.einsum('bqgrd,bgqkd->bgrqk', qb, ks_g).astype(jnp.float32) * scale
        p_s = masked_softmax(ss, smask[:, :, None])
        o_s = jnp.einsum('bgrqk,bgqkd->bqgrd', p_s.astype(vs_g.dtype), vs_g)
        kwb = lax.dynamic_slice_in_dim(kw_pad, s0, WIN + QB, axis=1)
        vwb = lax.dynamic_slice_in_dim(vw_pad, s0, WIN + QB, axis=1)
        kpos = s0 - WIN + jnp.arange(WIN + QB)
        dist = qpos[:, None] - kpos[None, :]
        wmask = (kpos[None, :] >= 0) & (dist >= 0) & (dist < WIN)
        sw = jnp.einsum('bqgrd,bkgd->bgrqk', qb, kwb).astype(jnp.float32) * scale
        p_w = masked_softmax(sw, wmask)
        o_w = jnp.einsum('bgrqk,bkgd->bqgrd', p_w.astype(vwb.dtype), vwb)
        gb = lax.dynamic_slice_in_dim(gates, s0, QB, axis=1)
        return gb[..., 0:1] * o_c + gb[..., 1:2] * o_s + gb[..., 2:3] * o_w

    o = lax.map(block, jnp.arange(S // QB))
    return o.transpose(1, 0, 2, 3, 4, 5).reshape(B, S, NSA_WIDTH)


def memory_cross_attention(hn, mn, wq, wkv, qk_norm, wo):
    B, S, _ = hn.shape
    M = mn.shape[1]
    q = rms_norm((hn @ wq).reshape(B, S, XA_HEADS, XA_DH), qk_norm[0])
    kv = (mn @ wkv).reshape(B, M, 2, XA_HEADS, XA_DH)
    k = rms_norm(kv[:, :, 0], qk_norm[1])
    v = kv[:, :, 1]
    s = jnp.einsum('bqhd,bkhd->bhqk', q, k).astype(jnp.float32) * (XA_DH ** -0.5)
    p = jax.nn.softmax(s, axis=-1)
    o = jnp.einsum('bhqk,bkhd->bqhd', p.astype(v.dtype), v).reshape(B, S, XA_HEADS * XA_DH)
    return o @ wo


def peer_ffn(hn, wq, sub_keys, u, v):
    B, S, D = hn.shape
    xt = hn.reshape(-1, PEER_CHUNK, D)

    def chunk(xc):
        q = (xc @ wq).reshape(PEER_CHUNK, PEER_HEADS, 2, PEER_HALF)
        s = jnp.einsum('thpd,hpkd->thpk', q, sub_keys).astype(jnp.float32)
        s1, i1 = lax.top_k(s[:, :, 0], PEER_TOPK)
        s2, i2 = lax.top_k(s[:, :, 1], PEER_TOPK)
        cand = (s1[..., :, None] + s2[..., None, :]).reshape(PEER_CHUNK, PEER_HEADS, PEER_TOPK * PEER_TOPK)
        cidx = (i1[..., :, None] * PEER_KEYS + i2[..., None, :]).reshape(PEER_CHUNK, PEER_HEADS, PEER_TOPK * PEER_TOPK)
        top, pos = lax.top_k(cand, PEER_TOPK)
        eidx = jnp.take_along_axis(cidx, pos, axis=-1)
        g = jax.nn.softmax(top, axis=-1)
        u_e = jnp.take(u, eidx, axis=0)
        act = jax.nn.gelu(jnp.einsum('thkd,td->thk', u_e, xc).astype(jnp.float32))
        v_e = jnp.take(v, eidx, axis=0)
        return jnp.einsum('thk,thkd->td', (g * act).astype(v.dtype), v_e)

    return lax.map(chunk, xt).reshape(B, S, D)


def setup_inputs(seed: int = 0) -> dict:
    key = jax.random.key(seed)
    ks = jax.random.split(key, 32)
    f32 = jnp.float32
    L = DEPTH

    def nrm(k, shape, scale):
        return jax.random.normal(k, shape, f32) * scale

    def gain(k, shape):
        return 1.0 + 0.02 * jax.random.normal(k, shape, f32)

    return {
        "x": nrm(ks[0], (BATCH, SEQ, D_MODEL), 1.0),
        "mem": nrm(ks[1], (BATCH, MEM_TOKENS, D_MODEL), 1.0),
        "mix_norm": gain(ks[2], (L, D_MODEL)),
        "w_in": nrm(ks[3], (L, D_MODEL, IN_COLS), D_MODEL ** -0.5),
        "mla_q_norm": gain(ks[4], (L, MLA_Q_LORA)),
        "mla_kv_norm": gain(ks[5], (L, MLA_KV_LORA)),
        "mla_w_uq": nrm(ks[6], (L, MLA_Q_LORA, MLA_HEADS * MLA_QK), MLA_Q_LORA ** -0.5),
        "mla_w_ukv": nrm(ks[7], (L, MLA_KV_LORA, MLA_HEADS * (MLA_NOPE + MLA_V)), MLA_KV_LORA ** -0.5),
        "mla_qk_norm": gain(ks[8], (L, 2, MLA_QK)),
        "nsa_q_norm": gain(ks[9], (L, NSA_DK)),
        "nsa_k_norm": gain(ks[10], (L, 3, NSA_DK)),
        "nsa_cmp_pe": nrm(ks[11], (L, 2, CMP_LEN, NSA_DK), 0.1),
        "nsa_cmp_w1": nrm(ks[12], (L, 2, CMP_LEN * NSA_DK, CMP_HIDDEN), (CMP_LEN * NSA_DK) ** -0.5),
        "nsa_cmp_w2": nrm(ks[13], (L, 2, CMP_HIDDEN, NSA_DK), CMP_HIDDEN ** -0.5),
        "mix_out_norm": gain(ks[14], (L, D_MIX)),
        "w_out": nrm(ks[15], (L, D_MIX, D_MODEL), D_MIX ** -0.5),
        "xa_norm": gain(ks[16], (L, D_MODEL)),
        "mem_norm": gain(ks[17], (L, D_MODEL)),
        "xa_wq": nrm(ks[18], (L, D_MODEL, XA_HEADS * XA_DH), D_MODEL ** -0.5),
        "xa_wkv": nrm(ks[19], (L, D_MODEL, 2 * XA_HEADS * XA_DH), D_MODEL ** -0.5),
        "xa_qk_norm": gain(ks[20], (L, 2, XA_DH)),
        "xa_wo": nrm(ks[21], (L, XA_HEADS * XA_DH, D_MODEL), (XA_HEADS * XA_DH) ** -0.5),
        "ffn_norm": gain(ks[22], (L, D_MODEL)),
        "peer_wq": nrm(ks[23], (L, D_MODEL, PEER_HEADS * PEER_QDIM), D_MODEL ** -0.5),
        "peer_keys": nrm(ks[24], (L, PEER_HEADS, 2, PEER_KEYS, PEER_HALF), PEER_HALF ** -0.5),
        "peer_u": nrm(ks[25], (L, PEER_EXPERTS, D_MODEL), D_MODEL ** -0.5),
        "peer_v": nrm(ks[26], (L, PEER_EXPERTS, D_MODEL), PEER_HEADS ** -0.5),
    }


def reference(x, mem, mix_norm, w_in, mla_q_norm, mla_kv_norm, mla_w_uq, mla_w_ukv, mla_qk_norm,
              nsa_q_norm, nsa_k_norm, nsa_cmp_pe, nsa_cmp_w1, nsa_cmp_w2, mix_out_norm, w_out,
              xa_norm, mem_norm, xa_wq, xa_wkv, xa_qk_norm, xa_wo,
              ffn_norm, peer_wq, peer_keys, peer_u, peer_v):
    offsets = [int(o) for o in np.cumsum(IN_SIZES)[:-1]]
    h = x
    for l in range(DEPTH):
        n = rms_norm(h, mix_norm[l])
        (c_q, c_kv, k_pe, q_nsa, kc_in, vc_in, ks_in, vs_in,
         kw_in, vw_in, gate_in) = jnp.split(n @ w_in[l], offsets, axis=-1)
        o_mla = mla_mixer(c_q, c_kv, k_pe, mla_q_norm[l], mla_kv_norm[l], mla_w_uq[l], mla_w_ukv[l], mla_qk_norm[l])
        o_nsa = nsa_mixer(q_nsa, kc_in, vc_in, ks_in, vs_in, kw_in, vw_in, gate_in,
                          nsa_q_norm[l], nsa_k_norm[l], nsa_cmp_pe[l], nsa_cmp_w1[l], nsa_cmp_w2[l])
        g_out = mix_out_norm[l]
        mixed = jnp.concatenate([rms_norm(o_mla, g_out[:MLA_WIDTH]), rms_norm(o_nsa, g_out[MLA_WIDTH:])], axis=-1)
        h = h + mixed @ w_out[l]
        h = h + memory_cross_attention(rms_norm(h, xa_norm[l]), rms_norm(mem, mem_norm[l]),
                                       xa_wq[l], xa_wkv[l], xa_qk_norm[l], xa_wo[l])
        h = h + peer_ffn(rms_norm(h, ffn_norm[l]), peer_wq[l], peer_keys[l], peer_u[l], peer_v[l])
    return h
```

```cpp
#include <hip/hip_runtime.h>
#include <cstdio>
#include <cstdint>

#ifndef STAGE
#define STAGE 4
#endif
#ifndef ONE_LAUNCH
#define ONE_LAUNCH 1
#endif
#ifndef PROBE_MASK
#define PROBE_MASK 0
#endif

typedef unsigned short bf16_t;
typedef short bf16x8 __attribute__((ext_vector_type(8)));
typedef float f32x16 __attribute__((ext_vector_type(16)));
typedef float f32x4 __attribute__((ext_vector_type(4)));
typedef float f32x2 __attribute__((ext_vector_type(2)));
typedef unsigned u32x4 __attribute__((ext_vector_type(4)));
typedef unsigned u32x2 __attribute__((ext_vector_type(2)));

#define T_TOK 65536
#define SEQ 4096
#define NBATCH 16
#define DM 1024
#define INC 1720
#define PLD 1728
#define INP 1792
#define C_CQ 1280
#define C_CKV 1536
#define C_KPE 1664
#define C_QN 416
#define C_KC 928
#define C_VC 1056
#define C_KS 1184
#define C_VS 1024
#define C_KW 1440
#define C_VW 1152
#define C_GATE 1696
#define EPSN 1e-6f
#define LOG2E 1.4426950408889634f

#define MIB (1024ull * 1024ull)
constexpr size_t WS_R1   = 0;
constexpr size_t WS_R2   = WS_R1 + 128 * MIB;
constexpr size_t WS_R3   = WS_R2 + 216 * MIB;
constexpr size_t WS_R4   = WS_R3 + 96 * MIB;
constexpr size_t WS_R5   = WS_R4 + 128 * MIB;
constexpr size_t WS_R6   = WS_R5 + 96 * MIB;
constexpr size_t WS_R7   = WS_R6 + 64 * MIB;
constexpr size_t WS_KS   = WS_R7 + 64 * MIB;
constexpr size_t WS_KW   = WS_KS + 16 * MIB;
constexpr size_t WS_VST  = WS_KW + 16 * MIB;
constexpr size_t WS_VWT  = WS_VST + 16 * MIB;
constexpr size_t WS_KCIN = WS_VWT + 16 * MIB;
constexpr size_t WS_VCIN = WS_KCIN + 16 * MIB;
constexpr size_t WS_PAD0 = WS_VCIN + 16 * MIB;
constexpr size_t WS_HID  = WS_PAD0 + 65536;
constexpr size_t WS_CRAW = WS_HID + 4 * MIB;
constexpr size_t WS_KC   = WS_CRAW + 4 * MIB;
constexpr size_t WS_VCT  = WS_KC + 1 * MIB;
constexpr size_t WS_GATE = WS_VCT + 1 * MIB;
constexpr size_t WS_RSTD0 = WS_GATE + 6 * MIB;
constexpr size_t WS_RSTDCQ = WS_RSTD0 + 262144;
constexpr size_t WS_RSTDCKV = WS_RSTDCQ + 262144;
constexpr size_t WS_RSTD2 = WS_RSTDCKV + 262144;
constexpr size_t WS_RSTDMEM = WS_RSTD2 + 262144;
constexpr size_t WS_UB   = WS_RSTDMEM + 16384;
constexpr size_t WS_VB   = WS_UB + 16 * MIB;
constexpr size_t WS_PARTC = WS_UB + 32 * MIB;
constexpr size_t WS_WIN  = WS_UB + 64 * MIB;
constexpr size_t WS_WUQ  = WS_WIN + 1792 * 1024 * 2;
constexpr size_t WS_WUKV = WS_WUQ + 768 * 256 * 2;
constexpr size_t WS_W1C  = WS_WUKV + 1024 * 128 * 2;
constexpr size_t WS_W2C  = WS_W1C + 2 * 128 * 2048 * 2;
constexpr size_t WS_WOUT = WS_W2C + 2 * 128 * 128 * 2;
constexpr size_t WS_WXQ  = WS_WOUT + 2 * MIB;
constexpr size_t WS_WXKV = WS_WXQ + 1 * MIB;
constexpr size_t WS_WXO  = WS_WXKV + 2 * MIB;
constexpr size_t WS_WPQ  = WS_WXO + 1 * MIB;
constexpr size_t WS_KP   = WS_WPQ + 2 * MIB;
constexpr size_t WS_MEMB = WS_KP + 262144;
constexpr size_t WS_KVX  = WS_MEMB + 8 * MIB;
constexpr size_t WS_KX   = WS_KVX + 8 * MIB;
constexpr size_t WS_VXT  = WS_KX + 4 * MIB;
constexpr size_t WS_ROPEM = WS_VXT + 4 * MIB;
constexpr size_t WS_ROPEN = WS_ROPEM + 524288;
constexpr size_t WS_BIASP = WS_ROPEN + 262144;
constexpr size_t WS_BIAS1 = WS_BIASP + 32768;
constexpr size_t WS_BAR  = WS_BIAS1 + 1024;
constexpr size_t WS_END  = WS_BAR + 16384;
constexpr size_t WS_XB = WS_R1, WS_H1B = WS_R1;
constexpr size_t WS_P = WS_R2, WS_OMIX = WS_R2, WS_QP = WS_R2, WS_QX = WS_R2 + 128 * MIB;
constexpr size_t WS_QMRAW = WS_R3, WS_OX = WS_R3;
constexpr size_t WS_KVRAW = WS_R4, WS_H2B = WS_R4;
constexpr size_t WS_KM = WS_R5, WS_EIDX = WS_R5, WS_EG = WS_R5 + 32 * MIB;
constexpr size_t WS_VMT = WS_R6, WS_QN = WS_R7;
constexpr size_t WS_SSQ = WS_CRAW;
constexpr size_t WS_USCALE = WS_RSTDCQ;
constexpr size_t WS_H2Q = WS_R6;
constexpr size_t WS_H2SSQ = WS_GATE;
constexpr size_t WS_H1SSQ = WS_HID;
constexpr size_t WS_CSSQ = WS_R6;
constexpr size_t WS_PART = WS_R2;

#define NT 512
#define NWV 8
#define LDS_BYTES 151552

__device__ __forceinline__ unsigned f2bf(float f) { unsigned u = __float_as_uint(f); u += 0x7FFFu + ((u >> 16) & 1u); return u >> 16; }
typedef __bf16 bf2n_t __attribute__((ext_vector_type(2)));
__device__ __forceinline__ unsigned pack2(float lo, float hi) { bf2n_t v; v[0] = (__bf16)lo; v[1] = (__bf16)hi; return __builtin_bit_cast(unsigned, v); }
__device__ __forceinline__ float bflo(unsigned w) { return __uint_as_float(w << 16); }
__device__ __forceinline__ float bfhi(unsigned w) { return __uint_as_float(w & 0xFFFF0000u); }
__device__ __forceinline__ float bf2f(bf16_t b) { return __uint_as_float(((unsigned)b) << 16); }
__device__ __forceinline__ void unpack8(const u32x4& r, float (&v)[8]) {
    v[0] = bflo(r.x); v[1] = bfhi(r.x); v[2] = bflo(r.y); v[3] = bfhi(r.y);
    v[4] = bflo(r.z); v[5] = bfhi(r.z); v[6] = bflo(r.w); v[7] = bfhi(r.w);
}
__device__ __forceinline__ u32x4 pack8(const float (&v)[8]) {
    u32x4 r; r.x = pack2(v[0], v[1]); r.y = pack2(v[2], v[3]); r.z = pack2(v[4], v[5]); r.w = pack2(v[6], v[7]); return r;
}
__device__ __forceinline__ int kap(int p) { return (p & ~0xC) | ((p & 4) << 1) | ((p & 8) >> 1); }
__device__ __forceinline__ float wave_sum(float v) {
    v += __shfl_xor(v, 32); v += __shfl_xor(v, 16); v += __shfl_xor(v, 8); v += __shfl_xor(v, 4); v += __shfl_xor(v, 2); v += __shfl_xor(v, 1); return v;
}
__device__ __forceinline__ float gelu_tanh(float x) {
    const float u = 0.7978845608028654f * (x + 0.044715f * x * x * x);
    const float e = __expf(2.0f * u);
    const float t = 1.0f - 2.0f / (e + 1.0f);
    return 0.5f * x * (1.0f + t);
}
__device__ __forceinline__ bf16x8 as_bf16x8(const u32x4& r) { union { u32x4 u; bf16x8 b; } c; c.u = r; return c.b; }
#define DPP_ROR_ADD(v, n) ((v) + __builtin_bit_cast(float, __builtin_amdgcn_update_dpp(0, __builtin_bit_cast(int, (v)), 0x120 + (n), 0xf, 0xf, false)))
#define MFMA32(a, b, c) __builtin_amdgcn_mfma_f32_32x32x16_bf16((a), (b), (c), 0, 0, 0)

struct Args {
    const float* in[27];
    float* out;
    unsigned char* ws;
    int ph_lo, ph_hi;
};

#define XB_TMO      128
#define XB_XCNT(j)  (256  + 64 * (j))
#define XB_XSUB(j)  (1280 + 64 * (j))
#define XB_XGEN(j)  (2304 + 64 * (j))
#define XB_TOP      3328
#define XB_TOPGEN   3392
#define XCD_BAR_WORDS 3456
#define XB_SPIN_CAP (1u << 22)
#define LAS __attribute__((address_space(3)))
__device__ __forceinline__ unsigned xb_ld(unsigned* p)              { return __hip_atomic_load(p, __ATOMIC_RELAXED, __HIP_MEMORY_SCOPE_AGENT); }
__device__ __forceinline__ unsigned xb_add(unsigned* p, unsigned v) { return __hip_atomic_fetch_add(p, v, __ATOMIC_RELAXED, __HIP_MEMORY_SCOPE_AGENT); }
__device__ __forceinline__ unsigned xb_xcc_id() { return (unsigned)__builtin_amdgcn_s_getreg((3 << 11) | 20) & 0xFu; }
#define XB_SPIN(cond, bar) do { unsigned _sp = 0; while (cond) { __builtin_amdgcn_s_sleep(1); \
    if ((++_sp & 255u) == 0u) { if (xb_ld(&(bar)[XB_TMO])) break; if (_sp > XB_SPIN_CAP) { atomicAdd(&(bar)[XB_TMO], 1u); break; } } } } while (0)
struct XcdBarrier { unsigned* bar; unsigned x; volatile unsigned* st; };
__device__ __forceinline__ XcdBarrier xcd_barrier_post(unsigned* bar, volatile unsigned* st) {
    XcdBarrier b; b.bar = bar; b.x = xb_xcc_id(); b.st = st;
    if (threadIdx.x == 0) (void)xb_add(&bar[XB_XCNT(b.x)], 1u);
    return b;
}
__device__ __forceinline__ void xcd_barrier_complete(unsigned* bar, unsigned x, unsigned& nloc, unsigned& nx) {
    const unsigned G = gridDim.x;
    unsigned sum, cnt, mine, sp = 0u;
    for (;;) {
        sum = 0u; cnt = 0u; mine = 0u;
#pragma unroll
        for (unsigned j = 0; j < 16; ++j) { const unsigned c = xb_ld(&bar[XB_XCNT(j)]); sum += c; cnt += (c > 0u) ? 1u : 0u; mine = (j == x) ? c : mine; }
        if (sum == G) break;
        __builtin_amdgcn_s_sleep(1);
        if ((++sp & 255u) == 0u) { if (xb_ld(&bar[XB_TMO])) break; if (sp > XB_SPIN_CAP) { atomicAdd(&bar[XB_TMO], 1u); break; } }
    }
    nloc = mine > 0u ? mine : 1u; nx = cnt > 0u ? cnt : 1u;
}
__device__ __forceinline__ void xcd_barrier(const XcdBarrier& b) {
    asm volatile("s_waitcnt vmcnt(0)" ::: "memory");
    __syncthreads();
    if (threadIdx.x == 0) {
        unsigned* bar = b.bar;
        __builtin_amdgcn_s_waitcnt(0);
        unsigned nloc = b.st[0], nx = b.st[1];
        if (nloc == 0u) { xcd_barrier_complete(bar, b.x, nloc, nx); b.st[0] = nloc; b.st[1] = nx; }
        const unsigned old = xb_add(&bar[XB_XSUB(b.x)], 1u);
        const unsigned gen = old / nloc;
        if (old + 1u == (gen + 1u) * nloc) {
            __builtin_amdgcn_fence(__ATOMIC_RELEASE, "agent");
            asm volatile("s_waitcnt vmcnt(0)" ::: "memory");
            const unsigned og = xb_add(&bar[XB_TOP], 1u);
            const unsigned tg = og / nx;
            if (og + 1u == (tg + 1u) * nx) xb_add(&bar[XB_TOPGEN], 1u);
            else XB_SPIN(xb_ld(&bar[XB_TOPGEN]) == tg, bar);
            __builtin_amdgcn_fence(__ATOMIC_ACQUIRE, "agent");
            xb_add(&bar[XB_XGEN(b.x)], 1u);
            asm volatile("s_waitcnt vmcnt(0)" ::: "memory");
        } else {
            XB_SPIN(xb_ld(&bar[XB_XGEN(b.x)]) == gen, bar);
            __builtin_amdgcn_fence(__ATOMIC_ACQUIRE, "agent");
            asm volatile("s_waitcnt vmcnt(0)" ::: "memory");
        }
    }
    __syncthreads();
}

#define GEMM_XBYTES 36864
#define GEMM_STAGE_BYTES 73728
#define GEMM_MISC_OFF 147456
template <bool ROWSS, class Epi, bool MIXN = false>
__device__ __forceinline__ void gemm_tile(const bf16_t* __restrict__ A, int lda, const bf16_t* __restrict__ Bt, int ldb, int K,
                                          int m0, int n0, Epi& epi, unsigned char* lds, const float* __restrict__ ssq16 = nullptr) {
    int tid_ = threadIdx.x; asm volatile("" : "+v"(tid_));
    const int tid = tid_, lane = tid & 63, w = tid >> 6;
    const int wm = w & 1, wn = w >> 1, l31 = lane & 31, hh = lane >> 5;
    const int lrow = tid >> 3, lc = tid & 7;
    const bf16_t* ag = A + (size_t)(m0 + lrow) * lda + lc * 8;
    const bf16_t* bg = Bt + (size_t)(n0 + lrow) * ldb + lc * 8;
    u32x4 ra[4], rb[4];
    f32x16 acc[2][4];
#pragma unroll
    for (int i = 0; i < 2; ++i)
#pragma unroll
        for (int j = 0; j < 4; ++j)
#pragma unroll
            for (int r = 0; r < 16; ++r) acc[i][j][r] = 0.f;
    float ssq[4] = {0.f, 0.f, 0.f, 0.f};
    const int nk = K >> 6;
#pragma unroll
    for (int i = 0; i < 4; ++i) { ra[i] = *(const u32x4*)(ag + (size_t)i * 64 * lda); rb[i] = *(const u32x4*)(bg + (size_t)i * 64 * ldb); }
    float* rs = (float*)(lds + GEMM_MISC_OFF);
    float* rtab = (float*)(lds + GEMM_MISC_OFF + 1024);
    __syncthreads();
#define GEMM_STORE(stage_) do { \
        unsigned char* sb_ = lds + (stage_) * GEMM_STAGE_BYTES; \
        _Pragma("unroll") for (int i_ = 0; i_ < 4; ++i_) { \
            *(u32x4*)(sb_ + (lrow + 64 * i_) * 144 + lc * 16) = ra[i_]; \
            *(u32x4*)(sb_ + GEMM_XBYTES + (lrow + 64 * i_) * 144 + lc * 16) = rb[i_]; } \
        if (ROWSS) { _Pragma("unroll") for (int i_ = 0; i_ < 4; ++i_) { float v_[8]; unpack8(ra[i_], v_); \
            _Pragma("unroll") for (int e_ = 0; e_ < 8; ++e_) ssq[i_] += v_[e_] * v_[e_]; } } } while (0)
    GEMM_STORE(0);
    if (MIXN && tid < 256) {
        const float* sp = ssq16 + (size_t)(m0 + tid) * 16;
        const f32x4 a0 = *(const f32x4*)sp, a1 = *(const f32x4*)(sp + 4), b0 = *(const f32x4*)(sp + 8), b1 = *(const f32x4*)(sp + 12);
        const float s1 = ((a0[0] + a0[1]) + (a0[2] + a0[3])) + ((a1[0] + a1[1]) + (a1[2] + a1[3]));
        const float s2 = ((b0[0] + b0[1]) + (b0[2] + b0[3])) + ((b1[0] + b1[1]) + (b1[2] + b1[3]));
        const float r1 = rsqrtf(s1 * (1.0f / 512.0f) + EPSN), r2 = rsqrtf(s2 * (1.0f / 512.0f) + EPSN);
        rtab[tid] = r1 / r2; rtab[256 + tid] = r2;
    }
    __syncthreads();
    const int xoff = (wm * 128 + l31) * 144 + hh * 16;
    const int woff = GEMM_XBYTES + (wn * 64 + kap(l31)) * 144 + hh * 16;
#pragma unroll 1
    for (int kt = 0; kt < nk; ++kt) {
        const bool more = kt + 1 < nk;
        if (more) {
#pragma unroll
            for (int i = 0; i < 4; ++i) { ra[i] = *(const u32x4*)(ag + (size_t)i * 64 * lda + (kt + 1) * 64); rb[i] = *(const u32x4*)(bg + (size_t)i * 64 * ldb + (kt + 1) * 64); }
        }
        if (MIXN && kt == (nk >> 1)) {
#pragma unroll
            for (int mt = 0; mt < 4; ++mt) {
                const float f = rtab[wm * 128 + mt * 32 + l31];
#pragma unroll
                for (int nf = 0; nf < 2; ++nf)
#pragma unroll
                    for (int r = 0; r < 16; ++r) acc[nf][mt][r] *= f;
            }
        }
        const unsigned char* st = lds + (kt & 1) * GEMM_STAGE_BYTES;
#pragma unroll
        for (int ks = 0; ks < 4; ++ks) {
            bf16x8 xf[4], wf[2];
#pragma unroll
            for (int mt = 0; mt < 4; ++mt) xf[mt] = as_bf16x8(*(const u32x4*)(st + xoff + mt * 32 * 144 + ks * 32));
#pragma unroll
            for (int nf = 0; nf < 2; ++nf) wf[nf] = as_bf16x8(*(const u32x4*)(st + woff + nf * 32 * 144 + ks * 32));
#pragma unroll
            for (int nf = 0; nf < 2; ++nf)
#pragma unroll
                for (int mt = 0; mt < 4; ++mt) acc[nf][mt] = MFMA32(wf[nf], xf[mt], acc[nf][mt]);
        }
        if (more) GEMM_STORE((kt + 1) & 1);
        __syncthreads();
    }
#undef GEMM_STORE
    if (ROWSS) {
#pragma unroll
        for (int i = 0; i < 4; ++i) { float s = ssq[i]; s += __shfl_xor(s, 1); s += __shfl_xor(s, 2); s += __shfl_xor(s, 4); if (lc == 0) rs[lrow + 64 * i] = s; }
        __syncthreads();
    }
    unsigned char* stg = lds + w * 8704;
    const int rrow = lane >> 4, rch = lane & 15;
#pragma unroll
    for (int mt = 0; mt < 4; ++mt) {
#pragma unroll
        for (int nf = 0; nf < 2; ++nf)
#pragma unroll
            for (int j = 0; j < 2; ++j) {
                float* sp = (float*)(stg + l31 * 272 + (nf * 32 + 16 * j + 8 * hh) * 4);
                *(f32x4*)sp = (f32x4){acc[nf][mt][8 * j + 0], acc[nf][mt][8 * j + 1], acc[nf][mt][8 * j + 2], acc[nf][mt][8 * j + 3]};
                *(f32x4*)(sp + 4) = (f32x4){acc[nf][mt][8 * j + 4], acc[nf][mt][8 * j + 5], acc[nf][mt][8 * j + 6], acc[nf][mt][8 * j + 7]};
            }
#pragma unroll
        for (int i = 0; i < 8; ++i) {
            const int r = 4 * i + rrow;
            const f32x4 v4 = *(const f32x4*)(stg + r * 272 + rch * 16);
            const int rl = wm * 128 + mt * 32 + r;
            float v[4] = {v4[0], v4[1], v4[2], v4[3]};
            epi(m0 + rl, n0 + wn * 64 + rch * 4, v, ROWSS ? rs[rl] : (MIXN ? rtab[256 + rl] : 0.f));
        }
    }
}
template <bool ROWSS, class Epi, bool MIXN = false>
__device__ __forceinline__ void gemm_tiles_xcd(const bf16_t* __restrict__ A, int lda, const bf16_t* __restrict__ Bt, int ldb, int K, int nM, int nN,
                                               Epi& epi, unsigned char* lds, const float* __restrict__ ssq16 = nullptr) {
    const int bid = blockIdx.x, x = bid & 7, stride = gridDim.x >> 3, cnt = (nM >> 3) * nN;
    for (int L = bid >> 3; L < cnt; L += stride) {
        const int m = x + 8 * (L / nN), n = L % nN;
        gemm_tile<ROWSS, Epi, MIXN>(A, lda, Bt, ldb, K, m * 256, n * 256, epi, lds, ssq16);
    }
}

__device__ __forceinline__ u32x2 pack4(const float (&v)[4]) { u32x2 r; r.x = pack2(v[0], v[1]); r.y = pack2(v[2], v[3]); return r; }
struct EpiRowScaleBf16 {
    bf16_t* out; int ld; const float* scale; int ncol;
    __device__ __forceinline__ void operator()(int row, int col, float (&v)[4], float) const {
        if (col >= ncol) return;
        const float s = scale ? scale[row] : 1.0f;
#pragma unroll
        for (int e = 0; e < 4; ++e) v[e] *= s;
        *(u32x2*)(out + (size_t)row * ld + col) = pack4(v);
    }
};
struct EpiBiasGeluBf16 {
    bf16_t* out; int ld; const float* bias;
    __device__ __forceinline__ void operator()(int row, int col, float (&v)[4], float) const {
#pragma unroll
        for (int e = 0; e < 4; ++e) v[e] = gelu_tanh(v[e] + bias[col + e]);
        *(u32x2*)(out + (size_t)row * ld + col) = pack4(v);
    }
};
struct EpiF32 {
    float* out; int ld; int ncol;
    __device__ __forceinline__ void operator()(int row, int col, float (&v)[4], float) const {
        if (col >= ncol) return;
        *(f32x4*)(out + (size_t)row * ld + col) = (f32x4){v[0], v[1], v[2], v[3]};
    }
};
struct EpiResidual {
    const float* res_in; float* res_out; bf16_t* hb;
    __device__ __forceinline__ void operator()(int row, int col, float (&v)[4], float) const {
        const f32x4 a = *(const f32x4*)(res_in + (size_t)row * DM + col);
        v[0] += a[0]; v[1] += a[1]; v[2] += a[2]; v[3] += a[3];
        *(f32x4*)(res_out + (size_t)row * DM + col) = (f32x4){v[0], v[1], v[2], v[3]};
        if (hb) *(u32x2*)(hb + (size_t)row * DM + col) = pack4(v);
    }
};
struct EpiInProj {
    const float* rstd0; bf16_t* P; bf16_t* QN; bf16_t* KS; bf16_t* KW; bf16_t* KCIN; bf16_t* VCIN; float* GATE;
    const f32x2* ropen; const float* qg; const float* kg;
    __device__ __forceinline__ void operator()(int row, int col, float (&v)[4], float) const {
        const float rs = rstd0[row];
#pragma unroll
        for (int e = 0; e < 4; ++e) v[e] *= rs;
        const int seg = col >> 6, c64 = col & 63;
        const int b = row >> 12, s = row & 4095;
        if (seg < 12) {
            float ss = v[0] * v[0] + v[1] * v[1] + v[2] * v[2] + v[3] * v[3];
            ss = DPP_ROR_ADD(ss, 8); ss = DPP_ROR_ADD(ss, 4); ss = DPP_ROR_ADD(ss, 2); ss = DPP_ROR_ADD(ss, 1);
            const float rr = rsqrtf(ss * (1.0f / 64.0f) + EPSN);
            const float* g = seg < 8 ? qg : (seg < 10 ? kg + 64 : kg + 128);
            const f32x4 g4 = *(const f32x4*)(g + c64);
#pragma unroll
            for (int e = 0; e < 4; ++e) v[e] = v[e] * rr * g4[e];
            const bool lowhalf = c64 < 8, rot = c64 < 16;
            const float sc = seg < 8 ? 0.125f * LOG2E : 1.0f;
#pragma unroll
            for (int e = 0; e < 4; ++e) {
                const float o = __builtin_bit_cast(float, __builtin_amdgcn_update_dpp(0, __builtin_bit_cast(int, v[e]), 0x4E, 0xf, 0xf, false));
                const f32x2 c = ropen[(size_t)s * 8 + ((c64 & 7) + e)];
                const float r = lowhalf ? (v[e] * c[0] - o * c[1]) : (v[e] * c[0] + o * c[1]);
                v[e] = (rot ? r : v[e]) * sc;
            }
            bf16_t* dst = seg < 8 ? QN + ((size_t)(b * 8 + seg) * SEQ + s) * 64
                        : seg < 10 ? KS + ((size_t)(b * 2 + (seg - 8)) * SEQ + s) * 64 : KW + ((size_t)(b * 2 + (seg - 10)) * SEQ + s) * 64;
            *(u32x2*)(dst + c64) = pack4(v);
        } else if (seg < 16) {
            bf16_t* dst = seg < 14 ? KCIN + ((size_t)(b * 2 + (seg - 12)) * SEQ + s) * 64 : VCIN + ((size_t)(b * 2 + (seg - 14)) * SEQ + s) * 64;
            *(u32x2*)(dst + c64) = pack4(v);
        } else if (col < 1696) {
            *(u32x2*)(P + (size_t)row * PLD + col) = pack4(v);
        } else if (col < 1720) {
            float* gp = GATE + (size_t)row * 24 + (col - 1696);
#pragma unroll
            for (int e = 0; e < 4; ++e) gp[e] = 1.0f / (1.0f + __expf(-v[e]));
        }
    }
};
struct EpiRssNScaleBf16 {
    bf16_t* out; int ld; float inv_n;
    __device__ __forceinline__ void operator()(int row, int col, float (&v)[4], float rss) const {
        const float s = rsqrtf(rss * inv_n + EPSN);
#pragma unroll
        for (int e = 0; e < 4; ++e) v[e] *= s;
        *(u32x2*)(out + (size_t)row * ld + col) = pack4(v);
    }
};
struct EpiNull {
    __device__ __forceinline__ void operator()(int, int, float (&v)[4], float) const { asm volatile("" :: "v"(v[0]), "v"(v[1]), "v"(v[2]), "v"(v[3])); }
};
struct EpiCmpFin {
    int kv; const f32x2* ropen; const float* gain; bf16_t* KC; bf16_t* VCT;
    __device__ __forceinline__ void operator()(int row, int col, float (&v)[4], float) const {
        if (col >= 64) return;
        const int n = row & 255, bg = row >> 8;
        if (n == 255) { v[0] = 0.f; v[1] = 0.f; v[2] = 0.f; v[3] = 0.f; }
        if (kv == 0) {
            float ss = v[0] * v[0] + v[1] * v[1] + v[2] * v[2] + v[3] * v[3];
            ss = DPP_ROR_ADD(ss, 8); ss = DPP_ROR_ADD(ss, 4); ss = DPP_ROR_ADD(ss, 2); ss = DPP_ROR_ADD(ss, 1);
            const float rr = rsqrtf(ss * (1.0f / 64.0f) + EPSN);
            const f32x4 g4 = *(const f32x4*)(gain + col);
#pragma unroll
            for (int e = 0; e < 4; ++e) v[e] = v[e] * rr * g4[e];
            int pos = 16 * n + 31; if (pos > 4095) pos = 4095;
            const bool lowhalf = col < 8, rot = col < 16;
#pragma unroll
            for (int e = 0; e < 4; ++e) {
                const float o = __builtin_bit_cast(float, __builtin_amdgcn_update_dpp(0, __builtin_bit_cast(int, v[e]), 0x4E, 0xf, 0xf, false));
                const f32x2 c = ropen[(size_t)pos * 8 + ((col & 7) + e)];
                const float r = lowhalf ? (v[e] * c[0] - o * c[1]) : (v[e] * c[0] + o * c[1]);
                v[e] = rot ? r : v[e];
            }
            if (n == 255) { v[0] = 0.f; v[1] = 0.f; v[2] = 0.f; v[3] = 0.f; }
            *(u32x2*)(KC + ((size_t)bg * 256 + n) * 64 + col) = pack4(v);
        } else {
#pragma unroll
            for (int e = 0; e < 4; ++e) VCT[((size_t)bg * 64 + col + e) * 256 + n] = (bf16_t)f2bf(v[e]);
        }
    }
};
template <bool USE_RSS>
struct EpiResBf16T {
    const bf16_t* hb_in; bf16_t* hb_out;
    __device__ __forceinline__ void operator()(int row, int col, float (&v)[4], float rss) const {
        const u32x2 a = *(const u32x2*)(hb_in + (size_t)row * DM + col);
        const float sc = USE_RSS ? rss : 1.0f;
        v[0] = v[0] * sc + bflo(a.x); v[1] = v[1] * sc + bfhi(a.x); v[2] = v[2] * sc + bflo(a.y); v[3] = v[3] * sc + bfhi(a.y);
        *(u32x2*)(hb_out + (size_t)row * DM + col) = pack4(v);
    }
};
#define H2Q_CLIP 8.0f
struct EpiResBf16Q {
    const bf16_t* hb_in; bf16_t* hb_out; unsigned* hq;
    __device__ __forceinline__ void operator()(int row, int col, float (&v)[4], float) const {
        const u32x2 a = *(const u32x2*)(hb_in + (size_t)row * DM + col);
        v[0] += bflo(a.x); v[1] += bfhi(a.x); v[2] += bflo(a.y); v[3] += bfhi(a.y);
        *(u32x2*)(hb_out + (size_t)row * DM + col) = pack4(v);
        unsigned w = 0u;
#pragma unroll
        for (int e = 0; e < 4; ++e) {
            const int qi = (int)rintf(fminf(fmaxf(v[e] * (127.0f / H2Q_CLIP), -127.0f), 127.0f));
            w |= ((unsigned)qi & 0xFFu) << (8 * e);
        }
        hq[((size_t)row * DM + col) >> 2] = w;
    }
};
struct EpiRssScaleBf16 {
    bf16_t* out; int ld; float* rstd_out;
    __device__ __forceinline__ void operator()(int row, int col, float (&v)[4], float rss) const {
        const float s = rsqrtf(rss * (1.0f / 1024.0f) + EPSN);
#pragma unroll
        for (int e = 0; e < 4; ++e) v[e] *= s;
        *(u32x2*)(out + (size_t)row * ld + col) = pack4(v);
        if (rstd_out && col == 0) rstd_out[row] = s;
    }
};

#define G8_HTB 16384
#define G8_MISC_OFF 131072
__device__ __forceinline__ int g8_lds_byte(int r, int c) { const int st = (r >> 4) * 2 + (c >> 5), rr = r & 15, cc = c & 31, ob = rr * 64 + cc * 2; return st * 1024 + (ob ^ (((ob >> 9) & 1) << 5)); }
__device__ __forceinline__ void g8_stage_rc(int b, int& R, int& C) { const int st = b / 1024, sb = b % 1024, swz = sb ^ (((sb >> 9) & 1) << 5); R = (st >> 1) * 16 + swz / 64; C = (st & 1) * 32 + (swz % 64) / 2; }
__device__ __forceinline__ int g8_perm32(int rho) { const int n = rho >> 4, i = rho & 15; return 8 * (i >> 2) + 4 * n + (i & 3); }
typedef float f32x4a __attribute__((ext_vector_type(4)));
template <class Epi, bool MIXN = false>
__device__ __forceinline__ void gemm8(const bf16_t* __restrict__ A, int lda, const bf16_t* __restrict__ Bt, int ldb, int K, int nM, int nN,
                                      const Epi& E, unsigned char* lds_gen, const float* __restrict__ ssq16 = nullptr) {
    LAS unsigned char* lds = (LAS unsigned char*)lds_gen;
    const int tid = threadIdx.x, wid = __builtin_amdgcn_readfirstlane(tid >> 6), lane = tid & 63, wr = wid >> 2, wc = wid & 3, fr = lane & 15, fq = lane >> 4;
    int nt_ = K >> 6; asm volatile("" : "+s"(nt_));
    const int nt = nt_;
    const int bid = blockIdx.x, xg = bid & 7, ustride = gridDim.x >> 3, ucnt = (nM >> 3) * nN;
    int L = bid >> 3;
    if (L >= ucnt) return;
    __syncthreads();
    unsigned voffA[2], voffB[2];
#pragma unroll
    for (int i = 0; i < 2; ++i) { int R, C; g8_stage_rc(tid * 16 + i * 8192, R, C);
        voffA[i] = (unsigned)(R * lda + C) * 2u; voffB[i] = (unsigned)((64 * (R >> 5) + g8_perm32(R & 31)) * ldb + C) * 2u; }
    const size_t kstep = 128;
    const size_t hstepA = (size_t)128 * lda * 2, tstepA = 2 * hstepA;
    const size_t hstepB = (size_t)32 * ldb * 2, tstepB = (size_t)256 * ldb * 2;
    const unsigned ldsw = (unsigned)wid * 1024u;
    const int aoff = g8_lds_byte(wr * 64 + fr, fq * 8), boff = g8_lds_byte(wc * 32 + fr, fq * 8);
    LAS float* rtab = (LAS float*)(lds + G8_MISC_OFF);
#define G8_SA(b, h) (((b) * 2 + (h)) * G8_HTB)
#define G8_SB(b, h) ((4 + (b) * 2 + (h)) * G8_HTB)
#define G8_STAGE(bufoff, gbase, voff) do { _Pragma("unroll") for (int _i = 0; _i < 2; ++_i) \
        __builtin_amdgcn_global_load_lds((const unsigned*)((const char*)(gbase) + (voff)[_i]), (LAS unsigned*)(lds + (bufoff) + ldsw + _i * 8192), 16, 0, 0); } while (0)
#define G8_LDA(dst, b, h) do { _Pragma("unroll") for (int m = 0; m < 4; ++m) _Pragma("unroll") for (int k = 0; k < 2; ++k) dst[m][k] = *(const LAS bf16x8*)(lds + G8_SA(b, h) + aoff + m * 2048 + k * 1024); } while (0)
#define G8_LDB(dst, b, h) do { _Pragma("unroll") for (int n = 0; n < 2; ++n) _Pragma("unroll") for (int k = 0; k < 2; ++k) dst[n][k] = *(const LAS bf16x8*)(lds + G8_SB(b, h) + boff + n * 2048 + k * 1024); } while (0)
#define G8_MMA(ai, bj, At, Bt_) do { __builtin_amdgcn_s_setprio(1); _Pragma("unroll") for (int m = 0; m < 4; ++m) _Pragma("unroll") for (int n = 0; n < 2; ++n) _Pragma("unroll") for (int k = 0; k < 2; ++k) \
        acc[ai][bj][m][n] = __builtin_amdgcn_mfma_f32_16x16x32_bf16(Bt_[n][k], At[m][k], acc[ai][bj][m][n], 0, 0, 0); __builtin_amdgcn_s_setprio(0); } while (0)
#define G8_WAIT_V(n) asm volatile("s_waitcnt vmcnt(" #n ")" ::: "memory")
#define G8_WAIT_L(n) asm volatile("s_waitcnt lgkmcnt(" #n ")" ::: "memory")
#define G8_BAR __builtin_amdgcn_s_barrier()
#define G8_SCHED __builtin_amdgcn_sched_barrier(0)
#define G8_RTAB_FILL(pm_, par_) do { if (MIXN && tid < 256) { \
        const float* sp_ = ssq16 + (size_t)((pm_) * 256 + tid) * 16; \
        const f32x4 a0_ = *(const f32x4*)sp_, a1_ = *(const f32x4*)(sp_ + 4), b0_ = *(const f32x4*)(sp_ + 8), b1_ = *(const f32x4*)(sp_ + 12); \
        const float s1_ = ((a0_[0] + a0_[1]) + (a0_[2] + a0_[3])) + ((a1_[0] + a1_[1]) + (a1_[2] + a1_[3])); \
        const float s2_ = ((b0_[0] + b0_[1]) + (b0_[2] + b0_[3])) + ((b1_[0] + b1_[1]) + (b1_[2] + b1_[3])); \
        const float r1_ = rsqrtf(s1_ * (1.0f / 512.0f) + EPSN), r2_ = rsqrtf(s2_ * (1.0f / 512.0f) + EPSN); \
        rtab[(par_) * 512 + tid] = r1_ / r2_; rtab[(par_) * 512 + 256 + tid] = r2_; } } while (0)
    int pm = xg + 8 * (L / nN), pn = L % nN, npm = 0, npn = 0, ui = 0;
    f32x4a acc[2][2][4][2];
#pragma unroll
    for (int a = 0; a < 2; ++a)
#pragma unroll
        for (int b = 0; b < 2; ++b)
#pragma unroll
            for (int m = 0; m < 4; ++m)
#pragma unroll
                for (int n = 0; n < 2; ++n) acc[a][b][m][n] = (f32x4a){0.f, 0.f, 0.f, 0.f};
    bf16x8 At[4][2], B0[2][2], B1[2][2];
    const char* cA = (const char*)A + (size_t)pm * tstepA; const char* cB = (const char*)Bt + (size_t)pn * tstepB;
    G8_RTAB_FILL(pm, 0);
    G8_STAGE(G8_SB(0, 0), cB, voffB); G8_STAGE(G8_SA(0, 0), cA, voffA); G8_STAGE(G8_SB(0, 1), cB + hstepB, voffB); G8_STAGE(G8_SA(0, 1), cA + hstepA, voffA);
    if (wr == 1) G8_BAR;
    G8_WAIT_V(4); G8_BAR;
    G8_STAGE(G8_SB(1, 0), cB + kstep, voffB); G8_STAGE(G8_SA(1, 0), cA + kstep, voffA); G8_STAGE(G8_SB(1, 1), cB + hstepB + kstep, voffB);
    G8_WAIT_V(6); G8_BAR;
    for (;;) {
        const int Ln = L + ustride;
        const bool has_next = Ln < ucnt;
        if (has_next) { npm = xg + 8 * (Ln / nN); npn = Ln % nN; }
        const char* nA = has_next ? (const char*)A + (size_t)npm * tstepA : cA; const char* nB = has_next ? (const char*)Bt + (size_t)npn * tstepB : cB;
        for (int t = 0; t < nt; t += 2) {
            const bool last = (t == nt - 2);
            const char* a1 = cA + (size_t)(t + 1) * kstep;
            const char* a2 = last ? nA : cA + (size_t)(t + 2) * kstep; const char* b2 = last ? nB : cB + (size_t)(t + 2) * kstep;
            const char* a3 = a2 + kstep; const char* b3 = b2 + kstep;
            if (MIXN && t == (nt >> 1)) {
#pragma unroll
                for (int ai = 0; ai < 2; ++ai)
#pragma unroll
                    for (int m = 0; m < 4; ++m) { const float f = rtab[(ui & 1) * 512 + ai * 128 + wr * 64 + m * 16 + (tid & 15)];
#pragma unroll
                        for (int bj = 0; bj < 2; ++bj)
#pragma unroll
                            for (int n = 0; n < 2; ++n) acc[ai][bj][m][n] *= f; }
            }
            G8_LDB(B0, 0, 0); G8_SCHED; G8_LDA(At, 0, 0); G8_STAGE(G8_SA(1, 1), a1 + hstepA, voffA);
            G8_WAIT_L(8); G8_BAR; G8_WAIT_L(0); G8_MMA(0, 0, At, B0); G8_BAR; G8_SCHED;
            G8_LDB(B1, 0, 1); G8_STAGE(G8_SB(0, 0), b2, voffB);
            G8_BAR; G8_WAIT_L(0); G8_MMA(0, 1, At, B1); G8_BAR;
            G8_LDA(At, 0, 1); G8_STAGE(G8_SA(0, 0), a2, voffA);
            G8_BAR; G8_WAIT_L(0); G8_MMA(1, 0, At, B0); G8_BAR; G8_SCHED;
            G8_STAGE(G8_SB(0, 1), b2 + hstepB, voffB);
            G8_WAIT_V(6); G8_BAR; G8_MMA(1, 1, At, B1); G8_BAR;
            G8_LDB(B0, 1, 0); G8_SCHED; G8_LDA(At, 1, 0); G8_STAGE(G8_SA(0, 1), a2 + hstepA, voffA);
            G8_WAIT_L(8); G8_BAR; G8_WAIT_L(0); G8_MMA(0, 0, At, B0); G8_BAR; G8_SCHED;
            G8_LDB(B1, 1, 1); G8_STAGE(G8_SB(1, 0), b3, voffB);
            G8_BAR; G8_WAIT_L(0); G8_MMA(0, 1, At, B1); G8_BAR;
            G8_LDA(At, 1, 1); G8_STAGE(G8_SA(1, 0), a3, voffA);
            G8_BAR; G8_WAIT_L(0); G8_MMA(1, 0, At, B0); G8_BAR; G8_SCHED;
            G8_STAGE(G8_SB(1, 1), b3 + hstepB, voffB);
            G8_WAIT_V(6); G8_BAR; G8_MMA(1, 1, At, B1); G8_BAR;
        }
        {
            const int col0 = pn * 256 + wc * 64;
            if (MIXN && has_next) G8_RTAB_FILL(npm, (ui + 1) & 1);
            int tid_e = tid; asm volatile("" : "+v"(tid_e));
            const int fr_e = tid_e & 15, fq_e = (tid_e >> 4) & 3;
            typename Epi::Pre pre[2][4];
#pragma unroll
            for (int ai = 0; ai < 2; ++ai)
#pragma unroll
                for (int m = 0; m < 4; ++m) pre[ai][m] = E.pre(pm * 256 + ai * 128 + wr * 64 + m * 16 + fr_e, col0, fq_e);
#pragma unroll
            for (int ai = 0; ai < 2; ++ai)
#pragma unroll
                for (int m = 0; m < 4; ++m) {
                    const int rl = ai * 128 + wr * 64 + m * 16 + fr_e;
                    float v[2][8];
#pragma unroll
                    for (int bj = 0; bj < 2; ++bj)
#pragma unroll
                        for (int n = 0; n < 2; ++n)
#pragma unroll
                            for (int e = 0; e < 4; ++e) v[bj][4 * n + e] = acc[ai][bj][m][n][e];
                    E(pm * 256 + rl, col0, fq_e, v, MIXN ? rtab[(ui & 1) * 512 + 256 + rl] : 0.f, pre[ai][m]);
                }
        }
        if (!has_next) break;
#pragma unroll
        for (int a = 0; a < 2; ++a)
#pragma unroll
            for (int b = 0; b < 2; ++b)
#pragma unroll
                for (int m = 0; m < 4; ++m)
#pragma unroll
                    for (int n = 0; n < 2; ++n) acc[a][b][m][n] = (f32x4a){0.f, 0.f, 0.f, 0.f};
        pm = npm; pn = npn; cA = nA; cB = nB; L = Ln; ++ui;
    }
    G8_WAIT_V(0);
    if (wr == 0) G8_BAR;
    G8_BAR;
#undef G8_SA
#undef G8_SB
#undef G8_STAGE
#undef G8_LDA
#undef G8_LDB
#undef G8_MMA
#undef G8_WAIT_V
#undef G8_WAIT_L
#undef G8_BAR
#undef G8_SCHED
#undef G8_RTAB_FILL
}

#ifndef FULL_LINE
#define FULL_LINE 0
#endif
__device__ __forceinline__ void rows16_xchg(u32x4& a0, u32x4& a1, bool hi) {
    if (!FULL_LINE) return;
    u32x4 send, recv;
#pragma unroll
    for (int q = 0; q < 4; ++q) send[q] = hi ? a0[q] : a1[q];
#pragma unroll
    for (int q = 0; q < 4; ++q) recv[q] = (unsigned)__builtin_amdgcn_update_dpp(0, (int)send[q], 0x128, 0xf, 0xf, false);
#pragma unroll
    for (int q = 0; q < 4; ++q) { a0[q] = hi ? recv[q] : a0[q]; a1[q] = hi ? a1[q] : recv[q]; }
}
__device__ __forceinline__ void rows16_xchg2(u32x2& a0, u32x2& a1, bool hi) {
    if (!FULL_LINE) return;
    u32x2 send, recv;
#pragma unroll
    for (int q = 0; q < 2; ++q) send[q] = hi ? a0[q] : a1[q];
#pragma unroll
    for (int q = 0; q < 2; ++q) recv[q] = (unsigned)__builtin_amdgcn_update_dpp(0, (int)send[q], 0x128, 0xf, 0xf, false);
#pragma unroll
    for (int q = 0; q < 2; ++q) { a0[q] = hi ? recv[q] : a0[q]; a1[q] = hi ? a1[q] : recv[q]; }
}
__device__ __forceinline__ bf16_t* rows16_ptr(bf16_t* own, size_t ld, int fr, int fq) { return FULL_LINE ? own - (size_t)(fr & 8) * ld + 32 * (fr >> 3) + 8 * fq : own + 8 * fq; }
__device__ __forceinline__ const bf16_t* rows16_ptr(const bf16_t* own, size_t ld, int fr, int fq) { return FULL_LINE ? own - (size_t)(fr & 8) * ld + 32 * (fr >> 3) + 8 * fq : own + 8 * fq; }
__device__ __forceinline__ size_t rows16_step(size_t ld) { return FULL_LINE ? 8 * ld : 32; }
__device__ __forceinline__ void st_rows16(bf16_t* own, size_t ld, int fr, int fq, u32x4 a0, u32x4 a1) {
    rows16_xchg(a0, a1, fr >= 8);
    bf16_t* p = rows16_ptr(own, ld, fr, fq);
    *(u32x4*)p = a0; *(u32x4*)(p + rows16_step(ld)) = a1;
}
__device__ __forceinline__ float fq_sum(float x) {
    u32x2 s = __builtin_amdgcn_permlane16_swap(__float_as_uint(x), __float_as_uint(x), false, false);
    x = __uint_as_float(s.x) + __uint_as_float(s.y);
    s = __builtin_amdgcn_permlane32_swap(__float_as_uint(x), __float_as_uint(x), false, false);
    return __uint_as_float(s.x) + __uint_as_float(s.y);
}
__device__ __forceinline__ float fq_xor1(float x, int fq) {
    const u32x2 s = __builtin_amdgcn_permlane16_swap(__float_as_uint(x), __float_as_uint(x), false, false);
    return __uint_as_float((fq & 1) ? s.x : s.y);
}
__device__ __forceinline__ void fq_bcast23(float x, float& r2, float& r3) {
    const u32x2 s = __builtin_amdgcn_permlane32_swap(__float_as_uint(x), __float_as_uint(x), false, false);
    const u32x2 t = __builtin_amdgcn_permlane16_swap(s.y, s.y, false, false);
    r2 = __uint_as_float(t.x); r3 = __uint_as_float(t.y);
}
struct Epi8ResBf16Q {
    const bf16_t* hb_in; bf16_t* hb_out; unsigned* hq; float* ssq;
    struct Pre { u32x4 r[2]; };
    __device__ __forceinline__ Pre pre(int row, int col0, int fq) const {
        Pre p; const bf16_t* s = rows16_ptr(hb_in + (size_t)row * DM + col0, DM, row & 15, fq); p.r[0] = *(const u32x4*)s; p.r[1] = *(const u32x4*)(s + rows16_step(DM)); return p; }
    __device__ __forceinline__ void operator()(int row, int col0, int fq, float (&v)[2][8], float, const Pre& p) const {
        float ss = 0.f;
        const int fr = row & 15;
        u32x4 hin[2] = {p.r[0], p.r[1]};
        rows16_xchg(hin[0], hin[1], fr >= 8);
        u32x4 ob[2]; u32x2 oq[2];
#pragma unroll
        for (int bj = 0; bj < 2; ++bj) {
            float x[8]; unpack8(hin[bj], x);
#pragma unroll
            for (int e = 0; e < 8; ++e) { v[bj][e] += x[e]; ss += v[bj][e] * v[bj][e]; }
            ob[bj] = pack8(v[bj]);
            unsigned w[2] = {0u, 0u};
#pragma unroll
            for (int e = 0; e < 8; ++e) {
                const int qi = (int)rintf(fminf(fmaxf(v[bj][e] * (127.0f / H2Q_CLIP), -127.0f), 127.0f));
                w[e >> 2] |= ((unsigned)qi & 0xFFu) << (8 * (e & 3));
            }
            oq[bj] = (u32x2){w[0], w[1]};
        }
        st_rows16(hb_out + (size_t)row * DM + col0, DM, fr, fq, ob[0], ob[1]);
        rows16_xchg2(oq[0], oq[1], fr >= 8);
        {
            unsigned char* qp = FULL_LINE ? (unsigned char*)hq + (size_t)(row - (fr & 8)) * DM + col0 + 32 * (fr >> 3) + 8 * fq : (unsigned char*)hq + (size_t)row * DM + col0 + 8 * fq;
            *(u32x2*)qp = oq[0]; *(u32x2*)(qp + rows16_step(DM)) = oq[1];
        }
        ss = fq_sum(ss);
        if (fq == 0) ssq[(size_t)row * 16 + (col0 >> 6)] = ss;
    }
};
struct Epi8RssScaleBf16 {
    bf16_t* out; int ld; const float* ssq; float* rstd_out;
    struct Pre { f32x4 s; };
    __device__ __forceinline__ Pre pre(int row, int, int fq) const { Pre p; p.s = *(const f32x4*)(ssq + (size_t)row * 16 + 4 * fq); return p; }
    __device__ __forceinline__ void operator()(int row, int col0, int fq, float (&v)[2][8], float, const Pre& p) const {
        float t = (p.s[0] + p.s[1]) + (p.s[2] + p.s[3]);
        t = fq_sum(t);
        const float s = rsqrtf(t * (1.0f / 1024.0f) + EPSN);
#pragma unroll
        for (int bj = 0; bj < 2; ++bj)
#pragma unroll
            for (int e = 0; e < 8; ++e) v[bj][e] *= s;
        st_rows16(out + (size_t)row * ld + col0, ld, row & 15, fq, pack8(v[0]), pack8(v[1]));
        if (rstd_out && col0 == 0 && fq == 0) rstd_out[row] = s;
    }
};
struct Epi8ResBf16S {
    const bf16_t* hb_in; bf16_t* hb_out; float* ssq;
    struct Pre { u32x4 r[2]; };
    __device__ __forceinline__ Pre pre(int row, int col0, int fq) const {
        Pre p; const bf16_t* s = rows16_ptr(hb_in + (size_t)row * DM + col0, DM, row & 15, fq); p.r[0] = *(const u32x4*)s; p.r[1] = *(const u32x4*)(s + rows16_step(DM)); return p; }
    __device__ __forceinline__ void operator()(int row, int col0, int fq, float (&v)[2][8], float aux, const Pre& p) const {
        float ss = 0.f;
        const int fr = row & 15;
        u32x4 hin[2] = {p.r[0], p.r[1]};
        rows16_xchg(hin[0], hin[1], fr >= 8);
#pragma unroll
        for (int bj = 0; bj < 2; ++bj) {
            float x[8]; unpack8(hin[bj], x);
#pragma unroll
            for (int e = 0; e < 8; ++e) { v[bj][e] = v[bj][e] * aux + x[e]; ss += v[bj][e] * v[bj][e]; }
        }
        st_rows16(hb_out + (size_t)row * DM + col0, DM, fr, fq, pack8(v[0]), pack8(v[1]));
        ss = fq_sum(ss);
        if (fq == 0) ssq[(size_t)row * 16 + (col0 >> 6)] = ss;
    }
};
struct Epi8RowScaleBf16 {
    bf16_t* out; int ld; const float* scale;
    struct Pre { float s; };
    __device__ __forceinline__ Pre pre(int row, int, int) const { Pre p; p.s = scale[row]; return p; }
    __device__ __forceinline__ void operator()(int row, int col0, int fq, float (&v)[2][8], float, const Pre& p) const {
#pragma unroll
        for (int bj = 0; bj < 2; ++bj)
#pragma unroll
            for (int e = 0; e < 8; ++e) v[bj][e] *= p.s;
        st_rows16(out + (size_t)row * ld + col0, ld, row & 15, fq, pack8(v[0]), pack8(v[1]));
    }
};
struct Epi8InProj {
    const float* rstd0; bf16_t* P; bf16_t* QN; bf16_t* KS; bf16_t* KW; bf16_t* KCIN; bf16_t* VCIN; float* GATE;
    const f32x2* ropen; const float* qg; const float* kg; float* CSSQ;
    struct Pre { float rs; };
    __device__ __forceinline__ Pre pre(int row, int, int) const { Pre p; p.rs = rstd0[row]; return p; }
    __device__ __forceinline__ void operator()(int row, int col0, int fq, float (&v)[2][8], float, const Pre& p) const {
        const int seg = col0 >> 6;
        const int b = row >> 12, s = row & 4095;
#pragma unroll
        for (int bj = 0; bj < 2; ++bj)
#pragma unroll
            for (int e = 0; e < 8; ++e) v[bj][e] *= p.rs;
        if (seg < 12) {
            float ss = 0.f;
#pragma unroll
            for (int bj = 0; bj < 2; ++bj)
#pragma unroll
                for (int e = 0; e < 8; ++e) ss += v[bj][e] * v[bj][e];
            ss = fq_sum(ss);
            const float rr = rsqrtf(ss * (1.0f / 64.0f) + EPSN);
            const float* g = seg < 8 ? qg : (seg < 10 ? kg + 64 : kg + 128);
#pragma unroll
            for (int bj = 0; bj < 2; ++bj) {
                const f32x4 g0 = *(const f32x4*)(g + 32 * bj + 8 * fq), g1 = *(const f32x4*)(g + 32 * bj + 8 * fq + 4);
#pragma unroll
                for (int e = 0; e < 4; ++e) { v[bj][e] *= rr * g0[e]; v[bj][4 + e] *= rr * g1[e]; }
            }
            const f32x4* rp = (const f32x4*)(ropen + (size_t)s * 8);
            const f32x4 c01 = rp[0], c23 = rp[1], c45 = rp[2], c67 = rp[3];
            const float cs[8] = {c01[0], c01[2], c23[0], c23[2], c45[0], c45[2], c67[0], c67[2]};
            const float sn[8] = {c01[1], c01[3], c23[1], c23[3], c45[1], c45[3], c67[1], c67[3]};
            const float sc = seg < 8 ? 0.125f * LOG2E : 1.0f;
#pragma unroll
            for (int j = 0; j < 8; ++j) {
                const float o = fq_xor1(v[0][j], fq);
                const float r = fq == 0 ? (v[0][j] * cs[j] - o * sn[j]) : (v[0][j] * cs[j] + o * sn[j]);
                v[0][j] = fq < 2 ? r : v[0][j];
            }
#pragma unroll
            for (int bj = 0; bj < 2; ++bj)
#pragma unroll
                for (int e = 0; e < 8; ++e) v[bj][e] *= sc;
            bf16_t* dst = seg < 8 ? QN + ((size_t)(b * 8 + seg) * SEQ + s) * 64
                        : seg < 10 ? KS + ((size_t)(b * 2 + (seg - 8)) * SEQ + s) * 64 : KW + ((size_t)(b * 2 + (seg - 10)) * SEQ + s) * 64;
            st_rows16(dst, 64, row & 15, fq, pack8(v[0]), pack8(v[1]));
        } else if (seg < 16) {
            bf16_t* dst = seg < 14 ? KCIN + ((size_t)(b * 2 + (seg - 12)) * SEQ + s) * 64 : VCIN + ((size_t)(b * 2 + (seg - 14)) * SEQ + s) * 64;
            st_rows16(dst, 64, row & 15, fq, pack8(v[0]), pack8(v[1]));
        } else if (seg < 26) {
            bf16_t* dst = P + (size_t)row * PLD + col0;
            st_rows16(dst, PLD, row & 15, fq, pack8(v[0]), pack8(v[1]));
            if (seg >= 20) {
                float ss = 0.f;
#pragma unroll
                for (int bj = 0; bj < 2; ++bj)
#pragma unroll
                    for (int e = 0; e < 8; ++e) ss += v[bj][e] * v[bj][e];
                ss = fq_sum(ss);
                if (fq == 0) CSSQ[(size_t)row * 8 + (seg - 20)] = ss;
            }
        } else if (seg == 26) {
            *(u32x4*)(P + (size_t)row * PLD + col0 + 8 * fq) = pack8(v[0]);
            {
                float ss = 0.f;
#pragma unroll
                for (int e = 0; e < 8; ++e) ss += v[0][e] * v[0][e];
                ss = fq_sum(ss);
                if (fq == 0) CSSQ[(size_t)row * 8 + 6] = ss;
            }
            if (fq < 3) {
                float* gp = GATE + (size_t)row * 24 + 8 * fq;
                f32x4 a, c;
#pragma unroll
                for (int e = 0; e < 4; ++e) { a[e] = 1.0f / (1.0f + __expf(-v[1][e])); c[e] = 1.0f / (1.0f + __expf(-v[1][4 + e])); }
                *(f32x4*)gp = a; *(f32x4*)(gp + 4) = c;
            }
        }
    }
};
struct Epi8QUp {
    bf16_t* out; int ld; const float* cssq;
    struct Pre { float s; };
    __device__ __forceinline__ Pre pre(int row, int, int fq) const { Pre p; p.s = cssq[(size_t)row * 8 + fq]; return p; }
    __device__ __forceinline__ void operator()(int row, int col0, int fq, float (&v)[2][8], float, const Pre& p) const {
        const float t = fq_sum(p.s);
        const float s = rsqrtf(t * (1.0f / 256.0f) + EPSN);
#pragma unroll
        for (int bj = 0; bj < 2; ++bj)
#pragma unroll
            for (int e = 0; e < 8; ++e) v[bj][e] *= s;
        st_rows16(out + (size_t)row * ld + col0, ld, row & 15, fq, pack8(v[0]), pack8(v[1]));
    }
};
struct Epi8KvUp {
    const float* cssq; const bf16_t* P; const f32x2* ropem; const float* kg; bf16_t* KM; bf16_t* KVR;
    struct Pre { f32x2 s; };
    __device__ __forceinline__ Pre pre(int row, int, int fq) const { Pre p; p.s = *(const f32x2*)(cssq + (size_t)row * 8 + 2 * fq); return p; }
    __device__ __forceinline__ void operator()(int row, int col0, int fq, float (&v)[2][8], float, const Pre& p) const {
        float ckv, kpe, dummy;
        fq_bcast23(p.s[0] + p.s[1], ckv, dummy);
        fq_bcast23(p.s[0], dummy, kpe);
        const float rc = rsqrtf(ckv * (1.0f / 128.0f) + EPSN);
#pragma unroll
        for (int bj = 0; bj < 2; ++bj)
#pragma unroll
            for (int e = 0; e < 8; ++e) v[bj][e] *= rc;
        const int seg = col0 >> 6, head = seg >> 1;
        if (seg & 1) {
            bf16_t* dst = KVR + (size_t)row * 1024 + head * 128 + 64;
            st_rows16(dst, 1024, row & 15, fq, pack8(v[0]), pack8(v[1]));
        } else {
            const int b = row >> 12, s = row & 4095;
            float ss = 0.f;
#pragma unroll
            for (int bj = 0; bj < 2; ++bj)
#pragma unroll
                for (int e = 0; e < 8; ++e) ss += v[bj][e] * v[bj][e];
            ss = fq_sum(ss);
            const float r = rsqrtf((ss + kpe) * (1.0f / 96.0f) + EPSN);
            bf16_t* kp = KM + ((size_t)(b * 8 + head) * SEQ + s) * 96;
#pragma unroll
            for (int bj = 0; bj < 2; ++bj) {
                const f32x4 g0 = *(const f32x4*)(kg + 32 * bj + 8 * fq), g1 = *(const f32x4*)(kg + 32 * bj + 8 * fq + 4);
#pragma unroll
                for (int e = 0; e < 4; ++e) { v[bj][e] *= r * g0[e]; v[bj][4 + e] *= r * g1[e]; }
            }
            st_rows16(kp, 96, row & 15, fq, pack8(v[0]), pack8(v[1]));
            const u32x2 x1w = *(const u32x2*)(P + (size_t)row * PLD + C_KPE + 4 * fq), x2w = *(const u32x2*)(P + (size_t)row * PLD + C_KPE + 16 + 4 * fq);
            const f32x4 cs0 = *(const f32x4*)(ropem + (size_t)s * 16 + 4 * fq), cs1 = *(const f32x4*)(ropem + (size_t)s * 16 + 4 * fq + 2);
            const f32x4 ga = *(const f32x4*)(kg + 64 + 4 * fq), gb = *(const f32x4*)(kg + 80 + 4 * fq);
            const float x1[4] = {bflo(x1w.x), bfhi(x1w.x), bflo(x1w.y), bfhi(x1w.y)}, x2[4] = {bflo(x2w.x), bfhi(x2w.x), bflo(x2w.y), bfhi(x2w.y)};
            const float cc[4] = {cs0[0], cs0[2], cs1[0], cs1[2]}, sn[4] = {cs0[1], cs0[3], cs1[1], cs1[3]};
            float y1[4], y2[4];
#pragma unroll
            for (int e = 0; e < 4; ++e) { const float a1 = x1[e] * r * ga[e], a2 = x2[e] * r * gb[e]; y1[e] = a1 * cc[e] - a2 * sn[e]; y2[e] = a2 * cc[e] + a1 * sn[e]; }
            *(u32x2*)(kp + 64 + 4 * fq) = pack4(y1); *(u32x2*)(kp + 80 + 4 * fq) = pack4(y2);
        }
    }
};

__device__ __forceinline__ int inproj_src_col(int n) {
    if (n < 512) return 416 + n;
    if (n < 640) return 1184 + (n - 512);
    if (n < 768) return 1440 + (n - 640);
    if (n < 896) return 928 + (n - 768);
    if (n < 1024) return 1056 + (n - 896);
    if (n < 1152) return 1312 + (n - 1024);
    if (n < 1280) return 1568 + (n - 1152);
    if (n < 1536) return n - 1280;
    if (n < 1664) return 256 + (n - 1536);
    if (n < 1696) return 384 + (n - 1664);
    if (n < 1720) return n;
    return -1;
}
template <bool PERM = false>
__device__ __forceinline__ void wt_tile(const float* __restrict__ W, int N, const float* __restrict__ gain, bf16_t* __restrict__ Wt, int ldt,
                                        int kt, int nt, float* tile, bool valid) {
    const int tid = threadIdx.x & 255;
    tile += (threadIdx.x >> 8) * (64 * 65);
    __syncthreads();
    if (valid) {
        const int i = tid >> 4, j4 = (tid & 15) * 4;
#pragma unroll
        for (int rr = 0; rr < 4; ++rr) {
            const int k = kt * 64 + i + 16 * rr, nd = nt * 64 + j4;
            const int n = PERM ? inproj_src_col(nd) : (nd < N ? nd : -1);
            f32x4 v = (f32x4){0.f, 0.f, 0.f, 0.f};
            if (n >= 0) v = *(const f32x4*)(W + (size_t)k * N + n);
            const float g = gain ? gain[k] : 1.0f;
            float* tp = tile + (i + 16 * rr) * 65 + j4;
            tp[0] = v[0] * g; tp[1] = v[1] * g; tp[2] = v[2] * g; tp[3] = v[3] * g;
        }
    }
    __syncthreads();
    if (valid) {
        const int j = tid >> 2, ic = (tid & 3) * 16;
        float a[8], b[8];
#pragma unroll
        for (int e = 0; e < 8; ++e) { a[e] = tile[(ic + e) * 65 + j]; b[e] = tile[(ic + 8 + e) * 65 + j]; }
        bf16_t* dp = Wt + (size_t)(nt * 64 + j) * ldt + kt * 64 + ic;
        *(u32x4*)dp = pack8(a); *(u32x4*)(dp + 8) = pack8(b);
    }
    __syncthreads();
}

__device__ __forceinline__ void tr_tile(const bf16_t* __restrict__ src, size_t src_ld, bf16_t* __restrict__ dst, size_t dst_ld, bf16_t* tile, bool valid) {
    const int tid = threadIdx.x & 255;
    tile += (threadIdx.x >> 8) * (64 * 66);
    __syncthreads();
    if (valid) {
        const int r = tid >> 2, c = (tid & 3) * 16;
        const u32x4 a = *(const u32x4*)(src + (size_t)r * src_ld + c), b = *(const u32x4*)(src + (size_t)r * src_ld + c + 8);
        unsigned* tp = (unsigned*)(tile + r * 66 + c);
        tp[0] = a.x; tp[1] = a.y; tp[2] = a.z; tp[3] = a.w; tp[4] = b.x; tp[5] = b.y; tp[6] = b.z; tp[7] = b.w;
    }
    __syncthreads();
    if (valid) {
        const int c = tid >> 2, r0 = (tid & 3) * 16;
        unsigned o[8];
#pragma unroll
        for (int e = 0; e < 8; ++e) o[e] = (unsigned)tile[(r0 + 2 * e) * 66 + c] | ((unsigned)tile[(r0 + 2 * e + 1) * 66 + c] << 16);
        bf16_t* dp = dst + (size_t)c * dst_ld + r0;
        *(u32x4*)dp = (u32x4){o[0], o[1], o[2], o[3]}; *(u32x4*)(dp + 8) = (u32x4){o[4], o[5], o[6], o[7]};
    }
    __syncthreads();
}

static __device__ const double INV_MLA[16] = {1.0, 0.44036660267178046, 0.19392274474868576, 0.08539710028576561, 0.03760603093086393, 0.016560440080994446,
    0.007292664737217109, 0.003211445994752591, 0.001414213562373095, 0.000622772421914596, 0.0002742481756762073, 0.00012076973741146504,
    5.318295896944988e-05, 2.341999896140934e-05, 1.031338537721246e-05, 4.5416704806078695e-06};
__device__ __forceinline__ f32x2 rope_cs(int pos, double inv) {
    double rev = (double)pos * inv * 0.15915494309189535;
    rev -= __builtin_floor(rev);
    const float rf = (float)rev;
    return (f32x2){__builtin_amdgcn_cosf(rf), __builtin_amdgcn_sinf(rf)};
}

__device__ __forceinline__ void rows_to_bf16(const float* __restrict__ x, bf16_t* __restrict__ xb, float* __restrict__ rstd, const float* __restrict__ gain,
                                             int nrows, int gw, int nw, int lane) {
    for (int r = gw; r < nrows; r += nw) {
        const float* xp = x + (size_t)r * 1024 + lane * 8;
        const f32x4 a = *(const f32x4*)xp, b = *(const f32x4*)(xp + 4), c = *(const f32x4*)(xp + 512), d = *(const f32x4*)(xp + 516);
        float v0[8] = {a[0], a[1], a[2], a[3], b[0], b[1], b[2], b[3]}, v1[8] = {c[0], c[1], c[2], c[3], d[0], d[1], d[2], d[3]};
        if (rstd) {
            float s = 0.f;
#pragma unroll
            for (int e = 0; e < 8; ++e) s += v0[e] * v0[e] + v1[e] * v1[e];
            s = wave_sum(s);
            if (lane == 0) rstd[r] = rsqrtf(s * (1.0f / 1024.0f) + EPSN);
        }
        if (gain) {
            const f32x4 ga = *(const f32x4*)(gain + lane * 8), gb = *(const f32x4*)(gain + lane * 8 + 4), gc = *(const f32x4*)(gain + 512 + lane * 8), gd = *(const f32x4*)(gain + 516 + lane * 8);
#pragma unroll
            for (int e = 0; e < 4; ++e) { v0[e] *= ga[e]; v0[4 + e] *= gb[e]; v1[e] *= gc[e]; v1[4 + e] *= gd[e]; }
        }
        bf16_t* op = xb + (size_t)r * 1024 + lane * 8;
        *(u32x4*)op = pack8(v0); *(u32x4*)(op + 512) = pack8(v1);
    }
}

#define U_SCALE 64.0f
#define V_SCALE 8.0f
__device__ __forceinline__ void rows_to_slices(const float* __restrict__ x, unsigned char* __restrict__ dst, const float* __restrict__ gain, float scale, int gw, int nw, int lane) {
    for (int r = gw; r < 16384; r += nw) {
        const float* xp = x + (size_t)r * 1024 + lane * 8;
        const f32x4 a = *(const f32x4*)xp, b = *(const f32x4*)(xp + 4), c = *(const f32x4*)(xp + 512), d = *(const f32x4*)(xp + 516);
        float v0[8] = {a[0], a[1], a[2], a[3], b[0], b[1], b[2], b[3]}, v1[8] = {c[0], c[1], c[2], c[3], d[0], d[1], d[2], d[3]};
        if (gain) {
            const f32x4 ga = *(const f32x4*)(gain + lane * 8), gb = *(const f32x4*)(gain + lane * 8 + 4), gc = *(const f32x4*)(gain + 512 + lane * 8), gd = *(const f32x4*)(gain + 516 + lane * 8);
#pragma unroll
            for (int e = 0; e < 4; ++e) { v0[e] *= ga[e]; v0[4 + e] *= gb[e]; v1[e] *= gc[e]; v1[4 + e] *= gd[e]; }
        }
#pragma unroll
        for (int e = 0; e < 8; ++e) { v0[e] *= scale; v1[e] *= scale; }
        u32x2 p0, p1;
        { int t = __builtin_amdgcn_cvt_pk_fp8_f32(v0[0], v0[1], 0, false); t = __builtin_amdgcn_cvt_pk_fp8_f32(v0[2], v0[3], t, true); p0.x = (unsigned)t;
          t = __builtin_amdgcn_cvt_pk_fp8_f32(v0[4], v0[5], 0, false); t = __builtin_amdgcn_cvt_pk_fp8_f32(v0[6], v0[7], t, true); p0.y = (unsigned)t;
          t = __builtin_amdgcn_cvt_pk_fp8_f32(v1[0], v1[1], 0, false); t = __builtin_amdgcn_cvt_pk_fp8_f32(v1[2], v1[3], t, true); p1.x = (unsigned)t;
          t = __builtin_amdgcn_cvt_pk_fp8_f32(v1[4], v1[5], 0, false); t = __builtin_amdgcn_cvt_pk_fp8_f32(v1[6], v1[7], t, true); p1.y = (unsigned)t; }
        const int sl = lane >> 4, off = (lane & 15) * 8;
        *(u32x2*)(dst + ((size_t)sl * 16384 + r) * 128 + off) = p0;
        *(u32x2*)(dst + ((size_t)(4 + sl) * 16384 + r) * 128 + off) = p1;
    }
}

__device__ __forceinline__ void rows_to_slices_i8(const float* __restrict__ x, unsigned char* __restrict__ dst, const float* __restrict__ gain, float* __restrict__ row_scale,
                                                  int gw, int nw, int lane) {
    for (int r = gw; r < 16384; r += nw) {
        const float* xp = x + (size_t)r * 1024 + lane * 8;
        const f32x4 a = *(const f32x4*)xp, b = *(const f32x4*)(xp + 4), c = *(const f32x4*)(xp + 512), d = *(const f32x4*)(xp + 516);
        float v0[8] = {a[0], a[1], a[2], a[3], b[0], b[1], b[2], b[3]}, v1[8] = {c[0], c[1], c[2], c[3], d[0], d[1], d[2], d[3]};
        const f32x4 ga = *(const f32x4*)(gain + lane * 8), gb = *(const f32x4*)(gain + lane * 8 + 4), gc = *(const f32x4*)(gain + 512 + lane * 8), gd = *(const f32x4*)(gain + 516 + lane * 8);
        float mx = 0.f;
#pragma unroll
        for (int e = 0; e < 4; ++e) { v0[e] *= ga[e]; v0[4 + e] *= gb[e]; v1[e] *= gc[e]; v1[4 + e] *= gd[e]; }
#pragma unroll
        for (int e = 0; e < 8; ++e) mx = fmaxf(mx, fmaxf(fabsf(v0[e]), fabsf(v1[e])));
        mx = fmaxf(mx, __shfl_xor(mx, 32)); mx = fmaxf(mx, __shfl_xor(mx, 16)); mx = fmaxf(mx, __shfl_xor(mx, 8));
        mx = fmaxf(mx, __shfl_xor(mx, 4)); mx = fmaxf(mx, __shfl_xor(mx, 2)); mx = fmaxf(mx, __shfl_xor(mx, 1));
        const float inv = mx > 0.f ? 127.0f / mx : 0.f;
        unsigned w[4] = {0u, 0u, 0u, 0u};
#pragma unroll
        for (int e = 0; e < 8; ++e) {
            const int q0 = (int)rintf(v0[e] * inv), q1 = (int)rintf(v1[e] * inv);
            w[e >> 2] |= ((unsigned)q0 & 0xFFu) << (8 * (e & 3));
            w[2 + (e >> 2)] |= ((unsigned)q1 & 0xFFu) << (8 * (e & 3));
        }
        const int sl = lane >> 4, off = (lane & 15) * 8;
        *(u32x2*)(dst + ((size_t)sl * 16384 + r) * 128 + off) = (u32x2){w[0], w[1]};
        *(u32x2*)(dst + ((size_t)(4 + sl) * 16384 + r) * 128 + off) = (u32x2){w[2], w[3]};
        if (lane == 0) row_scale[r] = mx * (1.0f / 127.0f);
    }
}

struct WtJob { const float* W; int K, N, Npad; const float* gain; bf16_t* Wt; int ldt; };

__device__ __forceinline__ void phase_prep(const Args& a, unsigned char* lds) {
    unsigned char* ws = a.ws;
    const int tid = threadIdx.x, lane = tid & 63, w = tid >> 6;
    const int gw = blockIdx.x * NWV + w, nw = gridDim.x * NWV;
    rows_to_bf16(a.in[0], (bf16_t*)(ws + WS_XB), (float*)(ws + WS_RSTD0), nullptr, T_TOK, gw, nw, lane);
    rows_to_bf16(a.in[1], (bf16_t*)(ws + WS_MEMB), (float*)(ws + WS_RSTDMEM), nullptr, 4096, gw, nw, lane);
    rows_to_slices_i8(a.in[25], ws + WS_UB, a.in[22], (float*)(ws + WS_USCALE), gw, nw, lane);
    rows_to_slices(a.in[26], ws + WS_VB, nullptr, V_SCALE, gw, nw, lane);
    for (int i = blockIdx.x * NT + tid; i < 131072 / 8; i += gridDim.x * NT) {
        const float* kp = a.in[24] + (size_t)i * 8;
        const f32x4 p = *(const f32x4*)kp, q = *(const f32x4*)(kp + 4);
        float v[8] = {p[0], p[1], p[2], p[3], q[0], q[1], q[2], q[3]};
        *(u32x4*)((bf16_t*)(ws + WS_KP) + (size_t)i * 8) = pack8(v);
    }
    for (int i = blockIdx.x * NT + tid; i < 4096 * 16; i += gridDim.x * NT) {
        const int pos = i >> 4, f = i & 15;
        ((f32x2*)(ws + WS_ROPEM))[i] = rope_cs(pos, INV_MLA[f]);
        if (f < 8) ((f32x2*)(ws + WS_ROPEN))[pos * 8 + f] = rope_cs(pos, INV_MLA[2 * f]);
    }
    for (int it = blockIdx.x; it < 32; it += gridDim.x) {
        const int kv = it >> 4, s16 = it & 15;
        if (tid >= 256) continue;
        const int j = tid & 127, kh = tid >> 7;
        const int sl = s16 * 2 + kh;
        const float* pe = a.in[11] + (size_t)kv * 2048 + sl * 64;
        const float* w1 = a.in[12] + ((size_t)kv * 2048 + sl * 64) * 128 + j;
        float s = 0.f;
        for (int k = 0; k < 64; ++k) s += pe[k] * w1[(size_t)k * 128];
        ((float*)(ws + WS_BIASP))[(kv * 32 + sl) * 128 + j] = s;
    }
    {
        float* tile = (float*)lds;
        const WtJob jobs[11] = {
            {a.in[3],  1024, INC,  INP,  a.in[2],  (bf16_t*)(ws + WS_WIN),  1024},
            {a.in[6],  256,  768,  768,  a.in[4],  (bf16_t*)(ws + WS_WUQ),  256},
            {a.in[7],  128,  1024, 1024, a.in[5],  (bf16_t*)(ws + WS_WUKV), 128},
            {a.in[12], 2048, 128,  128,  nullptr,  (bf16_t*)(ws + WS_W1C),  2048},
            {a.in[12] + 2048 * 128, 2048, 128, 128, nullptr, (bf16_t*)(ws + WS_W1C) + 128 * 2048, 2048},
            {a.in[13], 128,  64,   128,  nullptr,  (bf16_t*)(ws + WS_W2C),  128},
            {a.in[13] + 128 * 64, 128, 64, 128, nullptr, (bf16_t*)(ws + WS_W2C) + 128 * 128, 128},
            {a.in[15], 1024, 1024, 1024, a.in[14], (bf16_t*)(ws + WS_WOUT), 1024},
            {a.in[18], 1024, 512,  512,  a.in[16], (bf16_t*)(ws + WS_WXQ),  1024},
            {a.in[19], 1024, 1024, 1024, a.in[17], (bf16_t*)(ws + WS_WXKV), 1024},
            {a.in[21], 512,  1024, 1024, nullptr,  (bf16_t*)(ws + WS_WXO),  512},
        };
        int base = 0;
#pragma unroll
        for (int jb = 0; jb < 12; ++jb) {
            WtJob J;
            if (jb < 11) J = jobs[jb]; else J = WtJob{a.in[23], 1024, 1024, 1024, a.in[22], (bf16_t*)(ws + WS_WPQ), 1024};
            const int nkt = J.K / 64, nnt = J.Npad / 64, ntile = nkt * nnt;
            const int half = tid >> 8;
            for (int t0 = 2 * (int)blockIdx.x; t0 < ntile; t0 += 2 * (int)gridDim.x) {
                const int t = t0 + half; const bool ok = t < ntile; const int tt = ok ? t : 0;
                if (jb == 0) wt_tile<true>(J.W, J.N, J.gain, J.Wt, J.ldt, tt % nkt, tt / nkt, tile, ok); else wt_tile<false>(J.W, J.N, J.gain, J.Wt, J.ldt, tt % nkt, tt / nkt, tile, ok);
            }
            base += ntile;
        }
    }
}

__device__ __forceinline__ void norm_rope64(float (&v)[8], int p, const float* __restrict__ gain, const f32x2* __restrict__ cs, float scale, bool do_norm) {
    float s = 0.f;
#pragma unroll
    for (int e = 0; e < 8; ++e) s += v[e] * v[e];
    s += __shfl_xor(s, 1); s += __shfl_xor(s, 2); s += __shfl_xor(s, 4);
    const float r = rsqrtf(s * (1.0f / 64.0f) + EPSN);
    float g[8];
    { const f32x4 g0 = *(const f32x4*)(gain + p * 8), g1 = *(const f32x4*)(gain + p * 8 + 4);
      g[0] = g0[0]; g[1] = g0[1]; g[2] = g0[2]; g[3] = g0[3]; g[4] = g1[0]; g[5] = g1[1]; g[6] = g1[2]; g[7] = g1[3]; }
    if (do_norm) {
#pragma unroll
        for (int e = 0; e < 8; ++e) v[e] = v[e] * r * g[e];
    }
    float o[8];
#pragma unroll
    for (int e = 0; e < 8; ++e) o[e] = __shfl_xor(v[e], 1);
    if (do_norm && p < 2) {
#pragma unroll
        for (int e = 0; e < 8; ++e) {
            const f32x2 c = cs[e];
            v[e] = (p == 0) ? (v[e] * c[0] - o[e] * c[1]) : (v[e] * c[0] + o[e] * c[1]);
        }
    }
#pragma unroll
    for (int e = 0; e < 8; ++e) v[e] *= scale;
}

__device__ __forceinline__ void phase_tokpass(const Args& a) {
    unsigned char* ws = a.ws;
    const int tid = threadIdx.x, lane = tid & 63, w = tid >> 6;
    const int gw = blockIdx.x * NWV + w, nw = gridDim.x * NWV;
    const bf16_t* P = (const bf16_t*)(ws + WS_P);
    const f32x2* ropen = (const f32x2*)(ws + WS_ROPEN);
    const float* qn_gain = a.in[9];
    const float* kn_gain = a.in[10];
    for (int t = gw; t < T_TOK; t += nw) {
        const bf16_t* pr = P + (size_t)t * PLD;
        const int b = t >> 12, s = t & 4095;
        {
            const u32x2 q = *(const u32x2*)(pr + C_CQ + lane * 4);
            const unsigned kk = *(const unsigned*)(pr + C_CKV + lane * 2);
            float s1 = bflo(q.x) * bflo(q.x) + bfhi(q.x) * bfhi(q.x) + bflo(q.y) * bflo(q.y) + bfhi(q.y) * bfhi(q.y);
            float s2 = bflo(kk) * bflo(kk) + bfhi(kk) * bfhi(kk);
            s1 = wave_sum(s1); s2 = wave_sum(s2);
            if (lane == 0) { ((float*)(ws + WS_RSTDCQ))[t] = rsqrtf(s1 * (1.0f / 256.0f) + EPSN); ((float*)(ws + WS_RSTDCKV))[t] = rsqrtf(s2 * (1.0f / 128.0f) + EPSN); }
        }
        const f32x2* cs = ropen + (size_t)s * 8;
        {
            const int head = lane >> 3, p = lane & 7;
            float v[8]; unpack8(*(const u32x4*)(pr + C_QN + lane * 8), v);
            norm_rope64(v, p, qn_gain, cs, 0.125f * LOG2E, true);
            *(u32x4*)((bf16_t*)(ws + WS_QN) + ((size_t)(b * 8 + head) * SEQ + s) * 64 + p * 8) = pack8(v);
        }
        {
            const int which = lane >> 4, g = (lane >> 3) & 1, p = lane & 7;
            const int col = (which == 0 ? C_KS : which == 1 ? C_KW : which == 2 ? C_KC : C_VC) + g * 64 + p * 8;
            float v[8]; unpack8(*(const u32x4*)(pr + col), v);
            const float* gain = kn_gain + (which == 1 ? 128 : 64);
            norm_rope64(v, p, gain, cs, 1.0f, which < 2);
            bf16_t* dst = (bf16_t*)(ws + (which == 0 ? WS_KS : which == 1 ? WS_KW : which == 2 ? WS_KCIN : WS_VCIN));
            *(u32x4*)(dst + ((size_t)(b * 2 + g) * SEQ + s) * 64 + p * 8) = pack8(v);
        }
        if (lane < 24) {
            const float x = bf2f(pr[C_GATE + lane]);
            ((float*)(ws + WS_GATE))[(size_t)t * 24 + lane] = 1.0f / (1.0f + __expf(-x));
        }
    }
}

__device__ __forceinline__ void phase_mla_k(const Args& a) {
    unsigned char* ws = a.ws;
    const int tid = threadIdx.x, lane = tid & 63, w = tid >> 6;
    const int gw = blockIdx.x * NWV + w, nw = gridDim.x * NWV;
    const bf16_t* P = (const bf16_t*)(ws + WS_P);
    const bf16_t* KV = (const bf16_t*)(ws + WS_KVRAW);
    const f32x2* ropem = (const f32x2*)(ws + WS_ROPEM);
    const float* kg = a.in[8] + 96;
    const int head = lane >> 3, p = lane & 7;
    for (int t = gw; t < T_TOK; t += nw) {
        const int b = t >> 12, s = t & 4095;
        float v[8]; unpack8(*(const u32x4*)(KV + (size_t)t * 1024 + head * 128 + p * 8), v);
        const unsigned x1w = *(const unsigned*)(P + (size_t)t * PLD + C_KPE + 2 * p);
        const unsigned x2w = *(const unsigned*)(P + (size_t)t * PLD + C_KPE + 16 + 2 * p);
        float x1[2] = {bflo(x1w), bfhi(x1w)}, x2[2] = {bflo(x2w), bfhi(x2w)};
        float ss = x1[0] * x1[0] + x1[1] * x1[1] + x2[0] * x2[0] + x2[1] * x2[1];
#pragma unroll
        for (int e = 0; e < 8; ++e) ss += v[e] * v[e];
        ss += __shfl_xor(ss, 1); ss += __shfl_xor(ss, 2); ss += __shfl_xor(ss, 4);
        const float r = rsqrtf(ss * (1.0f / 96.0f) + EPSN);
#pragma unroll
        for (int e = 0; e < 8; ++e) v[e] = v[e] * r * kg[p * 8 + e];
        const f32x4 cs = *(const f32x4*)(ropem + (size_t)s * 16 + 2 * p);
        float y1[2], y2[2];
#pragma unroll
        for (int e = 0; e < 2; ++e) {
            const float a1 = x1[e] * r * kg[64 + 2 * p + e], a2 = x2[e] * r * kg[80 + 2 * p + e];
            const float c = cs[2 * e], sn = cs[2 * e + 1];
            y1[e] = a1 * c - a2 * sn; y2[e] = a2 * c + a1 * sn;
        }
        bf16_t* kp = (bf16_t*)(ws + WS_KM) + ((size_t)(b * 8 + head) * SEQ + s) * 96;
        *(u32x4*)(kp + p * 8) = pack8(v);
        *(unsigned*)(kp + 64 + 2 * p) = pack2(y1[0], y1[1]);
        *(unsigned*)(kp + 80 + 2 * p) = pack2(y2[0], y2[1]);
    }
}

__device__ __forceinline__ void phase_xa_k(const Args& a, int vb, int VG) {
    unsigned char* ws = a.ws;
    const int tid = threadIdx.x, lane = tid & 63, w = tid >> 6;
    const int gw = vb * NWV + w, nw = VG * NWV;
    const bf16_t* KVX = (const bf16_t*)(ws + WS_KVX);
    const float* kg = a.in[20] + 128;
    const int head = lane >> 4, p = lane & 15;
    for (int r = gw; r < 4096; r += nw) {
        const int b = r >> 8, m = r & 255;
        float v[8]; unpack8(*(const u32x4*)(KVX + (size_t)r * 1024 + head * 128 + p * 8), v);
        float ss = 0.f;
#pragma unroll
        for (int e = 0; e < 8; ++e) ss += v[e] * v[e];
        ss += __shfl_xor(ss, 1); ss += __shfl_xor(ss, 2); ss += __shfl_xor(ss, 4); ss += __shfl_xor(ss, 8);
        const float rr = rsqrtf(ss * (1.0f / 128.0f) + EPSN);
#pragma unroll
        for (int e = 0; e < 8; ++e) v[e] = v[e] * rr * kg[p * 8 + e];
        *(u32x4*)((bf16_t*)(ws + WS_KX) + ((size_t)(b * 4 + head) * 256 + m) * 128 + p * 8) = pack8(v);
    }
}

__device__ __forceinline__ void phase_cmp_fin(const Args& a) {
    unsigned char* ws = a.ws;
    const int tid = threadIdx.x, lane = tid & 63, w = tid >> 6;
    const int gw = blockIdx.x * NWV + w, nw = gridDim.x * NWV;
    const float* CR = (const float*)(ws + WS_CRAW);
    const f32x2* ropen = (const f32x2*)(ws + WS_ROPEN);
    const float* kg = a.in[10];
    for (int r = gw; r < 16384; r += nw) {
        const int kv = r >> 13, row = r & 8191, bg = row >> 8, n = row & 255;
        float x = CR[(size_t)r * 64 + lane];
        if (n == 255) x = 0.f;
        if (kv == 0) {
            float ss = wave_sum(x * x);
            const float rr = rsqrtf(ss * (1.0f / 64.0f) + EPSN);
            x = x * rr * kg[lane];
            const float o = __shfl_xor(x, 8);
            int pos = 16 * n + 31; if (pos > 4095) pos = 4095;
            if (lane < 16) {
                const f32x2 c = ropen[(size_t)pos * 8 + (lane & 7)];
                x = (lane < 8) ? (x * c[0] - o * c[1]) : (x * c[0] + o * c[1]);
            }
            if (n == 255) x = 0.f;
            ((bf16_t*)(ws + WS_KC))[((size_t)bg * 256 + n) * 64 + lane] = (bf16_t)f2bf(x);
        } else {
            ((bf16_t*)(ws + WS_VCT))[((size_t)bg * 64 + lane) * 256 + n] = (bf16_t)f2bf(x);
        }
    }
}

template <int KS, int DVT>
struct AttnRegs { u32x4 k[(KS * 128 + NT - 1) / NT]; u32x4 v[(DVT * 256 + NT - 1) / NT]; };

template <int KS, int DVT>
__device__ __forceinline__ void attn_prefetch(AttnRegs<KS, DVT>& R, const bf16_t* __restrict__ ktile  , const bf16_t* __restrict__ vt  , size_t ldv) {
    const int tid = threadIdx.x;
#pragma unroll
    for (int i = 0; i < (KS * 128 + NT - 1) / NT; ++i) { const int id = tid + NT * i; if (id < KS * 128) R.k[i] = *(const u32x4*)(ktile + (size_t)id * 8); }
#pragma unroll
    for (int i = 0; i < (DVT * 256 + NT - 1) / NT; ++i) { const int id = tid + NT * i; if (id < DVT * 256) R.v[i] = *(const u32x4*)(vt + (size_t)(id >> 3) * ldv + (id & 7) * 8); }
}
template <int KS, int DVT>
__device__ __forceinline__ void attn_store(const AttnRegs<KS, DVT>& R, unsigned char* kl, unsigned char* vl) {
    constexpr int KP = KS * 32 + 16;
    const int tid = threadIdx.x;
#pragma unroll
    for (int i = 0; i < (KS * 128 + NT - 1) / NT; ++i) { const int id = tid + NT * i; if (id < KS * 128) { const int row = id / (2 * KS), c = id % (2 * KS); *(u32x4*)(kl + row * KP + c * 16) = R.k[i]; } }
#pragma unroll
    for (int i = 0; i < (DVT * 256 + NT - 1) / NT; ++i) { const int id = tid + NT * i; if (id < DVT * 256) *(u32x4*)(vl + (id >> 3) * 144 + (id & 7) * 16) = R.v[i]; }
}

template <int KS>
__device__ __forceinline__ void attn_scores(const unsigned char* kl, const bf16x8 (&qf)[KS], f32x16 (&s)[2], int l31, int hh, float sinit = 0.f) {
    constexpr int KP = KS * 32 + 16;
    if (KS <= 6) {
        bf16x8 kf[2][KS];
#pragma unroll
        for (int kt2 = 0; kt2 < 2; ++kt2) {
            const unsigned char* kr = kl + (32 * kt2 + kap(l31)) * KP + hh * 16;
#pragma unroll
            for (int ks = 0; ks < KS; ++ks) kf[kt2][ks] = as_bf16x8(*(const u32x4*)(kr + ks * 32));
        }
        __builtin_amdgcn_sched_barrier(0);
#pragma unroll
        for (int kt2 = 0; kt2 < 2; ++kt2) {
#pragma unroll
            for (int r = 0; r < 16; ++r) s[kt2][r] = sinit;
#pragma unroll
            for (int ks = 0; ks < KS; ++ks) s[kt2] = MFMA32(kf[kt2][ks], qf[ks], s[kt2]);
        }
    } else {
#pragma unroll
        for (int kt2 = 0; kt2 < 2; ++kt2) {
            bf16x8 kf[KS];
            const unsigned char* kr = kl + (32 * kt2 + kap(l31)) * KP + hh * 16;
#pragma unroll
            for (int ks = 0; ks < KS; ++ks) kf[ks] = as_bf16x8(*(const u32x4*)(kr + ks * 32));
            __builtin_amdgcn_sched_barrier(0);
#pragma unroll
            for (int r = 0; r < 16; ++r) s[kt2][r] = sinit;
#pragma unroll
            for (int ks = 0; ks < KS; ++ks) s[kt2] = MFMA32(kf[ks], qf[ks], s[kt2]);
        }
    }
}

template <int KS, int DVT, bool MASKED = true, class MaskF>
__device__ __forceinline__ void flash_tile(const unsigned char* kl, const unsigned char* vl, const bf16x8 (&qf)[KS], f32x16 (&o)[DVT], float& m, float& l,
                                           int l31, int hh, MaskF valid, float sinit = 0.f) {
    f32x16 s[2];
    attn_scores<KS>(kl, qf, s, l31, hh, sinit);
    f32x2 ps2 = (f32x2){0.f, 0.f};
#pragma unroll
    for (int kt2 = 0; kt2 < 2; ++kt2) {
#pragma unroll
        for (int r = 0; r < 16; r += 2) {
            float p0 = __builtin_amdgcn_exp2f(s[kt2][r]), p1 = __builtin_amdgcn_exp2f(s[kt2][r + 1]);
            if (MASKED) {
                const int key = 32 * kt2 + 16 * (r >> 3) + 8 * hh + (r & 7);
                p0 = valid(key) ? p0 : 0.f; p1 = valid(key + 1) ? p1 : 0.f;
            }
            s[kt2][r] = p0; s[kt2][r + 1] = p1;
            ps2 += (f32x2){p0, p1};
        }
        bf16x8 pf[2];
#pragma unroll
        for (int s2 = 0; s2 < 2; ++s2) {
            u32x4 w;
            w.x = pack2(s[kt2][8 * s2 + 0], s[kt2][8 * s2 + 1]); w.y = pack2(s[kt2][8 * s2 + 2], s[kt2][8 * s2 + 3]);
            w.z = pack2(s[kt2][8 * s2 + 4], s[kt2][8 * s2 + 5]); w.w = pack2(s[kt2][8 * s2 + 6], s[kt2][8 * s2 + 7]);
            pf[s2] = as_bf16x8(w);
        }
#pragma unroll
        for (int d = 0; d < DVT; ++d) {
            const unsigned char* vr = vl + (32 * d + kap(l31)) * 144 + hh * 16 + (32 * kt2) * 2;
            const bf16x8 vf0 = as_bf16x8(*(const u32x4*)vr), vf1 = as_bf16x8(*(const u32x4*)(vr + 32));
            o[d] = MFMA32(vf0, pf[0], o[d]);
            o[d] = MFMA32(vf1, pf[1], o[d]);
        }
    }
    l += ps2[0] + ps2[1];
    (void)m;
}

template <int DVT>
__device__ __forceinline__ float flash_final(f32x16 (&o)[DVT], float l) {
    const float lt = l + __shfl_xor(l, 32);
    const float inv = lt > 0.f ? 1.0f / lt : 0.f;
#pragma unroll
    for (int d = 0; d < DVT; ++d)
#pragma unroll
        for (int r = 0; r < 16; ++r) o[d][r] *= inv;
    return inv;
}

#define ATT_K_OFF 0
#define ATT_V_OFF 17408
#define ATT_X_OFF 36864
#define ATT_MISC_OFF 103424

__device__ __forceinline__ void mla_unit(const Args& a, int b, int h, int qt, unsigned char* lds) {
    unsigned char* ws = a.ws;
    int tid_ = threadIdx.x; asm volatile("" : "+v"(tid_));
    const int tid = tid_, lane = tid & 63, w = tid >> 6, l31 = lane & 31, hh = lane >> 5;
    const int qw0 = qt * 256 + 32 * w, q = qw0 + l31;
    const size_t t = (size_t)b * SEQ + q;
    const bf16_t* kb = (const bf16_t*)(ws + WS_KM) + (size_t)(b * 8 + h) * SEQ * 96;
    const bf16_t* vb = (const bf16_t*)(ws + WS_VMT) + (size_t)(b * 8 + h) * 64 * SEQ;
    AttnRegs<6, 2> R;
    attn_prefetch<6, 2>(R, kb, vb, SEQ);
    bf16x8 qf[6];
    {
        const bf16_t* qr = (const bf16_t*)(ws + WS_QMRAW) + t * 768 + h * 96 + 8 * hh;
        const float* qg = a.in[8];
        float v[6][8]; float ss = 0.f;
#pragma unroll
        for (int ks = 0; ks < 6; ++ks) { unpack8(*(const u32x4*)(qr + 16 * ks), v[ks]);
#pragma unroll
            for (int e = 0; e < 8; ++e) ss += v[ks][e] * v[ks][e]; }
        ss += __shfl_xor(ss, 32);
        const float r = rsqrtf(ss * (1.0f / 96.0f) + EPSN);
#pragma unroll
        for (int ks = 0; ks < 6; ++ks)
#pragma unroll
            for (int e = 0; e < 8; ++e) v[ks][e] = v[ks][e] * r * qg[16 * ks + 8 * hh + e];
        const f32x2* cs = (const f32x2*)(ws + WS_ROPEM) + (size_t)q * 16 + 8 * hh;
#pragma unroll
        for (int e = 0; e < 8; ++e) {
            const f32x2 c = cs[e]; const float x1 = v[4][e], x2 = v[5][e];
            v[4][e] = x1 * c[0] - x2 * c[1]; v[5][e] = x2 * c[0] + x1 * c[1];
        }
        const float sc = 0.10206207261596577f * LOG2E;
#pragma unroll
        for (int ks = 0; ks < 6; ++ks) {
#pragma unroll
            for (int e = 0; e < 8; ++e) v[ks][e] *= sc;
            qf[ks] = as_bf16x8(pack8(v[ks]));
        }
    }
    f32x16 o[2];
#pragma unroll
    for (int d = 0; d < 2; ++d)
#pragma unroll
        for (int r = 0; r < 16; ++r) o[d][r] = 0.f;
    float m = -1e30f, l = 0.f;
    const int nkt = 4 * qt + 4;
    __syncthreads();
    attn_store<6, 2>(R, lds, lds + 13312);
    __syncthreads();
    for (int it = 0; it < nkt; ++it) {
        const int k0 = it * 64;
        const unsigned char* klc = lds + (it & 1) * 22528; const unsigned char* vlc = klc + 13312;
        if (it + 1 < nkt) attn_prefetch<6, 2>(R, kb + (size_t)(k0 + 64) * 96, vb + k0 + 64, SEQ);
        if (k0 + 63 <= qw0)
            flash_tile<6, 2, false>(klc, vlc, qf, o, m, l, l31, hh, [&](int) { return true; });
        else if (k0 <= qw0 + 31)
            flash_tile<6, 2>(klc, vlc, qf, o, m, l, l31, hh, [&](int key) { return k0 + key <= q; });
        if (it + 1 < nkt) attn_store<6, 2>(R, lds + ((it + 1) & 1) * 22528, lds + ((it + 1) & 1) * 22528 + 13312);
        __syncthreads();
    }
    flash_final<2>(o, l);
    {
        float sq = 0.f;
#pragma unroll
        for (int d = 0; d < 2; ++d)
#pragma unroll
            for (int r = 0; r < 16; ++r) sq += o[d][r] * o[d][r];
        sq += __shfl_xor(sq, 32);
        if (hh == 0) ((float*)(ws + WS_SSQ))[t * 16 + h] = sq;
    }
    bf16_t* op = (bf16_t*)(ws + WS_OMIX) + t * 1024 + h * 64 + 8 * hh;
#pragma unroll
    for (int d = 0; d < 2; ++d)
#pragma unroll
        for (int j = 0; j < 2; ++j) {
            float v[8];
#pragma unroll
            for (int e = 0; e < 8; ++e) v[e] = o[d][8 * j + e];
            *(u32x4*)(op + 32 * d + 16 * j) = pack8(v);
        }
}


#define PS_PITCH 260
__device__ __forceinline__ void nsa_unit(const Args& a, int b, int g, int j, unsigned char* lds) {
    unsigned char* ws = a.ws;
    int tid_ = threadIdx.x; asm volatile("" : "+v"(tid_));
    const int tid = tid_, lane = tid & 63, w = tid >> 6, l31 = lane & 31, hh = lane >> 5;
    const int posl = lane & 7, r4 = (lane >> 3) & 3;
    const int s0 = 64 * j, qpos = s0 + 8 * w + posl, hq = 4 * g + r4, bg = b * 2 + g;
    const size_t t = (size_t)b * SEQ + qpos;
    const int cur = j;
    unsigned char* kl = lds; unsigned char* vl = lds + 9216;
    float* psum = (float*)(lds + ATT_X_OFF);
    AttnRegs<4, 2> R;
    const int ntc = (4 * j + 2) / 64 + 1;
    const bf16_t* kcb = (const bf16_t*)(ws + WS_KC) + (size_t)bg * 256 * 64;
    const bf16_t* vcb = (const bf16_t*)(ws + WS_VCT) + (size_t)bg * 64 * 256;
    attn_prefetch<4, 2>(R, kcb, vcb, 256);
    bf16x8 qf[4];
    {
        const bf16_t* qr = (const bf16_t*)(ws + WS_QN) + ((size_t)(b * 8 + hq) * SEQ + qpos) * 64 + 8 * hh;
#pragma unroll
        for (int ks = 0; ks < 4; ++ks) qf[ks] = as_bf16x8(*(const u32x4*)(qr + 16 * ks));
    }
    const float* gate = (const float*)(ws + WS_GATE) + t * 24 + hq * 3;
    const float g_c = gate[0], g_s = gate[1], g_w = gate[2];
    f32x16 acc[2];
#pragma unroll
    for (int d = 0; d < 2; ++d)
#pragma unroll
        for (int r = 0; r < 16; ++r) acc[d][r] = 0.f;
    float m_c, inv_c;
    {
        f32x16 o[2];
#pragma unroll
        for (int d = 0; d < 2; ++d)
#pragma unroll
            for (int r = 0; r < 16; ++r) o[d][r] = 0.f;
        float m = -1e30f, l = 0.f;
        __syncthreads();
        attn_store<4, 2>(R, kl, vl);
        __syncthreads();
        for (int it = 0; it < ntc; ++it) {
            const int k0 = it * 64;
            const unsigned char* klc = kl + (it & 1) * 18432; const unsigned char* vlc = klc + 9216;
            if (it + 1 < ntc) attn_prefetch<4, 2>(R, kcb + (size_t)(k0 + 64) * 64, vcb + k0 + 64, 256);
            flash_tile<4, 2>(klc, vlc, qf, o, m, l, l31, hh, [&](int key) { return 16 * (k0 + key) + 31 <= qpos; });
            if (it + 1 < ntc) attn_store<4, 2>(R, kl + ((it + 1) & 1) * 18432, kl + ((it + 1) & 1) * 18432 + 9216);
            __syncthreads();
        }
        inv_c = flash_final<2>(o, l); m_c = m;
#pragma unroll
        for (int d = 0; d < 2; ++d)
#pragma unroll
            for (int r = 0; r < 16; ++r) acc[d][r] += g_c * o[d][r];
    }
    {
        attn_prefetch<4, 2>(R, kcb, vcb, 256);
        __syncthreads();
        attn_store<4, 2>(R, kl, vl);
        __syncthreads();
        for (int it = 0; it < ntc; ++it) {
            const int k0 = it * 64;
            const unsigned char* klc = kl + (it & 1) * 18432;
            if (it + 1 < ntc) attn_prefetch<4, 2>(R, kcb + (size_t)(k0 + 64) * 64, vcb + k0 + 64, 256);
            f32x16 s[2];
            attn_scores<4>(klc, qf, s, l31, hh);
#pragma unroll
            for (int kt2 = 0; kt2 < 2; ++kt2)
#pragma unroll
                for (int r = 0; r < 16; ++r) {
                    const int key = 32 * kt2 + 16 * (r >> 3) + 8 * hh + (r & 7);
                    const bool ok = 16 * (k0 + key) + 31 <= qpos;
                    float p = ok ? __builtin_amdgcn_exp2f(s[kt2][r]) * inv_c : 0.f;
                    p += __shfl_xor(p, 8); p += __shfl_xor(p, 16);
                    s[kt2][r] = p;
                }
            if (r4 == 0) {
                float* pr = psum + (8 * w + posl) * PS_PITCH + k0 + 8 * hh;
#pragma unroll
                for (int kt2 = 0; kt2 < 2; ++kt2)
#pragma unroll
                    for (int j2 = 0; j2 < 2; ++j2) {
                        *(f32x4*)(pr + 32 * kt2 + 16 * j2) = (f32x4){s[kt2][8 * j2 + 0], s[kt2][8 * j2 + 1], s[kt2][8 * j2 + 2], s[kt2][8 * j2 + 3]};
                        *(f32x4*)(pr + 32 * kt2 + 16 * j2 + 4) = (f32x4){s[kt2][8 * j2 + 4], s[kt2][8 * j2 + 5], s[kt2][8 * j2 + 6], s[kt2][8 * j2 + 7]};
                    }
            }
            if (it + 1 < ntc) attn_store<4, 2>(R, kl + ((it + 1) & 1) * 18432, kl + ((it + 1) & 1) * 18432 + 9216);
            __syncthreads();
        }
    }
    __syncthreads();
    unsigned long long mymask, unionmask;
    {
        const int mg = lane >> 3;
        float* impb = (float*)kl + (w * 8 + posl) * 64;
        const float* pr = psum + (8 * w + posl) * PS_PITCH;
        const int nvis = (64 * ntc < 255) ? 64 * ntc : 255;
        float imp[8];
#pragma unroll
        for (int e = 0; e < 8; ++e) {
            const int m = mg * 8 + e;
            float sacc = 0.f;
#pragma unroll
            for (int d = -1; d <= 3; ++d) { const int n = 4 * m + d; if (n >= 0 && n < nvis) sacc += pr[n]; }
            imp[e] = sacc; impb[m] = sacc;
        }
        __syncthreads();
        int cnt[8];
#pragma unroll
        for (int e = 0; e < 8; ++e) cnt[e] = 0;
        const float* ib = (const float*)kl + (w * 8 + posl) * 64;
        for (int mp = 1; mp <= cur - 2; ++mp) {
            const float v = ib[mp];
#pragma unroll
            for (int e = 0; e < 8; ++e) { const int m = mg * 8 + e; cnt[e] += ((v > imp[e]) || (v == imp[e] && mp < m)) ? 1 : 0; }
        }
        const int nf = cur == 0 ? 1 : (cur == 1 ? 2 : 3);
        const int nsel = 16 - nf;
        unsigned m8 = 0;
#pragma unroll
        for (int e = 0; e < 8; ++e) {
            const int m = mg * 8 + e;
            const bool forced = (m == 0) || (m == cur) || (m == cur - 1);
            const bool sel = (m <= cur) && (forced || (m >= 1 && m <= cur - 2 && cnt[e] < nsel));
            m8 |= sel ? (1u << e) : 0u;
        }
        unsigned lo = (mg < 4) ? (m8 << (8 * mg)) : 0u, hi = (mg >= 4) ? (m8 << (8 * (mg - 4))) : 0u;
        lo |= __shfl_xor(lo, 8); hi |= __shfl_xor(hi, 8);
        lo |= __shfl_xor(lo, 16); hi |= __shfl_xor(hi, 16);
        lo |= __shfl_xor(lo, 32); hi |= __shfl_xor(hi, 32);
        mymask = ((unsigned long long)hi << 32) | lo;
        unsigned ulo = lo, uhi = hi;
        ulo |= __shfl_xor(ulo, 1); uhi |= __shfl_xor(uhi, 1);
        ulo |= __shfl_xor(ulo, 2); uhi |= __shfl_xor(uhi, 2);
        ulo |= __shfl_xor(ulo, 4); uhi |= __shfl_xor(uhi, 4);
        unsigned* misc = (unsigned*)(lds + ATT_MISC_OFF);
        if (lane == 0) { misc[2 * w] = ulo; misc[2 * w + 1] = uhi; }
        __syncthreads();
        ulo = misc[0] | misc[2] | misc[4] | misc[6] | misc[8] | misc[10] | misc[12] | misc[14]; uhi = misc[1] | misc[3] | misc[5] | misc[7] | misc[9] | misc[11] | misc[13] | misc[15];
        unionmask = ((unsigned long long)uhi << 32) | ulo;
    }
    {
        f32x16 o[2];
#pragma unroll
        for (int d = 0; d < 2; ++d)
#pragma unroll
            for (int r = 0; r < 16; ++r) o[d][r] = 0.f;
        float m = -1e30f, l = 0.f;
        const bf16_t* kb = (const bf16_t*)(ws + WS_KS) + (size_t)bg * SEQ * 64;
        const bf16_t* vb = (const bf16_t*)(ws + WS_VST) + (size_t)bg * 64 * SEQ;
        unsigned long long rem = unionmask;
        int mb = __builtin_ctzll(rem); rem &= rem - 1;
        attn_prefetch<4, 2>(R, kb + (size_t)mb * 64 * 64, vb + mb * 64, SEQ);
        __syncthreads();
        attn_store<4, 2>(R, kl, vl);
        __syncthreads();
        int cbuf = 0;
        for (;;) {
            const int k0 = mb * 64;
            const bool more = rem != 0ull;
            int mnext = 0;
            if (more) { mnext = __builtin_ctzll(rem); rem &= rem - 1; }
            const unsigned char* klc = kl + cbuf * 18432; const unsigned char* vlc = klc + 9216;
            if (more) attn_prefetch<4, 2>(R, kb + (size_t)mnext * 64 * 64, vb + mnext * 64, SEQ);
            const bool mine = (mymask >> mb) & 1ull;
            if (mb < cur) {
                if (__all(mine)) flash_tile<4, 2, false>(klc, vlc, qf, o, m, l, l31, hh, [&](int) { return true; });
                else if (__any(mine)) flash_tile<4, 2, false>(klc, vlc, qf, o, m, l, l31, hh, [&](int) { return true; }, mine ? 0.f : -1e30f);
            } else
                flash_tile<4, 2>(klc, vlc, qf, o, m, l, l31, hh, [&](int key) { return mine && (k0 + key <= qpos); });
            if (more) attn_store<4, 2>(R, kl + (cbuf ^ 1) * 18432, kl + (cbuf ^ 1) * 18432 + 9216);
            __syncthreads();
            if (!more) break;
            mb = mnext; cbuf ^= 1;
        }
        flash_final<2>(o, l);
#pragma unroll
        for (int d = 0; d < 2; ++d)
#pragma unroll
            for (int r = 0; r < 16; ++r) acc[d][r] += g_s * o[d][r];
    }
    {
        f32x16 o[2];
#pragma unroll
        for (int d = 0; d < 2; ++d)
#pragma unroll
            for (int r = 0; r < 16; ++r) o[d][r] = 0.f;
        float m = -1e30f, l = 0.f;
        const bf16_t* kb = (const bf16_t*)(ws + WS_KW) + (size_t)bg * SEQ * 64;
        const bf16_t* vb = (const bf16_t*)(ws + WS_VWT) + (size_t)bg * 64 * SEQ;
        const int lo = s0 - 511;
        const int m0 = lo <= 0 ? 0 : (lo >> 6);
        attn_prefetch<4, 2>(R, kb + (size_t)m0 * 64 * 64, vb + m0 * 64, SEQ);
        __syncthreads();
        attn_store<4, 2>(R, kl, vl);
        __syncthreads();
        for (int mb = m0; mb <= cur; ++mb) {
            const int k0 = mb * 64;
            const int cb2 = (mb - m0) & 1;
            const unsigned char* klc = kl + cb2 * 18432; const unsigned char* vlc = klc + 9216;
            if (mb + 1 <= cur) attn_prefetch<4, 2>(R, kb + (size_t)(mb + 1) * 64 * 64, vb + (mb + 1) * 64, SEQ);
            if (k0 + 63 <= s0 + 8 * w && s0 + 8 * w + 7 - k0 < 512)
                flash_tile<4, 2, false>(klc, vlc, qf, o, m, l, l31, hh, [&](int) { return true; });
            else
                flash_tile<4, 2>(klc, vlc, qf, o, m, l, l31, hh, [&](int key) { const int kp = k0 + key; return (kp <= qpos) && (qpos - kp < 512); });
            if (mb + 1 <= cur) attn_store<4, 2>(R, kl + (cb2 ^ 1) * 18432, kl + (cb2 ^ 1) * 18432 + 9216);
            __syncthreads();
        }
        flash_final<2>(o, l);
#pragma unroll
        for (int d = 0; d < 2; ++d)
#pragma unroll
            for (int r = 0; r < 16; ++r) acc[d][r] += g_w * o[d][r];
    }
    {
        float sq = 0.f;
#pragma unroll
        for (int d = 0; d < 2; ++d)
#pragma unroll
            for (int r = 0; r < 16; ++r) sq += acc[d][r] * acc[d][r];
        sq += __shfl_xor(sq, 32);
        if (hh == 0) ((float*)(ws + WS_SSQ))[t * 16 + 8 + hq] = sq;
    }
    bf16_t* op = (bf16_t*)(ws + WS_OMIX) + t * 1024 + 512 + hq * 64 + 8 * hh;
#pragma unroll
    for (int d = 0; d < 2; ++d)
#pragma unroll
        for (int j2 = 0; j2 < 2; ++j2) {
            float v[8];
#pragma unroll
            for (int e = 0; e < 8; ++e) v[e] = acc[d][8 * j2 + e];
            *(u32x4*)(op + 32 * d + 16 * j2) = pack8(v);
        }
}


__device__ __forceinline__ void xa_unit(const Args& a, int b, int head, int qt, unsigned char* lds) {
    unsigned char* ws = a.ws;
    int tid_ = threadIdx.x; asm volatile("" : "+v"(tid_));
    const int tid = tid_, lane = tid & 63, w = tid >> 6, l31 = lane & 31, hh = lane >> 5;
    const int q = qt * 256 + 32 * w + l31;
    const size_t t = (size_t)b * SEQ + q;
    unsigned char* kl = lds + ATT_K_OFF; unsigned char* vl = lds + ATT_V_OFF;
    bf16x8 qf[8];
    {
        const bf16_t* qr = (const bf16_t*)(ws + WS_QX) + t * 512 + head * 128 + 8 * hh;
        const float* qg = a.in[20];
        float ss = 0.f;
        u32x4 raw[8];
#pragma unroll
        for (int ks = 0; ks < 8; ++ks) { raw[ks] = *(const u32x4*)(qr + 16 * ks); float v[8]; unpack8(raw[ks], v);
#pragma unroll
            for (int e = 0; e < 8; ++e) ss += v[e] * v[e]; }
        ss += __shfl_xor(ss, 32);
        const float r = rsqrtf(ss * (1.0f / 128.0f) + EPSN) * 0.08838834764831845f * LOG2E;
#pragma unroll
        for (int ks = 0; ks < 8; ++ks) { float v[8]; unpack8(raw[ks], v);
#pragma unroll
            for (int e = 0; e < 8; ++e) v[e] = v[e] * r * qg[16 * ks + 8 * hh + e];
            qf[ks] = as_bf16x8(pack8(v)); }
    }
    f32x16 o[4];
#pragma unroll
    for (int d = 0; d < 4; ++d)
#pragma unroll
        for (int r = 0; r < 16; ++r) o[d][r] = 0.f;
    float m = -1e30f, l = 0.f;
    const bf16_t* kb = (const bf16_t*)(ws + WS_KX) + (size_t)(b * 4 + head) * 256 * 128;
    const bf16_t* vb = (const bf16_t*)(ws + WS_VXT) + (size_t)(b * 4 + head) * 128 * 256;
#pragma unroll 1
    for (int it = 0; it < 4; ++it) {
        const int k0 = it * 64;
        __syncthreads();
        { AttnRegs<8, 4> R; attn_prefetch<8, 4>(R, kb + (size_t)k0 * 128, vb + k0, 256); attn_store<8, 4>(R, kl, vl); }
        __syncthreads();
        flash_tile<8, 4, false>(kl, vl, qf, o, m, l, l31, hh, [&](int) { return true; });
    }
    flash_final<4>(o, l);
    bf16_t* op = (bf16_t*)(ws + WS_OX) + t * 512 + head * 128 + 8 * hh;
#pragma unroll
    for (int d = 0; d < 4; ++d)
#pragma unroll
        for (int j2 = 0; j2 < 2; ++j2) {
            float v[8];
#pragma unroll
            for (int e = 0; e < 8; ++e) v[e] = o[d][8 * j2 + e];
            *(u32x4*)(op + 32 * d + 16 * j2) = pack8(v);
        }
}

__device__ __forceinline__ int f2ord(float x) { const int b = __float_as_int(x); return b ^ ((b >> 31) & 0x7FFFFFFF); }
__device__ __forceinline__ float ord2f(int k) { return __int_as_float(k ^ ((k >> 31) & 0x7FFFFFFF)); }
#define IMIN ((int)0x80000000)

#define CEX_DESC(a_, b_) do { const int hi_ = max((a_), (b_)), lo_ = min((a_), (b_)); (a_) = hi_; (b_) = lo_; } while (0)
__device__ __forceinline__ void bitonic_sort_desc16(int (&a)[16]) {
#pragma unroll
    for (int k = 2; k <= 16; k <<= 1)
#pragma unroll
        for (int j = k >> 1; j > 0; j >>= 1)
#pragma unroll
            for (int i = 0; i < 16; ++i) {
                const int l = i ^ j;
                if (l > i) { if ((i & k) == 0) CEX_DESC(a[i], a[l]); else CEX_DESC(a[l], a[i]); }
            }
}
__device__ __forceinline__ void merge_top16(int (&a)[16], const int (&b)[16]) {
#pragma unroll
    for (int i = 0; i < 16; ++i) a[i] = max(a[i], b[15 - i]);
#pragma unroll
    for (int j = 8; j > 0; j >>= 1)
#pragma unroll
        for (int i = 0; i < 16; ++i) { const int l = i ^ j; if (l > i) CEX_DESC(a[i], a[l]); }
}
__device__ __forceinline__ void peer_top16_of_128(const bf16_t* __restrict__ kp  , const bf16x8 (&qf)[4]  , int (&lst)[16], int l31, int hh) {
    int key[4][16];
#pragma unroll
    for (int kt = 0; kt < 4; ++kt) {
        f32x16 s;
#pragma unroll
        for (int r = 0; r < 16; ++r) s[r] = 0.f;
        const bf16_t* kr = kp + (size_t)(32 * kt + kap(l31)) * 64 + 8 * hh;
#pragma unroll
        for (int ks = 0; ks < 4; ++ks) { const bf16x8 kf = as_bf16x8(*(const u32x4*)(kr + 16 * ks)); s = MFMA32(kf, qf[ks], s); }
#pragma unroll
        for (int r = 0; r < 16; ++r) {
            const int idx = 32 * kt + 16 * (r >> 3) + 8 * hh + (r & 7);
            key[kt][r] = (__float_as_int(s[r] + 64.0f) & ~0x7F) | (127 - idx);
        }
    }
    bitonic_sort_desc16(key[0]); bitonic_sort_desc16(key[1]); bitonic_sort_desc16(key[2]); bitonic_sort_desc16(key[3]);
    merge_top16(key[0], key[1]); merge_top16(key[2], key[3]); merge_top16(key[0], key[2]);
#pragma unroll
    for (int i = 0; i < 16; ++i) lst[i] = key[0][i];
}

__device__ __forceinline__ void phase_peer_route(const Args& a) {
    unsigned char* ws = a.ws;
    int tid_ = threadIdx.x; asm volatile("" : "+v"(tid_));
    const int tid = tid_, lane = tid & 63, w = tid >> 6, l31 = lane & 31, hh = lane >> 5;
    const int gw = blockIdx.x * NWV + w, nw = gridDim.x * NWV;
    const bf16_t* QP = (const bf16_t*)(ws + WS_QP);
    const bf16_t* KP = (const bf16_t*)(ws + WS_KP);
    int* EIDX = (int*)(ws + WS_EIDX);
    float* EG = (float*)(ws + WS_EG);
    for (int it = gw; it < (T_TOK / 32) * 4; it += nw) {
        const int hp = it & 3, t = (it >> 2) * 32 + l31;
        const int h = 2 * hp + hh;
        int l1[16], l2[16];
        bf16x8 qA0[4], qB0[4], qA1[4], qB1[4];
        {
            const bf16_t* qr = QP + (size_t)t * 1024 + (2 * hp) * 128 + 8 * hh;
#pragma unroll
            for (int ks = 0; ks < 4; ++ks) {
                qA0[ks] = as_bf16x8(*(const u32x4*)(qr + 16 * ks)); qA1[ks] = as_bf16x8(*(const u32x4*)(qr + 64 + 16 * ks));
                qB0[ks] = as_bf16x8(*(const u32x4*)(qr + 128 + 16 * ks)); qB1[ks] = as_bf16x8(*(const u32x4*)(qr + 192 + 16 * ks));
            }
        }
        {
            int pA[16], pB[16];
            peer_top16_of_128(KP + (size_t)((2 * hp) * 2 + 0) * 128 * 64, qA0, pA, l31, hh);
            peer_top16_of_128(KP + (size_t)((2 * hp + 1) * 2 + 0) * 128 * 64, qB0, pB, l31, hh);
#pragma unroll
            for (int i = 0; i < 16; ++i) { const u32x2 sw = __builtin_amdgcn_permlane32_swap((unsigned)pA[i], (unsigned)pB[i], false, false); l1[i] = (int)sw.x; pB[i] = (int)sw.y; }
            merge_top16(l1, pB);
        }
        {
            int pA[16], pB[16];
            peer_top16_of_128(KP + (size_t)((2 * hp) * 2 + 1) * 128 * 64, qA1, pA, l31, hh);
            peer_top16_of_128(KP + (size_t)((2 * hp + 1) * 2 + 1) * 128 * 64, qB1, pB, l31, hh);
#pragma unroll
            for (int i = 0; i < 16; ++i) { const u32x2 sw = __builtin_amdgcn_permlane32_swap((unsigned)pA[i], (unsigned)pB[i], false, false); l2[i] = (int)sw.x; pB[i] = (int)sw.y; }
            merge_top16(l2, pB);
        }
        float f1[16], f2[16];
        unsigned i1p[4] = {0u, 0u, 0u, 0u}, i2p[4] = {0u, 0u, 0u, 0u};
#pragma unroll
        for (int i = 0; i < 16; ++i) {
            f1[i] = __int_as_float(l1[i] & ~0x7F); f2[i] = __int_as_float(l2[i] & ~0x7F) - 64.0f;
            i1p[i >> 2] |= (unsigned)(127 - (l1[i] & 0x7F)) << (8 * (i & 3));
            i2p[i >> 2] |= (unsigned)(127 - (l2[i] & 0x7F)) << (8 * (i & 3));
        }
        int cg[4][16];
#pragma unroll
        for (int gq = 0; gq < 4; ++gq)
#pragma unroll
            for (int i = 0; i < 16; ++i) cg[gq][i] = IMIN;
        {
            int n0 = 0, n1 = 0, n2 = 0, n3 = 0;
#pragma unroll
            for (int ca = 0; ca < 16; ++ca)
#pragma unroll
                for (int cb = 0; cb < 16; ++cb)
                    if ((ca + 1) * (cb + 1) <= 16) {
                        const int kc = (__float_as_int(f1[ca] + f2[cb]) & ~0xFF) | (255 - (ca * 16 + cb));
                        if (ca == 0) { cg[0][n0] = kc; ++n0; }
                        else if (ca <= 2) { cg[1][n1] = kc; ++n1; }
                        else if (ca <= 7) { cg[2][n2] = kc; ++n2; }
                        else { cg[3][n3] = kc; ++n3; }
                    }
        }
        bitonic_sort_desc16(cg[1]); bitonic_sort_desc16(cg[2]); bitonic_sort_desc16(cg[3]);
        merge_top16(cg[0], cg[1]); merge_top16(cg[2], cg[3]); merge_top16(cg[0], cg[2]);
        float tv[16]; int te[16];
#pragma unroll
        for (int rd = 0; rd < 16; ++rd) {
            const int mx = cg[0][rd];
            const int code = 255 - (mx & 0xFF), ca = code >> 4, cb = code & 15;
            const unsigned wa = (ca >> 2) == 0 ? i1p[0] : (ca >> 2) == 1 ? i1p[1] : (ca >> 2) == 2 ? i1p[2] : i1p[3];
            const unsigned wb = (cb >> 2) == 0 ? i2p[0] : (cb >> 2) == 1 ? i2p[1] : (cb >> 2) == 2 ? i2p[2] : i2p[3];
            const int i1 = (wa >> (8 * (ca & 3))) & 0xFF, i2 = (wb >> (8 * (cb & 3))) & 0xFF;
            te[rd] = i1 * 128 + i2;
            tv[rd] = __int_as_float(mx & ~0xFF);
        }
        {
            const float t0 = tv[0];
            float den = 0.f;
#pragma unroll
            for (int i = 0; i < 16; ++i) { tv[i] = __expf(tv[i] - t0); den += tv[i]; }
            const float rden = 1.0f / den;
#pragma unroll
            for (int i = 0; i < 16; ++i) tv[i] *= rden;
        }
        {
            int* ep = EIDX + (size_t)t * 128 + h * 16;
            float* gp = EG + (size_t)t * 128 + h * 16;
#pragma unroll
            for (int i = 0; i < 16; i += 4) {
                *(int __attribute__((ext_vector_type(4)))*)(ep + i) = (int __attribute__((ext_vector_type(4)))){te[i], te[i + 1], te[i + 2], te[i + 3]};
                *(f32x4*)(gp + i) = (f32x4){tv[i], tv[i + 1], tv[i + 2], tv[i + 3]};
            }
        }
    }
}

#define QCTR_WORD(ph, j) (3520 + ((ph) * 8 + (j)) * 16)
#define PEER_CHUNK_TOK 32
typedef __bf16 bf2_t __attribute__((ext_vector_type(2)));
__device__ __forceinline__ float dot2bf(unsigned a, unsigned b, float c) {
    union { unsigned u; bf2_t v; } x, y; x.u = a; y.u = b;
    return __builtin_amdgcn_fdot2_f32_bf16(x.v, y.v, c, false);
}
__device__ __forceinline__ float row16_sum(float v) { v = DPP_ROR_ADD(v, 8); v = DPP_ROR_ADD(v, 4); v = DPP_ROR_ADD(v, 2); v = DPP_ROR_ADD(v, 1); return v; }
__device__ __forceinline__ int queue_grab(unsigned* ctr, volatile int* slot) {
    __syncthreads();
    if (threadIdx.x == 0) *slot = (int)__hip_atomic_fetch_add(ctr, 1u, __ATOMIC_RELAXED, __HIP_MEMORY_SCOPE_AGENT);
    __syncthreads();
    return *slot;
}

#define DPP_ADD(v, ctrl) ((v) + __builtin_bit_cast(float, __builtin_amdgcn_update_dpp(0, __builtin_bit_cast(int, (v)), (ctrl), 0xf, 0xf, false)))
template <int WHICH>
__device__ __forceinline__ void phase_peer_sliced(const Args& a, unsigned char* lds, int qph, bool dry) {
    unsigned char* ws = a.ws;
    int tid_ = threadIdx.x; asm volatile("" : "+v"(tid_));
    const int tid = tid_, lane = tid & 63, c8 = lane & 7, g8 = lane >> 3;
    const int w = __builtin_amdgcn_readfirstlane(tid >> 6);
    const bf16_t* H2B = (const bf16_t*)(ws + WS_H2B);
    const int* EIDX = (const int*)(ws + WS_EIDX);
    const unsigned* W32 = (const unsigned*)(ws + WS_EG);
    float* PART = (float*)(ws + WS_PART);
    unsigned* bar = (unsigned*)(ws + WS_BAR);
    volatile int* slot = (volatile int*)(lds + LDS_BYTES - 32);
    const int myx = (int)(xb_xcc_id() & 7u);
    for (int qq = 0; qq < 8; ++qq) {
        const int j = (myx + qq) & 7;
        const unsigned char* TB = ws + (WHICH == 0 ? WS_UB : WS_VB) + (size_t)j * 16384 * 128;
        const unsigned lofs = (unsigned)c8 * 16u;
        for (;;) {
            int ch = 0;
            if (lane == 0) ch = (int)__hip_atomic_fetch_add(bar + QCTR_WORD(qph, j), 1u, __ATOMIC_RELAXED, __HIP_MEMORY_SCOPE_AGENT);
            ch = __builtin_amdgcn_readfirstlane(ch);
            if (ch >= T_TOK / (PEER_CHUNK_TOK / 4)) break;
            const int tbase = ch * (PEER_CHUNK_TOK / 4);
            constexpr int NTOK = PEER_CHUNK_TOK / 4;
            if (WHICH == 0) {
#define E1_ISSUE(ud_, esrc_) do { \
                    _Pragma("unroll") for (int i = 0; i < 8; ++i) { \
                        const int idx = __shfl(esrc_, 8 * i + g8); \
                        ud_[i] = *(const u32x4*)(TB + ((unsigned)idx * 128u + lofs)); } } while (0)
#define E1_DOT(ud_, res_) do { \
                    _Pragma("unroll") for (int i = 0; i < 8; ++i) { \
                        int d = __builtin_amdgcn_sdot4((int)ud_[i].x, hq[0], 0, false); \
                        d = __builtin_amdgcn_sdot4((int)ud_[i].y, hq[1], d, false); \
                        d = __builtin_amdgcn_sdot4((int)ud_[i].z, hq[2], d, false); \
                        d = __builtin_amdgcn_sdot4((int)ud_[i].w, hq[3], d, false); \
                        d += __builtin_amdgcn_update_dpp(0, d, 0xB1, 0xf, 0xf, false); \
                        d += __builtin_amdgcn_update_dpp(0, d, 0x4E, 0xf, 0xf, false); \
                        d += __builtin_amdgcn_update_dpp(0, d, 0x141, 0xf, 0xf, false); \
                        if (c8 == i) res_ = d; } } while (0)
                int e0 = EIDX[(size_t)tbase * 128 + lane], e1 = EIDX[(size_t)tbase * 128 + 64 + lane];
                const unsigned char* H2Q = ws + WS_H2Q;
                u32x4 h0 = *(const u32x4*)(H2Q + (size_t)tbase * 1024 + j * 128 + c8 * 16);
                u32x4 udA[8], udB[8];
                E1_ISSUE(udA, e0);
#pragma unroll 1
                for (int tt = 0; tt < NTOK; ++tt) {
                    const int t = tbase + tt;
                    E1_ISSUE(udB, e1);
                    const int hq[4] = {(int)h0.x, (int)h0.y, (int)h0.z, (int)h0.w};
                    if (tt + 1 < NTOK) {
                        e0 = EIDX[(size_t)(t + 1) * 128 + lane]; e1 = EIDX[(size_t)(t + 1) * 128 + 64 + lane];
                        h0 = *(const u32x4*)(H2Q + (size_t)(t + 1) * 1024 + j * 128 + c8 * 16);
                    }
                    int res0 = 0, res1 = 0;
                    E1_DOT(udA, res0);
                    if (tt + 1 < NTOK) E1_ISSUE(udA, e0);
                    E1_DOT(udB, res1);
                    int* pp = (int*)PART + ((size_t)j * T_TOK + t) * 128 + 8 * c8 + g8;
                    pp[0] = res0; pp[64] = res1;
                }
#undef E1_ISSUE
#undef E1_DOT
            } else {
#define E3_ISSUE(vd_, wk_, wsrc_) do { \
                    _Pragma("unroll") for (int i = 0; i < 8; ++i) { \
                        const unsigned pk = (unsigned)__shfl((int)(wsrc_), 8 * i + g8); \
                        wk_[i] = __uint_as_float(pk & 0xFFFF0000u); \
                        vd_[i] = *(const u32x4*)(TB + ((pk & 0xFFFFu) * 128u + lofs)); } } while (0)
#define E3_FMA(vd_, wk_) do { \
                    _Pragma("unroll") for (int i = 0; i < 8; ++i) { \
                        _Pragma("unroll") for (int q = 0; q < 4; ++q) { \
                            const f32x2 lo = __builtin_amdgcn_cvt_pk_f32_fp8((int)vd_[i][q], false), hi = __builtin_amdgcn_cvt_pk_f32_fp8((int)vd_[i][q], true); \
                            acc[4 * q] += wk_[i] * lo[0]; acc[4 * q + 1] += wk_[i] * lo[1]; acc[4 * q + 2] += wk_[i] * hi[0]; acc[4 * q + 3] += wk_[i] * hi[1]; } } } while (0)
                unsigned wa = W32[(size_t)tbase * 128 + lane], wb = W32[(size_t)tbase * 128 + 64 + lane];
                u32x4 vdA[8], vdB[8]; float wkA[8], wkB[8];
                E3_ISSUE(vdA, wkA, wa);
#pragma unroll 1
                for (int tt = 0; tt < NTOK; ++tt) {
                    const int t = tbase + tt;
                    E3_ISSUE(vdB, wkB, wb);
                    if (tt + 1 < NTOK) { wa = W32[(size_t)(t + 1) * 128 + lane]; wb = W32[(size_t)(t + 1) * 128 + 64 + lane]; }
                    u32x4 hr0, hr1;
                    if (!dry && g8 == 0) { const bf16_t* hp = H2B + (size_t)t * 1024 + j * 128 + c8 * 16; hr0 = *(const u32x4*)hp; hr1 = *(const u32x4*)(hp + 8); }
                    float acc[16];
#pragma unroll
                    for (int e = 0; e < 16; ++e) acc[e] = 0.f;
                    E3_FMA(vdA, wkA);
                    if (tt + 1 < NTOK) E3_ISSUE(vdA, wkA, wa);
                    E3_FMA(vdB, wkB);
#pragma unroll
                    for (int e = 0; e < 16; ++e) { acc[e] = DPP_ADD(acc[e], 0x128); acc[e] += __shfl_xor(acc[e], 16); acc[e] += __shfl_xor(acc[e], 32); }
                    if (dry) {
#pragma unroll
                        for (int e = 0; e < 16; ++e) asm volatile("" :: "v"(acc[e]));
                    } else if (g8 == 0) {
                        float* op = a.out + (size_t)t * 1024 + j * 128 + c8 * 16;
                        float v0[8], v1[8]; unpack8(hr0, v0); unpack8(hr1, v1);
#pragma unroll
                        for (int q = 0; q < 4; ++q) {
                            f32x4 oq;
#pragma unroll
                            for (int e = 0; e < 4; ++e) oq[e] = (q < 2 ? v0[4 * q + e] : v1[4 * (q - 2) + e]) + acc[4 * q + e] * (1.0f / V_SCALE);
                            *(f32x4*)(op + 4 * q) = oq;
                        }
                    }
                }
#undef E3_ISSUE
#undef E3_FMA
            }
        }
    }
}

__device__ __forceinline__ void phase_peer_weights(const Args& a) {
    unsigned char* ws = a.ws;
    float* EG = (float*)(ws + WS_EG);
    const int* EIDX = (const int*)(ws + WS_EIDX);
    const float* PART = (const float*)(ws + WS_PART);
    const float* RSTD2 = (const float*)(ws + WS_RSTD2);
    typedef int i32x4 __attribute__((ext_vector_type(4)));
    const float* USC = (const float*)(ws + WS_USCALE);
    for (size_t i = (size_t)blockIdx.x * NT + threadIdx.x; i < (size_t)T_TOK * 128 / 4; i += (size_t)gridDim.x * NT) {
        i32x4 s = *(const i32x4*)((const int*)PART + i * 4);
#pragma unroll
        for (int j = 1; j < 8; ++j) { const i32x4 p = *(const i32x4*)((const int*)PART + (size_t)j * T_TOK * 128 + i * 4); s[0] += p[0]; s[1] += p[1]; s[2] += p[2]; s[3] += p[3]; }
        const f32x4 gq = *(const f32x4*)(EG + i * 4);
        const i32x4 ev = *(const i32x4*)(EIDX + i * 4);
        const float rs2 = RSTD2[(i * 4) >> 7];
        u32x4 o;
#pragma unroll
        for (int e = 0; e < 4; ++e) {
            const float z = (float)s[e] * USC[ev[e]] * (H2Q_CLIP / 127.0f) * rs2;
            o[e] = (f2bf(gq[e] * gelu_tanh(z)) << 16) | (unsigned)ev[e];
        }
        *(u32x4*)(EG + i * 4) = o;
    }
}

__device__ __forceinline__ void phase_mixnorm(const Args& a) {
    unsigned char* ws = a.ws;
    const int tid = threadIdx.x, lane = tid & 63, w = tid >> 6;
    const int gw = blockIdx.x * NWV + w, nw = gridDim.x * NWV;
    bf16_t* O = (bf16_t*)(ws + WS_OMIX);
    for (int t = gw; t < T_TOK; t += nw) {
        bf16_t* row = O + (size_t)t * 1024 + lane * 8;
        float x[8], y[8];
        unpack8(*(const u32x4*)row, x);
        float s1 = 0.f, s2 = 0.f;
#pragma unroll
        for (int e = 0; e < 8; ++e) s1 += x[e] * x[e];
        s1 = wave_sum(s1);
        const float r1 = rsqrtf(s1 * (1.0f / 512.0f) + EPSN);
#pragma unroll
        for (int e = 0; e < 8; ++e) x[e] *= r1;
        *(u32x4*)row = pack8(x);
#if STAGE >= 2
        unpack8(*(const u32x4*)(row + 512), y);
#pragma unroll
        for (int e = 0; e < 8; ++e) s2 += y[e] * y[e];
        s2 = wave_sum(s2);
        const float r2 = rsqrtf(s2 * (1.0f / 512.0f) + EPSN);
#pragma unroll
        for (int e = 0; e < 8; ++e) y[e] *= r2;
#else
#pragma unroll
        for (int e = 0; e < 8; ++e) y[e] = 0.f;
        (void)s2;
#endif
        *(u32x4*)(row + 512) = pack8(y);
    }
}

#define N_PHASES 17
__global__ void __launch_bounds__(NT, 2) mega(Args a) {
    extern __shared__ __attribute__((aligned(16))) unsigned char lds[];
    unsigned char* ws = a.ws;
    const int tid = threadIdx.x;
    const int G = gridDim.x, bid = blockIdx.x;
    volatile unsigned* bst = (volatile unsigned*)(lds + LDS_BYTES - 16);
    XcdBarrier bar; bar.bar = (unsigned*)(ws + WS_BAR); bar.x = 0; bar.st = bst;
    const bool multi = (a.ph_hi - a.ph_lo) > 1;
    if (multi) {
        if (tid == 0) { bst[0] = 0u; bst[1] = 0u; }
        __syncthreads();
        bar = xcd_barrier_post((unsigned*)(ws + WS_BAR), bst);
    }
#define PH(k) (a.ph_lo <= (k) && (k) < a.ph_hi)
#define SEAM(k) do { if (PH(k) && PH((k) + 1)) { xcd_barrier(bar); if ((PROBE_MASK >> 22) & 1) { xcd_barrier(bar); xcd_barrier(bar); } } } while (0)
#define GEMM_BITS ((1 << 1) | (1 << 8) | (1 << 9) | (1 << 12))
#define PMASK2 (PROBE_MASK & ~GEMM_BITS & 0xFFFFF)
#define TREP(k) (1 + ((PROBE_MASK >> (k)) & 1))
#define FOR_TILES_XCD(nM, nN, m_, n_) for (int L_ = (bid >> 3); L_ < ((nM) >> 3) * (nN); L_ += (G >> 3)) { const int m_ = (bid & 7) + 8 * (L_ / (nN)); const int n_ = L_ % (nN);
#define PHREP(k) if (PH(k)) for (int rep_ = 0; rep_ <= ((PMASK2 >> (k)) & 1); ++rep_) if (rep_ ? (xcd_barrier(bar), true) : true)
#define LASTREP(k) (rep_ == ((PMASK2 >> (k)) & 1))

    PHREP(0) phase_prep(a, lds);
    SEAM(0);
    PHREP(1) {
        Epi8InProj e1{(const float*)(ws + WS_RSTD0), (bf16_t*)(ws + WS_P), (bf16_t*)(ws + WS_QN), (bf16_t*)(ws + WS_KS), (bf16_t*)(ws + WS_KW),
                     (bf16_t*)(ws + WS_KCIN), (bf16_t*)(ws + WS_VCIN), (float*)(ws + WS_GATE), (const f32x2*)(ws + WS_ROPEN), a.in[9], a.in[10], (float*)(ws + WS_CSSQ)};
        for (int rp = 0; rp < TREP(1); ++rp) {
            gemm8((const bf16_t*)(ws + WS_XB), 1024, (const bf16_t*)(ws + WS_WIN), 1024, 1024, 256, 7, e1, lds);
        }
        if (bid == G - 1 && tid < 256) {
            float s = 0.f;
            const float* bp = (const float*)(ws + WS_BIASP);
            const int kv = tid >> 7, j = tid & 127;
            for (int i = 0; i < 32; ++i) s += bp[(kv * 32 + i) * 128 + j];
            ((float*)(ws + WS_BIAS1))[tid] = s;
        }
    }
    SEAM(1);
    PHREP(3) {
        Epi8QUp eq{(bf16_t*)(ws + WS_QMRAW), 768, (const float*)(ws + WS_CSSQ)};
        Epi8KvUp ek{(const float*)(ws + WS_CSSQ), (const bf16_t*)(ws + WS_P), (const f32x2*)(ws + WS_ROPEM), a.in[8] + 96, (bf16_t*)(ws + WS_KM), (bf16_t*)(ws + WS_KVRAW)};
#if STAGE >= 2
        for (int it = bid; it < 256; it += G) {
            const int kv = it >> 7, mi = (it >> 2) & 31, ksl = it & 3;
            EpiF32 ep{(float*)(ws + WS_PARTC) + ((size_t)(ksl * 2 + kv) * 8192) * 128, 128, 128};
            gemm_tile<false>((const bf16_t*)(ws + (kv ? WS_VCIN : WS_KCIN)) + ksl * 512, 1024, (const bf16_t*)(ws + WS_W1C) + (size_t)kv * 128 * 2048 + ksl * 512, 2048, 512, mi * 256, 0, ep, lds);
        }
#endif
        gemm8((const bf16_t*)(ws + WS_P) + C_CQ, PLD, (const bf16_t*)(ws + WS_WUQ), 256, 256, 256, 3, eq, lds);
        gemm8((const bf16_t*)(ws + WS_P) + C_CKV, PLD, (const bf16_t*)(ws + WS_WUKV), 128, 128, 256, 4, ek, lds);
#if STAGE >= 2
        for (int id0 = 2 * bid; id0 < 2 * 32 * 64; id0 += 2 * G) {
            const int idr = id0 + (tid >> 8); const bool ok = idr < 2 * 32 * 64; const int id = ok ? idr : 0;
            const int which = id >> 11, bg = (id >> 6) & 31, st = id & 63, b = bg >> 1, g = bg & 1;
            const bf16_t* src = (const bf16_t*)(ws + WS_P) + ((size_t)b * SEQ + st * 64) * PLD + (which ? C_VW : C_VS) + g * 64;
            bf16_t* dst = (bf16_t*)(ws + (which ? WS_VWT : WS_VST)) + (size_t)bg * 64 * SEQ + st * 64;
            tr_tile(src, PLD, dst, SEQ, (bf16_t*)lds, ok);
        }
#endif
    }
    SEAM(3);
    PHREP(4) {
        const bool xa_wg = G > 64 && bid < 64;
        const int vb = G > 64 ? bid - 64 : bid, VG = G > 64 ? G - 64 : G;
#if STAGE >= 3
        {
            Epi8RowScaleBf16 e2{(bf16_t*)(ws + WS_KVX), 1024, (const float*)(ws + WS_RSTDMEM)};
            if (G > 64) gemm8((const bf16_t*)(ws + WS_MEMB), 1024, (const bf16_t*)(ws + WS_WXKV), 1024, 1024, 16, 4, e2, lds);
            else { EpiRowScaleBf16 e2o{(bf16_t*)(ws + WS_KVX), 1024, (const float*)(ws + WS_RSTDMEM), 1024}; gemm_tiles_xcd<false>((const bf16_t*)(ws + WS_MEMB), 1024, (const bf16_t*)(ws + WS_WXKV), 1024, 1024, 16, 4, e2o, lds); }
        }
#endif
        if (!xa_wg) for (int id0 = 2 * vb; id0 < 128 * 64; id0 += 2 * VG) {
            const int idr = id0 + (tid >> 8); const bool ok = idr < 128 * 64; const int id = ok ? idr : 0;
            const int bh = id >> 6, st = id & 63, b = bh >> 3, h = bh & 7;
            const bf16_t* src = (const bf16_t*)(ws + WS_KVRAW) + ((size_t)b * SEQ + st * 64) * 1024 + h * 128 + 64;
            bf16_t* dst = (bf16_t*)(ws + WS_VMT) + (size_t)bh * 64 * SEQ + st * 64;
            tr_tile(src, 1024, dst, SEQ, (bf16_t*)lds, ok);
        }
#if STAGE >= 2
        if (!xa_wg) for (int i = vb * NT + tid; i < 2 * 8192 * 128 / 4; i += VG * NT) {
            const float* pp = (const float*)(ws + WS_PARTC) + (size_t)i * 4;
            f32x4 s = *(const f32x4*)pp;
#pragma unroll
            for (int k = 1; k < 4; ++k) { const f32x4 p = *(const f32x4*)(pp + (size_t)k * 2 * 8192 * 128); s[0] += p[0]; s[1] += p[1]; s[2] += p[2]; s[3] += p[3]; }
            const int kv = i >> 18, col = (i * 4) & 127;
            const f32x4 bq = *(const f32x4*)((const float*)(ws + WS_BIAS1) + kv * 128 + col);
            float v[4];
#pragma unroll
            for (int e = 0; e < 4; ++e) v[e] = gelu_tanh(s[e] + bq[e]);
            *(u32x2*)((bf16_t*)(ws + WS_HID) + (size_t)i * 4) = pack4(v);
        }
#endif
    }
    SEAM(4);
#if STAGE >= 2
    PHREP(5) {
#if STAGE >= 3
        {
            const bool cmp_wg = G > 64 && bid < 64;
            const int vb = G > 64 ? bid - 64 : bid, VG = G > 64 ? G - 64 : G;
            if (!cmp_wg) {
                phase_xa_k(a, vb, VG);
                for (int id0 = 2 * vb; id0 < 16 * 4 * 8; id0 += 2 * VG) {
                    const int idr = id0 + (tid >> 8); const bool ok = idr < 16 * 4 * 8; const int id = ok ? idr : 0;
                    const int b = id >> 5, mt = (id >> 3) & 3, ct = id & 7;
                    const bf16_t* src = (const bf16_t*)(ws + WS_KVX) + ((size_t)b * 256 + mt * 64) * 1024 + 512 + ct * 64;
                    bf16_t* dst = (bf16_t*)(ws + WS_VXT) + ((size_t)b * 512 + ct * 64) * 256 + mt * 64;
                    tr_tile(src, 1024, dst, 256, (bf16_t*)lds, ok);
                }
            }
        }
#endif
        for (int it = bid; it < 64; it += G) {
            const int kv = it >> 5, mi = it & 31;
            EpiCmpFin ec{kv, (const f32x2*)(ws + WS_ROPEN), a.in[10], (bf16_t*)(ws + WS_KC), (bf16_t*)(ws + WS_VCT)};
            gemm_tile<false>((const bf16_t*)(ws + WS_HID) + (size_t)kv * 8192 * 128, 128, (const bf16_t*)(ws + WS_W2C) + (size_t)kv * 128 * 128, 128, 128, mi * 256, 0, ec, lds);
        }
    }
#endif
    SEAM(5);
    PHREP(6) {
        if (G == 256) {
            const int x = bid & 7, r = bid >> 3;
            for (int rp = 0; rp < TREP(20); ++rp)
                for (int i = 0; i < 8; ++i) {
                    const int bh = x + 8 * (2 * i + (r >> 4));
                    const int qt = (i & 1) ? 15 - (r & 15) : (r & 15);
                    mla_unit(a, bh >> 3, bh & 7, qt, lds);
                }
#if STAGE >= 2
            for (int rp = 0; rp < TREP(21); ++rp)
                for (int i = 0; i < 8; ++i) {
                    const int bg = x + 8 * (i >> 1);
                    const int jq = (i & 1) ? 63 - r : r;
                    nsa_unit(a, bg >> 1, bg & 1, jq, lds);
                }
#endif
        } else {
            for (int u = bid; u < 2048; u += G) {
                const int qt = 15 - (u >> 7), bh = u & 127;
                mla_unit(a, bh >> 3, bh & 7, qt, lds);
            }
#if STAGE >= 2
            for (int u = bid; u < 2048; u += G) {
                const int jq = 63 - (u >> 5), bg = u & 31;
                nsa_unit(a, bg >> 1, bg & 1, jq, lds);
            }
#endif
        }
    }
    SEAM(6);
    PHREP(8) {
        Epi8ResBf16S er{(const bf16_t*)(ws + WS_XB), (bf16_t*)(ws + WS_H1B), (float*)(ws + WS_H1SSQ)};
        for (int rp = 0; rp < TREP(8); ++rp) {
            gemm8<Epi8ResBf16S, true>((const bf16_t*)(ws + WS_OMIX), 1024, (const bf16_t*)(ws + WS_WOUT), 1024, 1024, 256, 4, er, lds, (const float*)(ws + WS_SSQ)); }
    }
    SEAM(8);
#if STAGE >= 3
    PHREP(9) {
        Epi8RssScaleBf16 eq{(bf16_t*)(ws + WS_QX), 512, (const float*)(ws + WS_H1SSQ), nullptr};
        for (int rp = 0; rp < TREP(9); ++rp) {
            gemm8((const bf16_t*)(ws + WS_H1B), 1024, (const bf16_t*)(ws + WS_WXQ), 1024, 1024, 256, 2, eq, lds); }
    }
    SEAM(9);
    PHREP(10) {
        for (int u = bid; u < 1024; u += G) xa_unit(a, u >> 6, (u >> 4) & 3, u & 15, lds);
    }
    SEAM(10);
    PHREP(11) {
        Epi8ResBf16Q er{(const bf16_t*)(ws + WS_H1B), (bf16_t*)(ws + WS_H2B), (unsigned*)(ws + WS_H2Q), (float*)(ws + WS_H2SSQ)};
        gemm8(( const bf16_t*)(ws + WS_OX), 512, (const bf16_t*)(ws + WS_WXO), 512, 512, 256, 4, er, lds);
    }
    SEAM(11);
#endif
#if STAGE >= 4
    PHREP(12) {
        Epi8RssScaleBf16 eq{(bf16_t*)(ws + WS_QP), 1024, (const float*)(ws + WS_H2SSQ), (float*)(ws + WS_RSTD2)};
        for (int rp = 0; rp < TREP(12); ++rp) {
            gemm8((const bf16_t*)(ws + WS_H2B), 1024, (const bf16_t*)(ws + WS_WPQ), 1024, 1024, 256, 4, eq, lds); }
    }
    SEAM(12);
    PHREP(13) phase_peer_route(a);
    SEAM(13);
    PHREP(14) phase_peer_sliced<0>(a, lds, rep_, false);
    SEAM(14);
    PHREP(15) phase_peer_weights(a);
    SEAM(15);
    PHREP(16) phase_peer_sliced<1>(a, lds, 2 + rep_, !LASTREP(16));
#endif
#undef PH
#undef SEAM
}

extern "C" void kernel_launch(void* const* d_in, const int* in_sizes, int n_in, void* d_out, int out_size, void* d_ws, size_t ws_size, hipStream_t stream) {
    static int grid = 0;
    if (grid == 0) {
        if (n_in != 27 || ws_size < WS_END) { fprintf(stderr, "kernel_launch: unexpected n_in %d or ws_size %zu (< %zu)\n", n_in, ws_size, (size_t)WS_END); grid = -1; return; }
        int dev = 0, cus = 0, per_cu = 0;
        hipGetDevice(&dev);
        hipDeviceGetAttribute(&cus, hipDeviceAttributeMultiprocessorCount, dev);
        hipFuncSetAttribute((const void*)mega, hipFuncAttributeMaxDynamicSharedMemorySize, LDS_BYTES);
        if (hipOccupancyMaxActiveBlocksPerMultiprocessor(&per_cu, (const void*)mega, NT, LDS_BYTES) != hipSuccess || per_cu < 1) per_cu = 1;
        (void)hipGetLastError();
        if (per_cu > 1) per_cu = 1;
        grid = cus * per_cu;
    }
    if (grid < 0) return;
    hipMemsetAsync((unsigned char*)d_ws + WS_BAR, 0, 16384, stream);
    Args a{};
    for (int i = 0; i < 27; ++i) a.in[i] = (const float*)d_in[i];
    a.out = (float*)d_out; a.ws = (unsigned char*)d_ws;
#if ONE_LAUNCH
    a.ph_lo = 0; a.ph_hi = N_PHASES;
    hipLaunchKernelGGL(mega, dim3(grid), dim3(NT), LDS_BYTES, stream, a);
#else
    for (int p = 0; p < N_PHASES; ++p) {
        a.ph_lo = p; a.ph_hi = p + 1;
        hipLaunchKernelGGL(mega, dim3(grid), dim3(NT), LDS_BYTES, stream, a);
    }
#endif
}
```

```cpp
#include <hip/hip_runtime.h>
#include <cstdio>
#include <cstdint>

#ifndef STAGE
#define STAGE 4
#endif
#ifndef ONE_LAUNCH
#define ONE_LAUNCH 1
#endif
#ifndef PROBE_MASK
#define PROBE_MASK 0
#endif

typedef unsigned short bf16_t;
typedef short bf16x8 __attribute__((ext_vector_type(8)));
typedef float f32x16 __attribute__((ext_vector_type(16)));
typedef float f32x4 __attribute__((ext_vector_type(4)));
typedef float f32x2 __attribute__((ext_vector_type(2)));
typedef unsigned u32x4 __attribute__((ext_vector_type(4)));
typedef unsigned u32x2 __attribute__((ext_vector_type(2)));

#define T_TOK 65536
#define SEQ 4096
#define NBATCH 16
#define DM 1024
#define INC 1720
#define PLD 1728
#define INP 1792
#define C_CQ 1280
#define C_CKV 1536
#define C_KPE 1664
#define C_QN 416
#define C_KC 928
#define C_VC 1056
#define C_KS 1184
#define C_VS 1024
#define C_KW 1440
#define C_VW 1152
#define C_GATE 1696
#define EPSN 1e-6f
#define LOG2E 1.4426950408889634f

#define MIB (1024ull * 1024ull)
constexpr size_t WS_R1   = 0;
constexpr size_t WS_R2   = WS_R1 + 128 * MIB;
constexpr size_t WS_R3   = WS_R2 + 216 * MIB;
constexpr size_t WS_R4   = WS_R3 + 96 * MIB;
constexpr size_t WS_R5   = WS_R4 + 128 * MIB;
constexpr size_t WS_R6   = WS_R5 + 96 * MIB;
constexpr size_t WS_R7   = WS_R6 + 64 * MIB;
constexpr size_t WS_KS   = WS_R7 + 64 * MIB;
constexpr size_t WS_KW   = WS_KS + 16 * MIB;
constexpr size_t WS_VST  = WS_KW + 16 * MIB;
constexpr size_t WS_VWT  = WS_VST + 16 * MIB;
constexpr size_t WS_KCIN = WS_VWT + 16 * MIB;
constexpr size_t WS_VCIN = WS_KCIN + 16 * MIB;
constexpr size_t WS_PAD0 = WS_VCIN + 16 * MIB;
constexpr size_t WS_HID  = WS_PAD0 + 65536;
constexpr size_t WS_CRAW = WS_HID + 4 * MIB;
constexpr size_t WS_KC   = WS_CRAW + 4 * MIB;
constexpr size_t WS_VCT  = WS_KC + 1 * MIB;
constexpr size_t WS_GATE = WS_VCT + 1 * MIB;
constexpr size_t WS_RSTD0 = WS_GATE + 6 * MIB;
constexpr size_t WS_RSTDCQ = WS_RSTD0 + 262144;
constexpr size_t WS_RSTDCKV = WS_RSTDCQ + 262144;
constexpr size_t WS_RSTD2 = WS_RSTDCKV + 262144;
constexpr size_t WS_RSTDMEM = WS_RSTD2 + 262144;
constexpr size_t WS_UB   = WS_RSTDMEM + 16384;
constexpr size_t WS_VB   = WS_UB + 16 * MIB;
constexpr size_t WS_PARTC = WS_UB + 32 * MIB;
constexpr size_t WS_WIN  = WS_UB + 64 * MIB;
constexpr size_t WS_WUQ  = WS_WIN + 1792 * 1024 * 2;
constexpr size_t WS_WUKV = WS_WUQ + 768 * 256 * 2;
constexpr size_t WS_W1C  = WS_WUKV + 1024 * 128 * 2;
constexpr size_t WS_W2C  = WS_W1C + 2 * 128 * 2048 * 2;
constexpr size_t WS_WOUT = WS_W2C + 2 * 128 * 128 * 2;
constexpr size_t WS_WXQ  = WS_WOUT + 2 * MIB;
constexpr size_t WS_WXKV = WS_WXQ + 1 * MIB;
constexpr size_t WS_WXO  = WS_WXKV + 2 * MIB;
constexpr size_t WS_WPQ  = WS_WXO + 1 * MIB;
constexpr size_t WS_KP   = WS_WPQ + 2 * MIB;
constexpr size_t WS_MEMB = WS_KP + 262144;
constexpr size_t WS_KVX  = WS_MEMB + 8 * MIB;
constexpr size_t WS_KX   = WS_KVX + 8 * MIB;
constexpr size_t WS_VXT  = WS_KX + 4 * MIB;
constexpr size_t WS_ROPEM = WS_VXT + 4 * MIB;
constexpr size_t WS_ROPEN = WS_ROPEM + 524288;
constexpr size_t WS_BIASP = WS_ROPEN + 262144;
constexpr size_t WS_BIAS1 = WS_BIASP + 32768;
constexpr size_t WS_BAR  = WS_BIAS1 + 1024;
constexpr size_t WS_END  = WS_BAR + 16384;
constexpr size_t WS_XB = WS_R1, WS_H1B = WS_R1;
constexpr size_t WS_P = WS_R2, WS_OMIX = WS_R2, WS_QP = WS_R2, WS_QX = WS_R2 + 128 * MIB;
constexpr size_t WS_QMRAW = WS_R3, WS_OX = WS_R3;
constexpr size_t WS_KVRAW = WS_R4, WS_H2B = WS_R4;
constexpr size_t WS_KM = WS_R5, WS_EIDX = WS_R5, WS_EG = WS_R5 + 32 * MIB;
constexpr size_t WS_VMT = WS_R6, WS_QN = WS_R7;
constexpr size_t WS_SSQ = WS_CRAW;
constexpr size_t WS_USCALE = WS_RSTDCQ;
constexpr size_t WS_H2Q = WS_R6;
constexpr size_t WS_H2SSQ = WS_GATE;
constexpr size_t WS_H1SSQ = WS_HID;
constexpr size_t WS_CSSQ = WS_R6;
constexpr size_t WS_PART = WS_R2;

#define NT 512
#define NWV 8
#define LDS_BYTES 151552

__device__ __forceinline__ unsigned f2bf(float f) { unsigned u = __float_as_uint(f); u += 0x7FFFu + ((u >> 16) & 1u); return u >> 16; }
typedef __bf16 bf2n_t __attribute__((ext_vector_type(2)));
__device__ __forceinline__ unsigned pack2(float lo, float hi) { bf2n_t v; v[0] = (__bf16)lo; v[1] = (__bf16)hi; return __builtin_bit_cast(unsigned, v); }
__device__ __forceinline__ float bflo(unsigned w) { return __uint_as_float(w << 16); }
__device__ __forceinline__ float bfhi(unsigned w) { return __uint_as_float(w & 0xFFFF0000u); }
__device__ __forceinline__ float bf2f(bf16_t b) { return __uint_as_float(((unsigned)b) << 16); }
__device__ __forceinline__ void unpack8(const u32x4& r, float (&v)[8]) {
    v[0] = bflo(r.x); v[1] = bfhi(r.x); v[2] = bflo(r.y); v[3] = bfhi(r.y);
    v[4] = bflo(r.z); v[5] = bfhi(r.z); v[6] = bflo(r.w); v[7] = bfhi(r.w);
}
__device__ __forceinline__ u32x4 pack8(const float (&v)[8]) {
    u32x4 r; r.x = pack2(v[0], v[1]); r.y = pack2(v[2], v[3]); r.z = pack2(v[4], v[5]); r.w = pack2(v[6], v[7]); return r;
}
__device__ __forceinline__ int kap(int p) { return (p & ~0xC) | ((p & 4) << 1) | ((p & 8) >> 1); }
__device__ __forceinline__ float wave_sum(float v) {
    v += __shfl_xor(v, 32); v += __shfl_xor(v, 16); v += __shfl_xor(v, 8); v += __shfl_xor(v, 4); v += __shfl_xor(v, 2); v += __shfl_xor(v, 1); return v;
}
__device__ __forceinline__ float gelu_tanh(float x) {
    const float u = 0.7978845608028654f * (x + 0.044715f * x * x * x);
    const float e = __expf(2.0f * u);
    const float t = 1.0f - 2.0f / (e + 1.0f);
    return 0.5f * x * (1.0f + t);
}
__device__ __forceinline__ bf16x8 as_bf16x8(const u32x4& r) { union { u32x4 u; bf16x8 b; } c; c.u = r; return c.b; }
#define DPP_ROR_ADD(v, n) ((v) + __builtin_bit_cast(float, __builtin_amdgcn_update_dpp(0, __builtin_bit_cast(int, (v)), 0x120 + (n), 0xf, 0xf, false)))
#define MFMA32(a, b, c) __builtin_amdgcn_mfma_f32_32x32x16_bf16((a), (b), (c), 0, 0, 0)

struct Args {
    const float* in[27];
    float* out;
    unsigned char* ws;
    int ph_lo, ph_hi;
};

#define XB_TMO      128
#define XB_XCNT(j)  (256  + 64 * (j))
#define XB_XSUB(j)  (1280 + 64 * (j))
#define XB_XGEN(j)  (2304 + 64 * (j))
#define XB_TOP      3328
#define XB_TOPGEN   3392
#define XCD_BAR_WORDS 3456
#define XB_SPIN_CAP (1u << 22)
#define LAS __attribute__((address_space(3)))
__device__ __forceinline__ unsigned xb_ld(unsigned* p)              { return __hip_atomic_load(p, __ATOMIC_RELAXED, __HIP_MEMORY_SCOPE_AGENT); }
__device__ __forceinline__ unsigned xb_add(unsigned* p, unsigned v) { return __hip_atomic_fetch_add(p, v, __ATOMIC_RELAXED, __HIP_MEMORY_SCOPE_AGENT); }
__device__ __forceinline__ unsigned xb_xcc_id() { return (unsigned)__builtin_amdgcn_s_getreg((3 << 11) | 20) & 0xFu; }
#define XB_SPIN(cond, bar) do { unsigned _sp = 0; while (cond) { __builtin_amdgcn_s_sleep(1); \
    if ((++_sp & 255u) == 0u) { if (xb_ld(&(bar)[XB_TMO])) break; if (_sp > XB_SPIN_CAP) { atomicAdd(&(bar)[XB_TMO], 1u); break; } } } } while (0)
struct XcdBarrier { unsigned* bar; unsigned x; volatile unsigned* st; };
__device__ __forceinline__ XcdBarrier xcd_barrier_post(unsigned* bar, volatile unsigned* st) {
    XcdBarrier b; b.bar = bar; b.x = xb_xcc_id(); b.st = st;
    if (threadIdx.x == 0) (void)xb_add(&bar[XB_XCNT(b.x)], 1u);
    return b;
}
__device__ __forceinline__ void xcd_barrier_complete(unsigned* bar, unsigned x, unsigned& nloc, unsigned& nx) {
    const unsigned G = gridDim.x;
    unsigned sum, cnt, mine, sp = 0u;
    for (;;) {
        sum = 0u; cnt = 0u; mine = 0u;
#pragma unroll
        for (unsigned j = 0; j < 16; ++j) { const unsigned c = xb_ld(&bar[XB_XCNT(j)]); sum += c; cnt += (c > 0u) ? 1u : 0u; mine = (j == x) ? c : mine; }
        if (sum == G) break;
        __builtin_amdgcn_s_sleep(1);
        if ((++sp & 255u) == 0u) { if (xb_ld(&bar[XB_TMO])) break; if (sp > XB_SPIN_CAP) { atomicAdd(&bar[XB_TMO], 1u); break; } }
    }
    nloc = mine > 0u ? mine : 1u; nx = cnt > 0u ? cnt : 1u;
}
__device__ __forceinline__ void xcd_barrier(const XcdBarrier& b) {
    asm volatile("s_waitcnt vmcnt(0)" ::: "memory");
    __syncthreads();
    if (threadIdx.x == 0) {
        unsigned* bar = b.bar;
        __builtin_amdgcn_s_waitcnt(0);
        unsigned nloc = b.st[0], nx = b.st[1];
        if (nloc == 0u) { xcd_barrier_complete(bar, b.x, nloc, nx); b.st[0] = nloc; b.st[1] = nx; }
        const unsigned old = xb_add(&bar[XB_XSUB(b.x)], 1u);
        const unsigned gen = old / nloc;
        if (old + 1u == (gen + 1u) * nloc) {
            __builtin_amdgcn_fence(__ATOMIC_RELEASE, "agent");
            asm volatile("s_waitcnt vmcnt(0)" ::: "memory");
            const unsigned og = xb_add(&bar[XB_TOP], 1u);
            const unsigned tg = og / nx;
            if (og + 1u == (tg + 1u) * nx) xb_add(&bar[XB_TOPGEN], 1u);
            else XB_SPIN(xb_ld(&bar[XB_TOPGEN]) == tg, bar);
            __builtin_amdgcn_fence(__ATOMIC_ACQUIRE, "agent");
            xb_add(&bar[XB_XGEN(b.x)], 1u);
            asm volatile("s_waitcnt vmcnt(0)" ::: "memory");
        } else {
            XB_SPIN(xb_ld(&bar[XB_XGEN(b.x)]) == gen, bar);
            __builtin_amdgcn_fence(__ATOMIC_ACQUIRE, "agent");
            asm volatile("s_waitcnt vmcnt(0)" ::: "memory");
        }
    }
    __syncthreads();
}

#define GEMM_XBYTES 36864
#define GEMM_STAGE_BYTES 73728
#define GEMM_MISC_OFF 147456
template <bool ROWSS, class Epi, bool MIXN = false>
__device__ __forceinline__ void gemm_tile(const bf16_t* __restrict__ A, int lda, const bf16_t* __restrict__ Bt, int ldb, int K,
                                          int m0, int n0, Epi& epi, unsigned char* lds, const float* __restrict__ ssq16 = nullptr) {
    int tid_ = threadIdx.x; asm volatile("" : "+v"(tid_));
    const int tid = tid_, lane = tid & 63, w = tid >> 6;
    const int wm = w & 1, wn = w >> 1, l31 = lane & 31, hh = lane >> 5;
    const int lrow = tid >> 3, lc = tid & 7;
    const bf16_t* ag = A + (size_t)(m0 + lrow) * lda + lc * 8;
    const bf16_t* bg = Bt + (size_t)(n0 + lrow) * ldb + lc * 8;
    u32x4 ra[4], rb[4];
    f32x16 acc[2][4];
#pragma unroll
    for (int i = 0; i < 2; ++i)
#pragma unroll
        for (int j = 0; j < 4; ++j)
#pragma unroll
            for (int r = 0; r < 16; ++r) acc[i][j][r] = 0.f;
    float ssq[4] = {0.f, 0.f, 0.f, 0.f};
    const int nk = K >> 6;
#pragma unroll
    for (int i = 0; i < 4; ++i) { ra[i] = *(const u32x4*)(ag + (size_t)i * 64 * lda); rb[i] = *(const u32x4*)(bg + (size_t)i * 64 * ldb); }
    float* rs = (float*)(lds + GEMM_MISC_OFF);
    float* rtab = (float*)(lds + GEMM_MISC_OFF + 1024);
    __syncthreads();
#define GEMM_STORE(stage_) do { \
        unsigned char* sb_ = lds + (stage_) * GEMM_STAGE_BYTES; \
        _Pragma("unroll") for (int i_ = 0; i_ < 4; ++i_) { \
            *(u32x4*)(sb_ + (lrow + 64 * i_) * 144 + lc * 16) = ra[i_]; \
            *(u32x4*)(sb_ + GEMM_XBYTES + (lrow + 64 * i_) * 144 + lc * 16) = rb[i_]; } \
        if (ROWSS) { _Pragma("unroll") for (int i_ = 0; i_ < 4; ++i_) { float v_[8]; unpack8(ra[i_], v_); \
            _Pragma("unroll") for (int e_ = 0; e_ < 8; ++e_) ssq[i_] += v_[e_] * v_[e_]; } } } while (0)
    GEMM_STORE(0);
    if (MIXN && tid < 256) {
        const float* sp = ssq16 + (size_t)(m0 + tid) * 16;
        const f32x4 a0 = *(const f32x4*)sp, a1 = *(const f32x4*)(sp + 4), b0 = *(const f32x4*)(sp + 8), b1 = *(const f32x4*)(sp + 12);
        const float s1 = ((a0[0] + a0[1]) + (a0[2] + a0[3])) + ((a1[0] + a1[1]) + (a1[2] + a1[3]));
        const float s2 = ((b0[0] + b0[1]) + (b0[2] + b0[3])) + ((b1[0] + b1[1]) + (b1[2] + b1[3]));
        const float r1 = rsqrtf(s1 * (1.0f / 512.0f) + EPSN), r2 = rsqrtf(s2 * (1.0f / 512.0f) + EPSN);
        rtab[tid] = r1 / r2; rtab[256 + tid] = r2;
    }
    __syncthreads();
    const int xoff = (wm * 128 + l31) * 144 + hh * 16;
    const int woff = GEMM_XBYTES + (wn * 64 + kap(l31)) * 144 + hh * 16;
#pragma unroll 1
    for (int kt = 0; kt < nk; ++kt) {
        const bool more = kt + 1 < nk;
        if (more) {
#pragma unroll
            for (int i = 0; i < 4; ++i) { ra[i] = *(const u32x4*)(ag + (size_t)i * 64 * lda + (kt + 1) * 64); rb[i] = *(const u32x4*)(bg + (size_t)i * 64 * ldb + (kt + 1) * 64); }
        }
        if (MIXN && kt == (nk >> 1)) {
#pragma unroll
            for (int mt = 0; mt < 4; ++mt) {
                const float f = rtab[wm * 128 + mt * 32 + l31];
#pragma unroll
                for (int nf = 0; nf < 2; ++nf)
#pragma unroll
                    for (int r = 0; r < 16; ++r) acc[nf][mt][r] *= f;
            }
        }
        const unsigned char* st = lds + (kt & 1) * GEMM_STAGE_BYTES;
#pragma unroll
        for (int ks = 0; ks < 4; ++ks) {
            bf16x8 xf[4], wf[2];
#pragma unroll
            for (int mt = 0; mt < 4; ++mt) xf[mt] = as_bf16x8(*(const u32x4*)(st + xoff + mt * 32 * 144 + ks * 32));
#pragma unroll
            for (int nf = 0; nf < 2; ++nf) wf[nf] = as_bf16x8(*(const u32x4*)(st + woff + nf * 32 * 144 + ks * 32));
#pragma unroll
            for (int nf = 0; nf < 2; ++nf)
#pragma unroll
                for (int mt = 0; mt < 4; ++mt) acc[nf][mt] = MFMA32(wf[nf], xf[mt], acc[nf][mt]);
        }
        if (more) GEMM_STORE((kt + 1) & 1);
        __syncthreads();
    }
#undef GEMM_STORE
    if (ROWSS) {
#pragma unroll
        for (int i = 0; i < 4; ++i) { float s = ssq[i]; s += __shfl_xor(s, 1); s += __shfl_xor(s, 2); s += __shfl_xor(s, 4); if (lc == 0) rs[lrow + 64 * i] = s; }
        __syncthreads();
    }
    unsigned char* stg = lds + w * 8704;
    const int rrow = lane >> 4, rch = lane & 15;
#pragma unroll
    for (int mt = 0; mt < 4; ++mt) {
#pragma unroll
        for (int nf = 0; nf < 2; ++nf)
#pragma unroll
            for (int j = 0; j < 2; ++j) {
                float* sp = (float*)(stg + l31 * 272 + (nf * 32 + 16 * j + 8 * hh) * 4);
                *(f32x4*)sp = (f32x4){acc[nf][mt][8 * j + 0], acc[nf][mt][8 * j + 1], acc[nf][mt][8 * j + 2], acc[nf][mt][8 * j + 3]};
                *(f32x4*)(sp + 4) = (f32x4){acc[nf][mt][8 * j + 4], acc[nf][mt][8 * j + 5], acc[nf][mt][8 * j + 6], acc[nf][mt][8 * j + 7]};
            }
#pragma unroll
        for (int i = 0; i < 8; ++i) {
            const int r = 4 * i + rrow;
            const f32x4 v4 = *(const f32x4*)(stg + r * 272 + rch * 16);
            const int rl = wm * 128 + mt * 32 + r;
            float v[4] = {v4[0], v4[1], v4[2], v4[3]};
            epi(m0 + rl, n0 + wn * 64 + rch * 4, v, ROWSS ? rs[rl] : (MIXN ? rtab[256 + rl] : 0.f));
        }
    }
}
template <bool ROWSS, class Epi, bool MIXN = false>
__device__ __forceinline__ void gemm_tiles_xcd(const bf16_t* __restrict__ A, int lda, const bf16_t* __restrict__ Bt, int ldb, int K, int nM, int nN,
                                               Epi& epi, unsigned char* lds, const float* __restrict__ ssq16 = nullptr) {
    const int bid = blockIdx.x, x = bid & 7, stride = gridDim.x >> 3, cnt = (nM >> 3) * nN;
    for (int L = bid >> 3; L < cnt; L += stride) {
        const int m = x + 8 * (L / nN), n = L % nN;
        gemm_tile<ROWSS, Epi, MIXN>(A, lda, Bt, ldb, K, m * 256, n * 256, epi, lds, ssq16);
    }
}

__device__ __forceinline__ u32x2 pack4(const float (&v)[4]) { u32x2 r; r.x = pack2(v[0], v[1]); r.y = pack2(v[2], v[3]); return r; }
struct EpiRowScaleBf16 {
    bf16_t* out; int ld; const float* scale; int ncol;
    __device__ __forceinline__ void operator()(int row, int col, float (&v)[4], float) const {
        if (col >= ncol) return;
        const float s = scale ? scale[row] : 1.0f;
#pragma unroll
        for (int e = 0; e < 4; ++e) v[e] *= s;
        *(u32x2*)(out + (size_t)row * ld + col) = pack4(v);
    }
};
struct EpiBiasGeluBf16 {
    bf16_t* out; int ld; const float* bias;
    __device__ __forceinline__ void operator()(int row, int col, float (&v)[4], float) const {
#pragma unroll
        for (int e = 0; e < 4; ++e) v[e] = gelu_tanh(v[e] + bias[col + e]);
        *(u32x2*)(out + (size_t)row * ld + col) = pack4(v);
    }
};
struct EpiF32 {
    float* out; int ld; int ncol;
    __device__ __forceinline__ void operator()(int row, int col, float (&v)[4], float) const {
        if (col >= ncol) return;
        *(f32x4*)(out + (size_t)row * ld + col) = (f32x4){v[0], v[1], v[2], v[3]};
    }
};
struct EpiResidual {
    const float* res_in; float* res_out; bf16_t* hb;
    __device__ __forceinline__ void operator()(int row, int col, float (&v)[4], float) const {
        const f32x4 a = *(const f32x4*)(res_in + (size_t)row * DM + col);
        v[0] += a[0]; v[1] += a[1]; v[2] += a[2]; v[3] += a[3];
        *(f32x4*)(res_out + (size_t)row * DM + col) = (f32x4){v[0], v[1], v[2], v[3]};
        if (hb) *(u32x2*)(hb + (size_t)row * DM + col) = pack4(v);
    }
};
struct EpiInProj {
    const float* rstd0; bf16_t* P; bf16_t* QN; bf16_t* KS; bf16_t* KW; bf16_t* KCIN; bf16_t* VCIN; float* GATE;
    const f32x2* ropen; const float* qg; const float* kg;
    __device__ __forceinline__ void operator()(int row, int col, float (&v)[4], float) const {
        const float rs = rstd0[row];
#pragma unroll
        for (int e = 0; e < 4; ++e) v[e] *= rs;
        const int seg = col >> 6, c64 = col & 63;
        const int b = row >> 12, s = row & 4095;
        if (seg < 12) {
            float ss = v[0] * v[0] + v[1] * v[1] + v[2] * v[2] + v[3] * v[3];
            ss = DPP_ROR_ADD(ss, 8); ss = DPP_ROR_ADD(ss, 4); ss = DPP_ROR_ADD(ss, 2); ss = DPP_ROR_ADD(ss, 1);
            const float rr = rsqrtf(ss * (1.0f / 64.0f) + EPSN);
            const float* g = seg < 8 ? qg : (seg < 10 ? kg + 64 : kg + 128);
            const f32x4 g4 = *(const f32x4*)(g + c64);
#pragma unroll
            for (int e = 0; e < 4; ++e) v[e] = v[e] * rr * g4[e];
            const bool lowhalf = c64 < 8, rot = c64 < 16;
            const float sc = seg < 8 ? 0.125f * LOG2E : 1.0f;
#pragma unroll
            for (int e = 0; e < 4; ++e) {
                const float o = __builtin_bit_cast(float, __builtin_amdgcn_update_dpp(0, __builtin_bit_cast(int, v[e]), 0x4E, 0xf, 0xf, false));
                const f32x2 c = ropen[(size_t)s * 8 + ((c64 & 7) + e)];
                const float r = lowhalf ? (v[e] * c[0] - o * c[1]) : (v[e] * c[0] + o * c[1]);
                v[e] = (rot ? r : v[e]) * sc;
            }
            bf16_t* dst = seg < 8 ? QN + ((size_t)(b * 8 + seg) * SEQ + s) * 64
                        : seg < 10 ? KS + ((size_t)(b * 2 + (seg - 8)) * SEQ + s) * 64 : KW + ((size_t)(b * 2 + (seg - 10)) * SEQ + s) * 64;
            *(u32x2*)(dst + c64) = pack4(v);
        } else if (seg < 16) {
            bf16_t* dst = seg < 14 ? KCIN + ((size_t)(b * 2 + (seg - 12)) * SEQ + s) * 64 : VCIN + ((size_t)(b * 2 + (seg - 14)) * SEQ + s) * 64;
            *(u32x2*)(dst + c64) = pack4(v);
        } else if (col < 1696) {
            *(u32x2*)(P + (size_t)row * PLD + col) = pack4(v);
        } else if (col < 1720) {
            float* gp = GATE + (size_t)row * 24 + (col - 1696);
#pragma unroll
            for (int e = 0; e < 4; ++e) gp[e] = 1.0f / (1.0f + __expf(-v[e]));
        }
    }
};
struct EpiRssNScaleBf16 {
    bf16_t* out; int ld; float inv_n;
    __device__ __forceinline__ void operator()(int row, int col, float (&v)[4], float rss) const {
        const float s = rsqrtf(rss * inv_n + EPSN);
#pragma unroll
        for (int e = 0; e < 4; ++e) v[e] *= s;
        *(u32x2*)(out + (size_t)row * ld + col) = pack4(v);
    }
};
struct EpiNull {
    __device__ __forceinline__ void operator()(int, int, float (&v)[4], float) const { asm volatile("" :: "v"(v[0]), "v"(v[1]), "v"(v[2]), "v"(v[3])); }
};
struct EpiCmpFin {
    int kv; const f32x2* ropen; const float* gain; bf16_t* KC; bf16_t* VCT;
    __device__ __forceinline__ void operator()(int row, int col, float (&v)[4], float) const {
        if (col >= 64) return;
        const int n = row & 255, bg = row >> 8;
        if (n == 255) { v[0] = 0.f; v[1] = 0.f; v[2] = 0.f; v[3] = 0.f; }
        if (kv == 0) {
            float ss = v[0] * v[0] + v[1] * v[1] + v[2] * v[2] + v[3] * v[3];
            ss = DPP_ROR_ADD(ss, 8); ss = DPP_ROR_ADD(ss, 4); ss = DPP_ROR_ADD(ss, 2); ss = DPP_ROR_ADD(ss, 1);
            const float rr = rsqrtf(ss * (1.0f / 64.0f) + EPSN);
            const f32x4 g4 = *(const f32x4*)(gain + col);
#pragma unroll
            for (int e = 0; e < 4; ++e) v[e] = v[e] * rr * g4[e];
            int pos = 16 * n + 31; if (pos > 4095) pos = 4095;
            const bool lowhalf = col < 8, rot = col < 16;
#pragma unroll
            for (int e = 0; e < 4; ++e) {
                const float o = __builtin_bit_cast(float, __builtin_amdgcn_update_dpp(0, __builtin_bit_cast(int, v[e]), 0x4E, 0xf, 0xf, false));
                const f32x2 c = ropen[(size_t)pos * 8 + ((col & 7) + e)];
                const float r = lowhalf ? (v[e] * c[0] - o * c[1]) : (v[e] * c[0] + o * c[1]);
                v[e] = rot ? r : v[e];
            }
            if (n == 255) { v[0] = 0.f; v[1] = 0.f; v[2] = 0.f; v[3] = 0.f; }
            *(u32x2*)(KC + ((size_t)bg * 256 + n) * 64 + col) = pack4(v);
        } else {
#pragma unroll
            for (int e = 0; e < 4; ++e) VCT[((size_t)bg * 64 + col + e) * 256 + n] = (bf16_t)f2bf(v[e]);
        }
    }
};
template <bool USE_RSS>
struct EpiResBf16T {
    const bf16_t* hb_in; bf16_t* hb_out;
    __device__ __forceinline__ void operator()(int row, int col, float (&v)[4], float rss) const {
        const u32x2 a = *(const u32x2*)(hb_in + (size_t)row * DM + col);
        const float sc = USE_RSS ? rss : 1.0f;
        v[0] = v[0] * sc + bflo(a.x); v[1] = v[1] * sc + bfhi(a.x); v[2] = v[2] * sc + bflo(a.y); v[3] = v[3] * sc + bfhi(a.y);
        *(u32x2*)(hb_out + (size_t)row * DM + col) = pack4(v);
    }
};
#define H2Q_CLIP 8.0f
struct EpiResBf16Q {
    const bf16_t* hb_in; bf16_t* hb_out; unsigned* hq;
    __device__ __forceinline__ void operator()(int row, int col, float (&v)[4], float) const {
        const u32x2 a = *(const u32x2*)(hb_in + (size_t)row * DM + col);
        v[0] += bflo(a.x); v[1] += bfhi(a.x); v[2] += bflo(a.y); v[3] += bfhi(a.y);
        *(u32x2*)(hb_out + (size_t)row * DM + col) = pack4(v);
        unsigned w = 0u;
#pragma unroll
        for (int e = 0; e < 4; ++e) {
            const int qi = (int)rintf(fminf(fmaxf(v[e] * (127.0f / H2Q_CLIP), -127.0f), 127.0f));
            w |= ((unsigned)qi & 0xFFu) << (8 * e);
        }
        hq[((size_t)row * DM + col) >> 2] = w;
    }
};
struct EpiRssScaleBf16 {
    bf16_t* out; int ld; float* rstd_out;
    __device__ __forceinline__ void operator()(int row, int col, float (&v)[4], float rss) const {
        const float s = rsqrtf(rss * (1.0f / 1024.0f) + EPSN);
#pragma unroll
        for (int e = 0; e < 4; ++e) v[e] *= s;
        *(u32x2*)(out + (size_t)row * ld + col) = pack4(v);
        if (rstd_out && col == 0) rstd_out[row] = s;
    }
};

#define G8_HTB 16384
#define G8_MISC_OFF 131072
__device__ __forceinline__ int g8_lds_byte(int r, int c) { const int st = (r >> 4) * 2 + (c >> 5), rr = r & 15, cc = c & 31, ob = rr * 64 + cc * 2; return st * 1024 + (ob ^ (((ob >> 9) & 1) << 5)); }
__device__ __forceinline__ void g8_stage_rc(int b, int& R, int& C) { const int st = b / 1024, sb = b % 1024, swz = sb ^ (((sb >> 9) & 1) << 5); R = (st >> 1) * 16 + swz / 64; C = (st & 1) * 32 + (swz % 64) / 2; }
__device__ __forceinline__ int g8_perm32(int rho) { const int n = rho >> 4, i = rho & 15; return 8 * (i >> 2) + 4 * n + (i & 3); }
typedef float f32x4a __attribute__((ext_vector_type(4)));
template <class Epi, bool MIXN = false>
__device__ __forceinline__ void gemm8(const bf16_t* __restrict__ A, int lda, const bf16_t* __restrict__ Bt, int ldb, int K, int nM, int nN,
                                      const Epi& E, unsigned char* lds_gen, const float* __restrict__ ssq16 = nullptr) {
    LAS unsigned char* lds = (LAS unsigned char*)lds_gen;
    const int tid = threadIdx.x, wid = __builtin_amdgcn_readfirstlane(tid >> 6), lane = tid & 63, wr = wid >> 2, wc = wid & 3, fr = lane & 15, fq = lane >> 4;
    int nt_ = K >> 6; asm volatile("" : "+s"(nt_));
    const int nt = nt_;
    const int bid = blockIdx.x, xg = bid & 7, ustride = gridDim.x >> 3, ucnt = (nM >> 3) * nN;
    int L = bid >> 3;
    if (L >= ucnt) return;
    __syncthreads();
    unsigned voffA[2], voffB[2];
#pragma unroll
    for (int i = 0; i < 2; ++i) { int R, C; g8_stage_rc(tid * 16 + i * 8192, R, C);
        voffA[i] = (unsigned)(R * lda + C) * 2u; voffB[i] = (unsigned)((64 * (R >> 5) + g8_perm32(R & 31)) * ldb + C) * 2u; }
    const size_t kstep = 128;
    const size_t hstepA = (size_t)128 * lda * 2, tstepA = 2 * hstepA;
    const size_t hstepB = (size_t)32 * ldb * 2, tstepB = (size_t)256 * ldb * 2;
    const unsigned ldsw = (unsigned)wid * 1024u;
    const int aoff = g8_lds_byte(wr * 64 + fr, fq * 8), boff = g8_lds_byte(wc * 32 + fr, fq * 8);
    LAS float* rtab = (LAS float*)(lds + G8_MISC_OFF);
#define G8_SA(b, h) (((b) * 2 + (h)) * G8_HTB)
#define G8_SB(b, h) ((4 + (b) * 2 + (h)) * G8_HTB)
#define G8_STAGE(bufoff, gbase, voff) do { _Pragma("unroll") for (int _i = 0; _i < 2; ++_i) \
        __builtin_amdgcn_global_load_lds((const unsigned*)((const char*)(gbase) + (voff)[_i]), (LAS unsigned*)(lds + (bufoff) + ldsw + _i * 8192), 16, 0, 0); } while (0)
#define G8_LDA(dst, b, h) do { _Pragma("unroll") for (int m = 0; m < 4; ++m) _Pragma("unroll") for (int k = 0; k < 2; ++k) dst[m][k] = *(const LAS bf16x8*)(lds + G8_SA(b, h) + aoff + m * 2048 + k * 1024); } while (0)
#define G8_LDB(dst, b, h) do { _Pragma("unroll") for (int n = 0; n < 2; ++n) _Pragma("unroll") for (int k = 0; k < 2; ++k) dst[n][k] = *(const LAS bf16x8*)(lds + G8_SB(b, h) + boff + n * 2048 + k * 1024); } while (0)
#define G8_MMA(ai, bj, At, Bt_) do { __builtin_amdgcn_s_setprio(1); _Pragma("unroll") for (int m = 0; m < 4; ++m) _Pragma("unroll") for (int n = 0; n < 2; ++n) _Pragma("unroll") for (int k = 0; k < 2; ++k) \
        acc[ai][bj][m][n] = __builtin_amdgcn_mfma_f32_16x16x32_bf16(Bt_[n][k], At[m][k], acc[ai][bj][m][n], 0, 0, 0); __builtin_amdgcn_s_setprio(0); } while (0)
#define G8_WAIT_V(n) asm volatile("s_waitcnt vmcnt(" #n ")" ::: "memory")
#define G8_WAIT_L(n) asm volatile("s_waitcnt lgkmcnt(" #n ")" ::: "memory")
#define G8_BAR __builtin_amdgcn_s_barrier()
#define G8_SCHED __builtin_amdgcn_sched_barrier(0)
#define G8_RTAB_FILL(pm_, par_) do { if (MIXN && tid < 256) { \
        const float* sp_ = ssq16 + (size_t)((pm_) * 256 + tid) * 16; \
        const f32x4 a0_ = *(const f32x4*)sp_, a1_ = *(const f32x4*)(sp_ + 4), b0_ = *(const f32x4*)(sp_ + 8), b1_ = *(const f32x4*)(sp_ + 12); \
        const float s1_ = ((a0_[0] + a0_[1]) + (a0_[2] + a0_[3])) + ((a1_[0] + a1_[1]) + (a1_[2] + a1_[3])); \
        const float s2_ = ((b0_[0] + b0_[1]) + (b0_[2] + b0_[3])) + ((b1_[0] + b1_[1]) + (b1_[2] + b1_[3])); \
        const float r1_ = rsqrtf(s1_ * (1.0f / 512.0f) + EPSN), r2_ = rsqrtf(s2_ * (1.0f / 512.0f) + EPSN); \
        rtab[(par_) * 512 + tid] = r1_ / r2_; rtab[(par_) * 512 + 256 + tid] = r2_; } } while (0)
    int pm = xg + 8 * (L / nN), pn = L % nN, npm = 0, npn = 0, ui = 0;
    f32x4a acc[2][2][4][2];
#pragma unroll
    for (int a = 0; a < 2; ++a)
#pragma unroll
        for (int b = 0; b < 2; ++b)
#pragma unroll
            for (int m = 0; m < 4; ++m)
#pragma unroll
                for (int n = 0; n < 2; ++n) acc[a][b][m][n] = (f32x4a){0.f, 0.f, 0.f, 0.f};
    bf16x8 At[4][2], B0[2][2], B1[2][2];
    const char* cA = (const char*)A + (size_t)pm * tstepA; const char* cB = (const char*)Bt + (size_t)pn * tstepB;
    G8_RTAB_FILL(pm, 0);
    G8_STAGE(G8_SB(0, 0), cB, voffB); G8_STAGE(G8_SA(0, 0), cA, voffA); G8_STAGE(G8_SB(0, 1), cB + hstepB, voffB); G8_STAGE(G8_SA(0, 1), cA + hstepA, voffA);
    if (wr == 1) G8_BAR;
    G8_WAIT_V(4); G8_BAR;
    G8_STAGE(G8_SB(1, 0), cB + kstep, voffB); G8_STAGE(G8_SA(1, 0), cA + kstep, voffA); G8_STAGE(G8_SB(1, 1), cB + hstepB + kstep, voffB);
    G8_WAIT_V(6); G8_BAR;
    for (;;) {
        const int Ln = L + ustride;
        const bool has_next = Ln < ucnt;
        if (has_next) { npm = xg + 8 * (Ln / nN); npn = Ln % nN; }
        const char* nA = has_next ? (const char*)A + (size_t)npm * tstepA : cA; const char* nB = has_next ? (const char*)Bt + (size_t)npn * tstepB : cB;
        for (int t = 0; t < nt; t += 2) {
            const bool last = (t == nt - 2);
            const char* a1 = cA + (size_t)(t + 1) * kstep;
            const char* a2 = last ? nA : cA + (size_t)(t + 2) * kstep; const char* b2 = last ? nB : cB + (size_t)(t + 2) * kstep;
            const char* a3 = a2 + kstep; const char* b3 = b2 + kstep;
            if (MIXN && t == (nt >> 1)) {
#pragma unroll
                for (int ai = 0; ai < 2; ++ai)
#pragma unroll
                    for (int m = 0; m < 4; ++m) { const float f = rtab[(ui & 1) * 512 + ai * 128 + wr * 64 + m * 16 + (tid & 15)];
#pragma unroll
                        for (int bj = 0; bj < 2; ++bj)
#pragma unroll
                            for (int n = 0; n < 2; ++n) acc[ai][bj][m][n] *= f; }
            }
            if (MIXN && last && has_next) G8_RTAB_FILL(npm, (ui + 1) & 1);
            G8_LDB(B0, 0, 0); G8_SCHED; G8_LDA(At, 0, 0); G8_STAGE(G8_SA(1, 1), a1 + hstepA, voffA);
            G8_WAIT_L(8); G8_BAR; G8_WAIT_L(0); G8_MMA(0, 0, At, B0); G8_BAR; G8_SCHED;
            G8_LDB(B1, 0, 1); G8_STAGE(G8_SB(0, 0), b2, voffB);
            G8_BAR; G8_WAIT_L(0); G8_MMA(0, 1, At, B1); G8_BAR;
            G8_LDA(At, 0, 1); G8_STAGE(G8_SA(0, 0), a2, voffA);
            G8_BAR; G8_WAIT_L(0); G8_MMA(1, 0, At, B0); G8_BAR; G8_SCHED;
            G8_STAGE(G8_SB(0, 1), b2 + hstepB, voffB);
            G8_WAIT_V(6); G8_BAR; G8_MMA(1, 1, At, B1); G8_BAR;
            G8_LDB(B0, 1, 0); G8_SCHED; G8_LDA(At, 1, 0); G8_STAGE(G8_SA(0, 1), a2 + hstepA, voffA);
            G8_WAIT_L(8); G8_BAR; G8_WAIT_L(0); G8_MMA(0, 0, At, B0); G8_BAR; G8_SCHED;
            G8_LDB(B1, 1, 1); G8_STAGE(G8_SB(1, 0), b3, voffB);
            G8_BAR; G8_WAIT_L(0); G8_MMA(0, 1, At, B1); G8_BAR;
            G8_LDA(At, 1, 1); G8_STAGE(G8_SA(1, 0), a3, voffA);
            G8_BAR; G8_WAIT_L(0); G8_MMA(1, 0, At, B0); G8_BAR; G8_SCHED;
            G8_STAGE(G8_SB(1, 1), b3 + hstepB, voffB);
            G8_WAIT_V(6); G8_BAR; G8_MMA(1, 1, At, B1); G8_BAR;
        }
        {
            const int col0 = pn * 256 + wc * 64;
            int tid_e = tid; asm volatile("" : "+v"(tid_e));
            const int fr_e = tid_e & 15, fq_e = (tid_e >> 4) & 3;
            typename Epi::Pre pre[2][4];
#pragma unroll
            for (int ai = 0; ai < 2; ++ai)
#pragma unroll
                for (int m = 0; m < 4; ++m) pre[ai][m] = E.pre(pm * 256 + ai * 128 + wr * 64 + m * 16 + fr_e, col0, fq_e);
#pragma unroll
            for (int ai = 0; ai < 2; ++ai)
#pragma unroll
                for (int m = 0; m < 4; ++m) {
                    const int rl = ai * 128 + wr * 64 + m * 16 + fr_e;
                    float v[2][8];
#pragma unroll
                    for (int bj = 0; bj < 2; ++bj)
#pragma unroll
                        for (int n = 0; n < 2; ++n)
#pragma unroll
                            for (int e = 0; e < 4; ++e) v[bj][4 * n + e] = acc[ai][bj][m][n][e];
                    E(pm * 256 + rl, col0, fq_e, v, MIXN ? rtab[(ui & 1) * 512 + 256 + rl] : 0.f, pre[ai][m]);
                }
        }
        if (!has_next) break;
#pragma unroll
        for (int a = 0; a < 2; ++a)
#pragma unroll
            for (int b = 0; b < 2; ++b)
#pragma unroll
                for (int m = 0; m < 4; ++m)
#pragma unroll
                    for (int n = 0; n < 2; ++n) acc[a][b][m][n] = (f32x4a){0.f, 0.f, 0.f, 0.f};
        pm = npm; pn = npn; cA = nA; cB = nB; L = Ln; ++ui;
    }
    G8_WAIT_V(0);
    if (wr == 0) G8_BAR;
    G8_BAR;
#undef G8_SA
#undef G8_SB
#undef G8_STAGE
#undef G8_LDA
#undef G8_LDB
#undef G8_MMA
#undef G8_WAIT_V
#undef G8_WAIT_L
#undef G8_BAR
#undef G8_SCHED
#undef G8_RTAB_FILL
}

#ifndef FULL_LINE
#define FULL_LINE 0
#endif
__device__ __forceinline__ void rows16_xchg(u32x4& a0, u32x4& a1, bool hi) {
    if (!FULL_LINE) return;
    u32x4 send, recv;
#pragma unroll
    for (int q = 0; q < 4; ++q) send[q] = hi ? a0[q] : a1[q];
#pragma unroll
    for (int q = 0; q < 4; ++q) recv[q] = (unsigned)__builtin_amdgcn_update_dpp(0, (int)send[q], 0x128, 0xf, 0xf, false);
#pragma unroll
    for (int q = 0; q < 4; ++q) { a0[q] = hi ? recv[q] : a0[q]; a1[q] = hi ? a1[q] : recv[q]; }
}
__device__ __forceinline__ void rows16_xchg2(u32x2& a0, u32x2& a1, bool hi) {
    if (!FULL_LINE) return;
    u32x2 send, recv;
#pragma unroll
    for (int q = 0; q < 2; ++q) send[q] = hi ? a0[q] : a1[q];
#pragma unroll
    for (int q = 0; q < 2; ++q) recv[q] = (unsigned)__builtin_amdgcn_update_dpp(0, (int)send[q], 0x128, 0xf, 0xf, false);
#pragma unroll
    for (int q = 0; q < 2; ++q) { a0[q] = hi ? recv[q] : a0[q]; a1[q] = hi ? a1[q] : recv[q]; }
}
__device__ __forceinline__ bf16_t* rows16_ptr(bf16_t* own, size_t ld, int fr, int fq) { return FULL_LINE ? own - (size_t)(fr & 8) * ld + 32 * (fr >> 3) + 8 * fq : own + 8 * fq; }
__device__ __forceinline__ const bf16_t* rows16_ptr(const bf16_t* own, size_t ld, int fr, int fq) { return FULL_LINE ? own - (size_t)(fr & 8) * ld + 32 * (fr >> 3) + 8 * fq : own + 8 * fq; }
__device__ __forceinline__ size_t rows16_step(size_t ld) { return FULL_LINE ? 8 * ld : 32; }
__device__ __forceinline__ void st_rows16(bf16_t* own, size_t ld, int fr, int fq, u32x4 a0, u32x4 a1) {
    rows16_xchg(a0, a1, fr >= 8);
    bf16_t* p = rows16_ptr(own, ld, fr, fq);
    *(u32x4*)p = a0; *(u32x4*)(p + rows16_step(ld)) = a1;
}
__device__ __forceinline__ float fq_sum(float x) {
    u32x2 s = __builtin_amdgcn_permlane16_swap(__float_as_uint(x), __float_as_uint(x), false, false);
    x = __uint_as_float(s.x) + __uint_as_float(s.y);
    s = __builtin_amdgcn_permlane32_swap(__float_as_uint(x), __float_as_uint(x), false, false);
    return __uint_as_float(s.x) + __uint_as_float(s.y);
}
__device__ __forceinline__ float fq_xor1(float x, int fq) {
    const u32x2 s = __builtin_amdgcn_permlane16_swap(__float_as_uint(x), __float_as_uint(x), false, false);
    return __uint_as_float((fq & 1) ? s.x : s.y);
}
__device__ __forceinline__ void fq_bcast23(float x, float& r2, float& r3) {
    const u32x2 s = __builtin_amdgcn_permlane32_swap(__float_as_uint(x), __float_as_uint(x), false, false);
    const u32x2 t = __builtin_amdgcn_permlane16_swap(s.y, s.y, false, false);
    r2 = __uint_as_float(t.x); r3 = __uint_as_float(t.y);
}
struct Epi8ResBf16Q {
    const bf16_t* hb_in; bf16_t* hb_out; unsigned* hq; float* ssq;
    struct Pre { u32x4 r[2]; };
    __device__ __forceinline__ Pre pre(int row, int col0, int fq) const {
        Pre p; const bf16_t* s = rows16_ptr(hb_in + (size_t)row * DM + col0, DM, row & 15, fq); p.r[0] = *(const u32x4*)s; p.r[1] = *(const u32x4*)(s + rows16_step(DM)); return p; }
    __device__ __forceinline__ void operator()(int row, int col0, int fq, float (&v)[2][8], float, const Pre& p) const {
        float ss = 0.f;
        const int fr = row & 15;
        u32x4 hin[2] = {p.r[0], p.r[1]};
        rows16_xchg(hin[0], hin[1], fr >= 8);
        u32x4 ob[2]; u32x2 oq[2];
#pragma unroll
        for (int bj = 0; bj < 2; ++bj) {
            float x[8]; unpack8(hin[bj], x);
#pragma unroll
            for (int e = 0; e < 8; ++e) { v[bj][e] += x[e]; ss += v[bj][e] * v[bj][e]; }
            ob[bj] = pack8(v[bj]);
            unsigned w[2] = {0u, 0u};
#pragma unroll
            for (int e = 0; e < 8; ++e) {
                const int qi = (int)rintf(fminf(fmaxf(v[bj][e] * (127.0f / H2Q_CLIP), -127.0f), 127.0f));
                w[e >> 2] |= ((unsigned)qi & 0xFFu) << (8 * (e & 3));
            }
            oq[bj] = (u32x2){w[0], w[1]};
        }
        st_rows16(hb_out + (size_t)row * DM + col0, DM, fr, fq, ob[0], ob[1]);
        rows16_xchg2(oq[0], oq[1], fr >= 8);
        {
            unsigned char* qp = FULL_LINE ? (unsigned char*)hq + (size_t)(row - (fr & 8)) * DM + col0 + 32 * (fr >> 3) + 8 * fq : (unsigned char*)hq + (size_t)row * DM + col0 + 8 * fq;
            *(u32x2*)qp = oq[0]; *(u32x2*)(qp + rows16_step(DM)) = oq[1];
        }
        ss = fq_sum(ss);
        if (fq == 0) ssq[(size_t)row * 16 + (col0 >> 6)] = ss;
    }
};
struct Epi8RssScaleBf16 {
    bf16_t* out; int ld; const float* ssq; float* rstd_out;
    struct Pre { f32x4 s; };
    __device__ __forceinline__ Pre pre(int row, int, int fq) const { Pre p; p.s = *(const f32x4*)(ssq + (size_t)row * 16 + 4 * fq); return p; }
    __device__ __forceinline__ void operator()(int row, int col0, int fq, float (&v)[2][8], float, const Pre& p) const {
        float t = (p.s[0] + p.s[1]) + (p.s[2] + p.s[3]);
        t = fq_sum(t);
        const float s = rsqrtf(t * (1.0f / 1024.0f) + EPSN);
#pragma unroll
        for (int bj = 0; bj < 2; ++bj)
#pragma unroll
            for (int e = 0; e < 8; ++e) v[bj][e] *= s;
        st_rows16(out + (size_t)row * ld + col0, ld, row & 15, fq, pack8(v[0]), pack8(v[1]));
        if (rstd_out && col0 == 0 && fq == 0) rstd_out[row] = s;
    }
};
struct Epi8ResBf16S {
    const bf16_t* hb_in; bf16_t* hb_out; float* ssq;
    struct Pre { u32x4 r[2]; };
    __device__ __forceinline__ Pre pre(int row, int col0, int fq) const {
        Pre p; const bf16_t* s = rows16_ptr(hb_in + (size_t)row * DM + col0, DM, row & 15, fq); p.r[0] = *(const u32x4*)s; p.r[1] = *(const u32x4*)(s + rows16_step(DM)); return p; }
    __device__ __forceinline__ void operator()(int row, int col0, int fq, float (&v)[2][8], float aux, const Pre& p) const {
        float ss = 0.f;
        const int fr = row & 15;
        u32x4 hin[2] = {p.r[0], p.r[1]};
        rows16_xchg(hin[0], hin[1], fr >= 8);
#pragma unroll
        for (int bj = 0; bj < 2; ++bj) {
            float x[8]; unpack8(hin[bj], x);
#pragma unroll
            for (int e = 0; e < 8; ++e) { v[bj][e] = v[bj][e] * aux + x[e]; ss += v[bj][e] * v[bj][e]; }
        }
        st_rows16(hb_out + (size_t)row * DM + col0, DM, fr, fq, pack8(v[0]), pack8(v[1]));
        ss = fq_sum(ss);
        if (fq == 0) ssq[(size_t)row * 16 + (col0 >> 6)] = ss;
    }
};
struct Epi8RowScaleBf16 {
    bf16_t* out; int ld; const float* scale;
    struct Pre { float s; };
    __device__ __forceinline__ Pre pre(int row, int, int) const { Pre p; p.s = scale[row]; return p; }
    __device__ __forceinline__ void operator()(int row, int col0, int fq, float (&v)[2][8], float, const Pre& p) const {
#pragma unroll
        for (int bj = 0; bj < 2; ++bj)
#pragma unroll
            for (int e = 0; e < 8; ++e) v[bj][e] *= p.s;
        st_rows16(out + (size_t)row * ld + col0, ld, row & 15, fq, pack8(v[0]), pack8(v[1]));
    }
};
struct Epi8InProj {
    const float* rstd0; bf16_t* P; bf16_t* QN; bf16_t* KS; bf16_t* KW; bf16_t* KCIN; bf16_t* VCIN; float* GATE;
    const f32x2* ropen; const float* qg; const float* kg; float* CSSQ;
    struct Pre { float rs; };
    __device__ __forceinline__ Pre pre(int row, int, int) const { Pre p; p.rs = rstd0[row]; return p; }
    __device__ __forceinline__ void operator()(int row, int col0, int fq, float (&v)[2][8], float, const Pre& p) const {
        const int seg = col0 >> 6;
        const int b = row >> 12, s = row & 4095;
#pragma unroll
        for (int bj = 0; bj < 2; ++bj)
#pragma unroll
            for (int e = 0; e < 8; ++e) v[bj][e] *= p.rs;
        if (seg < 12) {
            float ss = 0.f;
#pragma unroll
            for (int bj = 0; bj < 2; ++bj)
#pragma unroll
                for (int e = 0; e < 8; ++e) ss += v[bj][e] * v[bj][e];
            ss = fq_sum(ss);
            const float rr = rsqrtf(ss * (1.0f / 64.0f) + EPSN);
            const float* g = seg < 8 ? qg : (seg < 10 ? kg + 64 : kg + 128);
#pragma unroll
            for (int bj = 0; bj < 2; ++bj) {
                const f32x4 g0 = *(const f32x4*)(g + 32 * bj + 8 * fq), g1 = *(const f32x4*)(g + 32 * bj + 8 * fq + 4);
#pragma unroll
                for (int e = 0; e < 4; ++e) { v[bj][e] *= rr * g0[e]; v[bj][4 + e] *= rr * g1[e]; }
            }
            const f32x4* rp = (const f32x4*)(ropen + (size_t)s * 8);
            const f32x4 c01 = rp[0], c23 = rp[1], c45 = rp[2], c67 = rp[3];
            const float cs[8] = {c01[0], c01[2], c23[0], c23[2], c45[0], c45[2], c67[0], c67[2]};
            const float sn[8] = {c01[1], c01[3], c23[1], c23[3], c45[1], c45[3], c67[1], c67[3]};
            const float sc = seg < 8 ? 0.125f * LOG2E : 1.0f;
#pragma unroll
            for (int j = 0; j < 8; ++j) {
                const float o = fq_xor1(v[0][j], fq);
                const float r = fq == 0 ? (v[0][j] * cs[j] - o * sn[j]) : (v[0][j] * cs[j] + o * sn[j]);
                v[0][j] = fq < 2 ? r : v[0][j];
            }
#pragma unroll
            for (int bj = 0; bj < 2; ++bj)
#pragma unroll
                for (int e = 0; e < 8; ++e) v[bj][e] *= sc;
            bf16_t* dst = seg < 8 ? QN + ((size_t)(b * 8 + seg) * SEQ + s) * 64
                        : seg < 10 ? KS + ((size_t)(b * 2 + (seg - 8)) * SEQ + s) * 64 : KW + ((size_t)(b * 2 + (seg - 10)) * SEQ + s) * 64;
            st_rows16(dst, 64, row & 15, fq, pack8(v[0]), pack8(v[1]));
        } else if (seg < 16) {
            bf16_t* dst = seg < 14 ? KCIN + ((size_t)(b * 2 + (seg - 12)) * SEQ + s) * 64 : VCIN + ((size_t)(b * 2 + (seg - 14)) * SEQ + s) * 64;
            st_rows16(dst, 64, row & 15, fq, pack8(v[0]), pack8(v[1]));
        } else if (seg < 26) {
            bf16_t* dst = P + (size_t)row * PLD + col0;
            st_rows16(dst, PLD, row & 15, fq, pack8(v[0]), pack8(v[1]));
            if (seg >= 20) {
                float ss = 0.f;
#pragma unroll
                for (int bj = 0; bj < 2; ++bj)
#pragma unroll
                    for (int e = 0; e < 8; ++e) ss += v[bj][e] * v[bj][e];
                ss = fq_sum(ss);
                if (fq == 0) CSSQ[(size_t)row * 8 + (seg - 20)] = ss;
            }
        } else if (seg == 26) {
            *(u32x4*)(P + (size_t)row * PLD + col0 + 8 * fq) = pack8(v[0]);
            {
                float ss = 0.f;
#pragma unroll
                for (int e = 0; e < 8; ++e) ss += v[0][e] * v[0][e];
                ss = fq_sum(ss);
                if (fq == 0) CSSQ[(size_t)row * 8 + 6] = ss;
            }
            if (fq < 3) {
                float* gp = GATE + (size_t)row * 24 + 8 * fq;
                f32x4 a, c;
#pragma unroll
                for (int e = 0; e < 4; ++e) { a[e] = 1.0f / (1.0f + __expf(-v[1][e])); c[e] = 1.0f / (1.0f + __expf(-v[1][4 + e])); }
                *(f32x4*)gp = a; *(f32x4*)(gp + 4) = c;
            }
        }
    }
};
struct Epi8QUp {
    bf16_t* out; int ld; const float* cssq;
    struct Pre { float s; };
    __device__ __forceinline__ Pre pre(int row, int, int fq) const { Pre p; p.s = cssq[(size_t)row * 8 + fq]; return p; }
    __device__ __forceinline__ void operator()(int row, int col0, int fq, float (&v)[2][8], float, const Pre& p) const {
        const float t = fq_sum(p.s);
        const float s = rsqrtf(t * (1.0f / 256.0f) + EPSN);
#pragma unroll
        for (int bj = 0; bj < 2; ++bj)
#pragma unroll
            for (int e = 0; e < 8; ++e) v[bj][e] *= s;
        st_rows16(out + (size_t)row * ld + col0, ld, row & 15, fq, pack8(v[0]), pack8(v[1]));
    }
};
struct Epi8KvUp {
    const float* cssq; const bf16_t* P; const f32x2* ropem; const float* kg; bf16_t* KM; bf16_t* KVR;
    struct Pre { f32x2 s; };
    __device__ __forceinline__ Pre pre(int row, int, int fq) const { Pre p; p.s = *(const f32x2*)(cssq + (size_t)row * 8 + 2 * fq); return p; }
    __device__ __forceinline__ void operator()(int row, int col0, int fq, float (&v)[2][8], float, const Pre& p) const {
        float ckv, kpe, dummy;
        fq_bcast23(p.s[0] + p.s[1], ckv, dummy);
        fq_bcast23(p.s[0], dummy, kpe);
        const float rc = rsqrtf(ckv * (1.0f / 128.0f) + EPSN);
#pragma unroll
        for (int bj = 0; bj < 2; ++bj)
#pragma unroll
            for (int e = 0; e < 8; ++e) v[bj][e] *= rc;
        const int seg = col0 >> 6, head = seg >> 1;
        if (seg & 1) {
            bf16_t* dst = KVR + (size_t)row * 1024 + head * 128 + 64;
            st_rows16(dst, 1024, row & 15, fq, pack8(v[0]), pack8(v[1]));
        } else {
            const int b = row >> 12, s = row & 4095;
            float ss = 0.f;
#pragma unroll
            for (int bj = 0; bj < 2; ++bj)
#pragma unroll
                for (int e = 0; e < 8; ++e) ss += v[bj][e] * v[bj][e];
            ss = fq_sum(ss);
            const float r = rsqrtf((ss + kpe) * (1.0f / 96.0f) + EPSN);
            bf16_t* kp = KM + ((size_t)(b * 8 + head) * SEQ + s) * 96;
#pragma unroll
            for (int bj = 0; bj < 2; ++bj) {
                const f32x4 g0 = *(const f32x4*)(kg + 32 * bj + 8 * fq), g1 = *(const f32x4*)(kg + 32 * bj + 8 * fq + 4);
#pragma unroll
                for (int e = 0; e < 4; ++e) { v[bj][e] *= r * g0[e]; v[bj][4 + e] *= r * g1[e]; }
            }
            st_rows16(kp, 96, row & 15, fq, pack8(v[0]), pack8(v[1]));
            const u32x2 x1w = *(const u32x2*)(P + (size_t)row * PLD + C_KPE + 4 * fq), x2w = *(const u32x2*)(P + (size_t)row * PLD + C_KPE + 16 + 4 * fq);
            const f32x4 cs0 = *(const f32x4*)(ropem + (size_t)s * 16 + 4 * fq), cs1 = *(const f32x4*)(ropem + (size_t)s * 16 + 4 * fq + 2);
            const f32x4 ga = *(const f32x4*)(kg + 64 + 4 * fq), gb = *(const f32x4*)(kg + 80 + 4 * fq);
            const float x1[4] = {bflo(x1w.x), bfhi(x1w.x), bflo(x1w.y), bfhi(x1w.y)}, x2[4] = {bflo(x2w.x), bfhi(x2w.x), bflo(x2w.y), bfhi(x2w.y)};
            const float cc[4] = {cs0[0], cs0[2], cs1[0], cs1[2]}, sn[4] = {cs0[1], cs0[3], cs1[1], cs1[3]};
            float y1[4], y2[4];
#pragma unroll
            for (int e = 0; e < 4; ++e) { const float a1 = x1[e] * r * ga[e], a2 = x2[e] * r * gb[e]; y1[e] = a1 * cc[e] - a2 * sn[e]; y2[e] = a2 * cc[e] + a1 * sn[e]; }
            *(u32x2*)(kp + 64 + 4 * fq) = pack4(y1); *(u32x2*)(kp + 80 + 4 * fq) = pack4(y2);
        }
    }
};

__device__ __forceinline__ int inproj_src_col(int n) {
    if (n < 512) return 416 + n;
    if (n < 640) return 1184 + (n - 512);
    if (n < 768) return 1440 + (n - 640);
    if (n < 896) return 928 + (n - 768);
    if (n < 1024) return 1056 + (n - 896);
    if (n < 1152) return 1312 + (n - 1024);
    if (n < 1280) return 1568 + (n - 1152);
    if (n < 1536) return n - 1280;
    if (n < 1664) return 256 + (n - 1536);
    if (n < 1696) return 384 + (n - 1664);
    if (n < 1720) return n;
    return -1;
}
template <bool PERM = false>
__device__ __forceinline__ void wt_tile(const float* __restrict__ W, int N, const float* __restrict__ gain, bf16_t* __restrict__ Wt, int ldt,
                                        int kt, int nt, float* tile, bool valid) {
    const int tid = threadIdx.x & 255;
    tile += (threadIdx.x >> 8) * (64 * 65);
    __syncthreads();
    if (valid) {
        const int i = tid >> 4, j4 = (tid & 15) * 4;
#pragma unroll
        for (int rr = 0; rr < 4; ++rr) {
            const int k = kt * 64 + i + 16 * rr, nd = nt * 64 + j4;
            const int n = PERM ? inproj_src_col(nd) : (nd < N ? nd : -1);
            f32x4 v = (f32x4){0.f, 0.f, 0.f, 0.f};
            if (n >= 0) v = *(const f32x4*)(W + (size_t)k * N + n);
            const float g = gain ? gain[k] : 1.0f;
            float* tp = tile + (i + 16 * rr) * 65 + j4;
            tp[0] = v[0] * g; tp[1] = v[1] * g; tp[2] = v[2] * g; tp[3] = v[3] * g;
        }
    }
    __syncthreads();
    if (valid) {
        const int j = tid >> 2, ic = (tid & 3) * 16;
        float a[8], b[8];
#pragma unroll
        for (int e = 0; e < 8; ++e) { a[e] = tile[(ic + e) * 65 + j]; b[e] = tile[(ic + 8 + e) * 65 + j]; }
        bf16_t* dp = Wt + (size_t)(nt * 64 + j) * ldt + kt * 64 + ic;
        *(u32x4*)dp = pack8(a); *(u32x4*)(dp + 8) = pack8(b);
    }
    __syncthreads();
}

__device__ __forceinline__ void tr_tile(const bf16_t* __restrict__ src, size_t src_ld, bf16_t* __restrict__ dst, size_t dst_ld, bf16_t* tile, bool valid) {
    const int tid = threadIdx.x & 255;
    tile += (threadIdx.x >> 8) * (64 * 66);
    __syncthreads();
    if (valid) {
        const int r = tid >> 2, c = (tid & 3) * 16;
        const u32x4 a = *(const u32x4*)(src + (size_t)r * src_ld + c), b = *(const u32x4*)(src + (size_t)r * src_ld + c + 8);
        unsigned* tp = (unsigned*)(tile + r * 66 + c);
        tp[0] = a.x; tp[1] = a.y; tp[2] = a.z; tp[3] = a.w; tp[4] = b.x; tp[5] = b.y; tp[6] = b.z; tp[7] = b.w;
    }
    __syncthreads();
    if (valid) {
        const int c = tid >> 2, r0 = (tid & 3) * 16;
        unsigned o[8];
#pragma unroll
        for (int e = 0; e < 8; ++e) o[e] = (unsigned)tile[(r0 + 2 * e) * 66 + c] | ((unsigned)tile[(r0 + 2 * e + 1) * 66 + c] << 16);
        bf16_t* dp = dst + (size_t)c * dst_ld + r0;
        *(u32x4*)dp = (u32x4){o[0], o[1], o[2], o[3]}; *(u32x4*)(dp + 8) = (u32x4){o[4], o[5], o[6], o[7]};
    }
    __syncthreads();
}

static __device__ const double INV_MLA[16] = {1.0, 0.44036660267178046, 0.19392274474868576, 0.08539710028576561, 0.03760603093086393, 0.016560440080994446,
    0.007292664737217109, 0.003211445994752591, 0.001414213562373095, 0.000622772421914596, 0.0002742481756762073, 0.00012076973741146504,
    5.318295896944988e-05, 2.341999896140934e-05, 1.031338537721246e-05, 4.5416704806078695e-06};
__device__ __forceinline__ f32x2 rope_cs(int pos, double inv) {
    double rev = (double)pos * inv * 0.15915494309189535;
    rev -= __builtin_floor(rev);
    const float rf = (float)rev;
    return (f32x2){__builtin_amdgcn_cosf(rf), __builtin_amdgcn_sinf(rf)};
}

__device__ __forceinline__ void rows_to_bf16(const float* __restrict__ x, bf16_t* __restrict__ xb, float* __restrict__ rstd, const float* __restrict__ gain,
                                             int nrows, int gw, int nw, int lane) {
    for (int r = gw; r < nrows; r += nw) {
        const float* xp = x + (size_t)r * 1024 + lane * 8;
        const f32x4 a = *(const f32x4*)xp, b = *(const f32x4*)(xp + 4), c = *(const f32x4*)(xp + 512), d = *(const f32x4*)(xp + 516);
        float v0[8] = {a[0], a[1], a[2], a[3], b[0], b[1], b[2], b[3]}, v1[8] = {c[0], c[1], c[2], c[3], d[0], d[1], d[2], d[3]};
        if (rstd) {
            float s = 0.f;
#pragma unroll
            for (int e = 0; e < 8; ++e) s += v0[e] * v0[e] + v1[e] * v1[e];
            s = wave_sum(s);
            if (lane == 0) rstd[r] = rsqrtf(s * (1.0f / 1024.0f) + EPSN);
        }
        if (gain) {
            const f32x4 ga = *(const f32x4*)(gain + lane * 8), gb = *(const f32x4*)(gain + lane * 8 + 4), gc = *(const f32x4*)(gain + 512 + lane * 8), gd = *(const f32x4*)(gain + 516 + lane * 8);
#pragma unroll
            for (int e = 0; e < 4; ++e) { v0[e] *= ga[e]; v0[4 + e] *= gb[e]; v1[e] *= gc[e]; v1[4 + e] *= gd[e]; }
        }
        bf16_t* op = xb + (size_t)r * 1024 + lane * 8;
        *(u32x4*)op = pack8(v0); *(u32x4*)(op + 512) = pack8(v1);
    }
}

#define U_SCALE 64.0f
#define V_SCALE 8.0f
__device__ __forceinline__ void rows_to_slices(const float* __restrict__ x, unsigned char* __restrict__ dst, const float* __restrict__ gain, float scale, int gw, int nw, int lane) {
    for (int r = gw; r < 16384; r += nw) {
        const float* xp = x + (size_t)r * 1024 + lane * 8;
        const f32x4 a = *(const f32x4*)xp, b = *(const f32x4*)(xp + 4), c = *(const f32x4*)(xp + 512), d = *(const f32x4*)(xp + 516);
        float v0[8] = {a[0], a[1], a[2], a[3], b[0], b[1], b[2], b[3]}, v1[8] = {c[0], c[1], c[2], c[3], d[0], d[1], d[2], d[3]};
        if (gain) {
            const f32x4 ga = *(const f32x4*)(gain + lane * 8), gb = *(const f32x4*)(gain + lane * 8 + 4), gc = *(const f32x4*)(gain + 512 + lane * 8), gd = *(const f32x4*)(gain + 516 + lane * 8);
#pragma unroll
            for (int e = 0; e < 4; ++e) { v0[e] *= ga[e]; v0[4 + e] *= gb[e]; v1[e] *= gc[e]; v1[4 + e] *= gd[e]; }
        }
#pragma unroll
        for (int e = 0; e < 8; ++e) { v0[e] *= scale; v1[e] *= scale; }
        u32x2 p0, p1;
        { int t = __builtin_amdgcn_cvt_pk_fp8_f32(v0[0], v0[1], 0, false); t = __builtin_amdgcn_cvt_pk_fp8_f32(v0[2], v0[3], t, true); p0.x = (unsigned)t;
          t = __builtin_amdgcn_cvt_pk_fp8_f32(v0[4], v0[5], 0, false); t = __builtin_amdgcn_cvt_pk_fp8_f32(v0[6], v0[7], t, true); p0.y = (unsigned)t;
          t = __builtin_amdgcn_cvt_pk_fp8_f32(v1[0], v1[1], 0, false); t = __builtin_amdgcn_cvt_pk_fp8_f32(v1[2], v1[3], t, true); p1.x = (unsigned)t;
          t = __builtin_amdgcn_cvt_pk_fp8_f32(v1[4], v1[5], 0, false); t = __builtin_amdgcn_cvt_pk_fp8_f32(v1[6], v1[7], t, true); p1.y = (unsigned)t; }
        const int sl = lane >> 4, off = (lane & 15) * 8;
        *(u32x2*)(dst + ((size_t)sl * 16384 + r) * 128 + off) = p0;
        *(u32x2*)(dst + ((size_t)(4 + sl) * 16384 + r) * 128 + off) = p1;
    }
}

__device__ __forceinline__ void rows_to_slices_i8(const float* __restrict__ x, unsigned char* __restrict__ dst, const float* __restrict__ gain, float* __restrict__ row_scale,
                                                  int gw, int nw, int lane) {
    for (int r = gw; r < 16384; r += nw) {
        const float* xp = x + (size_t)r * 1024 + lane * 8;
        const f32x4 a = *(const f32x4*)xp, b = *(const f32x4*)(xp + 4), c = *(const f32x4*)(xp + 512), d = *(const f32x4*)(xp + 516);
        float v0[8] = {a[0], a[1], a[2], a[3], b[0], b[1], b[2], b[3]}, v1[8] = {c[0], c[1], c[2], c[3], d[0], d[1], d[2], d[3]};
        const f32x4 ga = *(const f32x4*)(gain + lane * 8), gb = *(const f32x4*)(gain + lane * 8 + 4), gc = *(const f32x4*)(gain + 512 + lane * 8), gd = *(const f32x4*)(gain + 516 + lane * 8);
        float mx = 0.f;
#pragma unroll
        for (int e = 0; e < 4; ++e) { v0[e] *= ga[e]; v0[4 + e] *= gb[e]; v1[e] *= gc[e]; v1[4 + e] *= gd[e]; }
#pragma unroll
        for (int e = 0; e < 8; ++e) mx = fmaxf(mx, fmaxf(fabsf(v0[e]), fabsf(v1[e])));
        mx = fmaxf(mx, __shfl_xor(mx, 32)); mx = fmaxf(mx, __shfl_xor(mx, 16)); mx = fmaxf(mx, __shfl_xor(mx, 8));
        mx = fmaxf(mx, __shfl_xor(mx, 4)); mx = fmaxf(mx, __shfl_xor(mx, 2)); mx = fmaxf(mx, __shfl_xor(mx, 1));
        const float inv = mx > 0.f ? 127.0f / mx : 0.f;
        unsigned w[4] = {0u, 0u, 0u, 0u};
#pragma unroll
        for (int e = 0; e < 8; ++e) {
            const int q0 = (int)rintf(v0[e] * inv), q1 = (int)rintf(v1[e] * inv);
            w[e >> 2] |= ((unsigned)q0 & 0xFFu) << (8 * (e & 3));
            w[2 + (e >> 2)] |= ((unsigned)q1 & 0xFFu) << (8 * (e & 3));
        }
        const int sl = lane >> 4, off = (lane & 15) * 8;
        *(u32x2*)(dst + ((size_t)sl * 16384 + r) * 128 + off) = (u32x2){w[0], w[1]};
        *(u32x2*)(dst + ((size_t)(4 + sl) * 16384 + r) * 128 + off) = (u32x2){w[2], w[3]};
        if (lane == 0) row_scale[r] = mx * (1.0f / 127.0f);
    }
}

struct WtJob { const float* W; int K, N, Npad; const float* gain; bf16_t* Wt; int ldt; };

__device__ __forceinline__ void phase_prep(const Args& a, unsigned char* lds) {
    unsigned char* ws = a.ws;
    const int tid = threadIdx.x, lane = tid & 63, w = tid >> 6;
    const int gw = blockIdx.x * NWV + w, nw = gridDim.x * NWV;
    rows_to_bf16(a.in[0], (bf16_t*)(ws + WS_XB), (float*)(ws + WS_RSTD0), nullptr, T_TOK, gw, nw, lane);
    rows_to_bf16(a.in[1], (bf16_t*)(ws + WS_MEMB), (float*)(ws + WS_RSTDMEM), nullptr, 4096, gw, nw, lane);
    rows_to_slices_i8(a.in[25], ws + WS_UB, a.in[22], (float*)(ws + WS_USCALE), gw, nw, lane);
    rows_to_slices(a.in[26], ws + WS_VB, nullptr, V_SCALE, gw, nw, lane);
    for (int i = blockIdx.x * NT + tid; i < 131072 / 8; i += gridDim.x * NT) {
        const float* kp = a.in[24] + (size_t)i * 8;
        const f32x4 p = *(const f32x4*)kp, q = *(const f32x4*)(kp + 4);
        float v[8] = {p[0], p[1], p[2], p[3], q[0], q[1], q[2], q[3]};
        *(u32x4*)((bf16_t*)(ws + WS_KP) + (size_t)i * 8) = pack8(v);
    }
    for (int i = blockIdx.x * NT + tid; i < 4096 * 16; i += gridDim.x * NT) {
        const int pos = i >> 4, f = i & 15;
        ((f32x2*)(ws + WS_ROPEM))[i] = rope_cs(pos, INV_MLA[f]);
        if (f < 8) ((f32x2*)(ws + WS_ROPEN))[pos * 8 + f] = rope_cs(pos, INV_MLA[2 * f]);
    }
    for (int it = blockIdx.x; it < 32; it += gridDim.x) {
        const int kv = it >> 4, s16 = it & 15;
        if (tid >= 256) continue;
        const int j = tid & 127, kh = tid >> 7;
        const int sl = s16 * 2 + kh;
        const float* pe = a.in[11] + (size_t)kv * 2048 + sl * 64;
        const float* w1 = a.in[12] + ((size_t)kv * 2048 + sl * 64) * 128 + j;
        float s = 0.f;
        for (int k = 0; k < 64; ++k) s += pe[k] * w1[(size_t)k * 128];
        ((float*)(ws + WS_BIASP))[(kv * 32 + sl) * 128 + j] = s;
    }
    {
        float* tile = (float*)lds;
        const WtJob jobs[11] = {
            {a.in[3],  1024, INC,  INP,  a.in[2],  (bf16_t*)(ws + WS_WIN),  1024},
            {a.in[6],  256,  768,  768,  a.in[4],  (bf16_t*)(ws + WS_WUQ),  256},
            {a.in[7],  128,  1024, 1024, a.in[5],  (bf16_t*)(ws + WS_WUKV), 128},
            {a.in[12], 2048, 128,  128,  nullptr,  (bf16_t*)(ws + WS_W1C),  2048},
            {a.in[12] + 2048 * 128, 2048, 128, 128, nullptr, (bf16_t*)(ws + WS_W1C) + 128 * 2048, 2048},
            {a.in[13], 128,  64,   128,  nullptr,  (bf16_t*)(ws + WS_W2C),  128},
            {a.in[13] + 128 * 64, 128, 64, 128, nullptr, (bf16_t*)(ws + WS_W2C) + 128 * 128, 128},
            {a.in[15], 1024, 1024, 1024, a.in[14], (bf16_t*)(ws + WS_WOUT), 1024},
            {a.in[18], 1024, 512,  512,  a.in[16], (bf16_t*)(ws + WS_WXQ),  1024},
            {a.in[19], 1024, 1024, 1024, a.in[17], (bf16_t*)(ws + WS_WXKV), 1024},
            {a.in[21], 512,  1024, 1024, nullptr,  (bf16_t*)(ws + WS_WXO),  512},
        };
        int base = 0;
#pragma unroll
        for (int jb = 0; jb < 12; ++jb) {
            WtJob J;
            if (jb < 11) J = jobs[jb]; else J = WtJob{a.in[23], 1024, 1024, 1024, a.in[22], (bf16_t*)(ws + WS_WPQ), 1024};
            const int nkt = J.K / 64, nnt = J.Npad / 64, ntile = nkt * nnt;
            const int half = tid >> 8;
            for (int t0 = 2 * (int)blockIdx.x; t0 < ntile; t0 += 2 * (int)gridDim.x) {
                const int t = t0 + half; const bool ok = t < ntile; const int tt = ok ? t : 0;
                if (jb == 0) wt_tile<true>(J.W, J.N, J.gain, J.Wt, J.ldt, tt % nkt, tt / nkt, tile, ok); else wt_tile<false>(J.W, J.N, J.gain, J.Wt, J.ldt, tt % nkt, tt / nkt, tile, ok);
            }
            base += ntile;
        }
    }
}

__device__ __forceinline__ void norm_rope64(float (&v)[8], int p, const float* __restrict__ gain, const f32x2* __restrict__ cs, float scale, bool do_norm) {
    float s = 0.f;
#pragma unroll
    for (int e = 0; e < 8; ++e) s += v[e] * v[e];
    s += __shfl_xor(s, 1); s += __shfl_xor(s, 2); s += __shfl_xor(s, 4);
    const float r = rsqrtf(s * (1.0f / 64.0f) + EPSN);
    float g[8];
    { const f32x4 g0 = *(const f32x4*)(gain + p * 8), g1 = *(const f32x4*)(gain + p * 8 + 4);
      g[0] = g0[0]; g[1] = g0[1]; g[2] = g0[2]; g[3] = g0[3]; g[4] = g1[0]; g[5] = g1[1]; g[6] = g1[2]; g[7] = g1[3]; }
    if (do_norm) {
#pragma unroll
        for (int e = 0; e < 8; ++e) v[e] = v[e] * r * g[e];
    }
    float o[8];
#pragma unroll
    for (int e = 0; e < 8; ++e) o[e] = __shfl_xor(v[e], 1);
    if (do_norm && p < 2) {
#pragma unroll
        for (int e = 0; e < 8; ++e) {
            const f32x2 c = cs[e];
            v[e] = (p == 0) ? (v[e] * c[0] - o[e] * c[1]) : (v[e] * c[0] + o[e] * c[1]);
        }
    }
#pragma unroll
    for (int e = 0; e < 8; ++e) v[e] *= scale;
}

__device__ __forceinline__ void phase_tokpass(const Args& a) {
    unsigned char* ws = a.ws;
    const int tid = threadIdx.x, lane = tid & 63, w = tid >> 6;
    const int gw = blockIdx.x * NWV + w, nw = gridDim.x * NWV;
    const bf16_t* P = (const bf16_t*)(ws + WS_P);
    const f32x2* ropen = (const f32x2*)(ws + WS_ROPEN);
    const float* qn_gain = a.in[9];
    const float* kn_gain = a.in[10];
    for (int t = gw; t < T_TOK; t += nw) {
        const bf16_t* pr = P + (size_t)t * PLD;
        const int b = t >> 12, s = t & 4095;
        {
            const u32x2 q = *(const u32x2*)(pr + C_CQ + lane * 4);
            const unsigned kk = *(const unsigned*)(pr + C_CKV + lane * 2);
            float s1 = bflo(q.x) * bflo(q.x) + bfhi(q.x) * bfhi(q.x) + bflo(q.y) * bflo(q.y) + bfhi(q.y) * bfhi(q.y);
            float s2 = bflo(kk) * bflo(kk) + bfhi(kk) * bfhi(kk);
            s1 = wave_sum(s1); s2 = wave_sum(s2);
            if (lane == 0) { ((float*)(ws + WS_RSTDCQ))[t] = rsqrtf(s1 * (1.0f / 256.0f) + EPSN); ((float*)(ws + WS_RSTDCKV))[t] = rsqrtf(s2 * (1.0f / 128.0f) + EPSN); }
        }
        const f32x2* cs = ropen + (size_t)s * 8;
        {
            const int head = lane >> 3, p = lane & 7;
            float v[8]; unpack8(*(const u32x4*)(pr + C_QN + lane * 8), v);
            norm_rope64(v, p, qn_gain, cs, 0.125f * LOG2E, true);
            *(u32x4*)((bf16_t*)(ws + WS_QN) + ((size_t)(b * 8 + head) * SEQ + s) * 64 + p * 8) = pack8(v);
        }
        {
            const int which = lane >> 4, g = (lane >> 3) & 1, p = lane & 7;
            const int col = (which == 0 ? C_KS : which == 1 ? C_KW : which == 2 ? C_KC : C_VC) + g * 64 + p * 8;
            float v[8]; unpack8(*(const u32x4*)(pr + col), v);
            const float* gain = kn_gain + (which == 1 ? 128 : 64);
            norm_rope64(v, p, gain, cs, 1.0f, which < 2);
            bf16_t* dst = (bf16_t*)(ws + (which == 0 ? WS_KS : which == 1 ? WS_KW : which == 2 ? WS_KCIN : WS_VCIN));
            *(u32x4*)(dst + ((size_t)(b * 2 + g) * SEQ + s) * 64 + p * 8) = pack8(v);
        }
        if (lane < 24) {
            const float x = bf2f(pr[C_GATE + lane]);
            ((float*)(ws + WS_GATE))[(size_t)t * 24 + lane] = 1.0f / (1.0f + __expf(-x));
        }
    }
}

__device__ __forceinline__ void phase_mla_k(const Args& a) {
    unsigned char* ws = a.ws;
    const int tid = threadIdx.x, lane = tid & 63, w = tid >> 6;
    const int gw = blockIdx.x * NWV + w, nw = gridDim.x * NWV;
    const bf16_t* P = (const bf16_t*)(ws + WS_P);
    const bf16_t* KV = (const bf16_t*)(ws + WS_KVRAW);
    const f32x2* ropem = (const f32x2*)(ws + WS_ROPEM);
    const float* kg = a.in[8] + 96;
    const int head = lane >> 3, p = lane & 7;
    for (int t = gw; t < T_TOK; t += nw) {
        const int b = t >> 12, s = t & 4095;
        float v[8]; unpack8(*(const u32x4*)(KV + (size_t)t * 1024 + head * 128 + p * 8), v);
        const unsigned x1w = *(const unsigned*)(P + (size_t)t * PLD + C_KPE + 2 * p);
        const unsigned x2w = *(const unsigned*)(P + (size_t)t * PLD + C_KPE + 16 + 2 * p);
        float x1[2] = {bflo(x1w), bfhi(x1w)}, x2[2] = {bflo(x2w), bfhi(x2w)};
        float ss = x1[0] * x1[0] + x1[1] * x1[1] + x2[0] * x2[0] + x2[1] * x2[1];
#pragma unroll
        for (int e = 0; e < 8; ++e) ss += v[e] * v[e];
        ss += __shfl_xor(ss, 1); ss += __shfl_xor(ss, 2); ss += __shfl_xor(ss, 4);
        const float r = rsqrtf(ss * (1.0f / 96.0f) + EPSN);
#pragma unroll
        for (int e = 0; e < 8; ++e) v[e] = v[e] * r * kg[p * 8 + e];
        const f32x4 cs = *(const f32x4*)(ropem + (size_t)s * 16 + 2 * p);
        float y1[2], y2[2];
#pragma unroll
        for (int e = 0; e < 2; ++e) {
            const float a1 = x1[e] * r * kg[64 + 2 * p + e], a2 = x2[e] * r * kg[80 + 2 * p + e];
            const float c = cs[2 * e], sn = cs[2 * e + 1];
            y1[e] = a1 * c - a2 * sn; y2[e] = a2 * c + a1 * sn;
        }
        bf16_t* kp = (bf16_t*)(ws + WS_KM) + ((size_t)(b * 8 + head) * SEQ + s) * 96;
        *(u32x4*)(kp + p * 8) = pack8(v);
        *(unsigned*)(kp + 64 + 2 * p) = pack2(y1[0], y1[1]);
        *(unsigned*)(kp + 80 + 2 * p) = pack2(y2[0], y2[1]);
    }
}

__device__ __forceinline__ void phase_xa_k(const Args& a, int vb, int VG) {
    unsigned char* ws = a.ws;
    const int tid = threadIdx.x, lane = tid & 63, w = tid >> 6;
    const int gw = vb * NWV + w, nw = VG * NWV;
    const bf16_t* KVX = (const bf16_t*)(ws + WS_KVX);
    const float* kg = a.in[20] + 128;
    const int head = lane >> 4, p = lane & 15;
    for (int r = gw; r < 4096; r += nw) {
        const int b = r >> 8, m = r & 255;
        float v[8]; unpack8(*(const u32x4*)(KVX + (size_t)r * 1024 + head * 128 + p * 8), v);
        float ss = 0.f;
#pragma unroll
        for (int e = 0; e < 8; ++e) ss += v[e] * v[e];
        ss += __shfl_xor(ss, 1); ss += __shfl_xor(ss, 2); ss += __shfl_xor(ss, 4); ss += __shfl_xor(ss, 8);
        const float rr = rsqrtf(ss * (1.0f / 128.0f) + EPSN);
#pragma unroll
        for (int e = 0; e < 8; ++e) v[e] = v[e] * rr * kg[p * 8 + e];
        *(u32x4*)((bf16_t*)(ws + WS_KX) + ((size_t)(b * 4 + head) * 256 + m) * 128 + p * 8) = pack8(v);
    }
}

__device__ __forceinline__ void phase_cmp_fin(const Args& a) {
    unsigned char* ws = a.ws;
    const int tid = threadIdx.x, lane = tid & 63, w = tid >> 6;
    const int gw = blockIdx.x * NWV + w, nw = gridDim.x * NWV;
    const float* CR = (const float*)(ws + WS_CRAW);
    const f32x2* ropen = (const f32x2*)(ws + WS_ROPEN);
    const float* kg = a.in[10];
    for (int r = gw; r < 16384; r += nw) {
        const int kv = r >> 13, row = r & 8191, bg = row >> 8, n = row & 255;
        float x = CR[(size_t)r * 64 + lane];
        if (n == 255) x = 0.f;
        if (kv == 0) {
            float ss = wave_sum(x * x);
            const float rr = rsqrtf(ss * (1.0f / 64.0f) + EPSN);
            x = x * rr * kg[lane];
            const float o = __shfl_xor(x, 8);
            int pos = 16 * n + 31; if (pos > 4095) pos = 4095;
            if (lane < 16) {
                const f32x2 c = ropen[(size_t)pos * 8 + (lane & 7)];
                x = (lane < 8) ? (x * c[0] - o * c[1]) : (x * c[0] + o * c[1]);
            }
            if (n == 255) x = 0.f;
            ((bf16_t*)(ws + WS_KC))[((size_t)bg * 256 + n) * 64 + lane] = (bf16_t)f2bf(x);
        } else {
            ((bf16_t*)(ws + WS_VCT))[((size_t)bg * 64 + lane) * 256 + n] = (bf16_t)f2bf(x);
        }
    }
}

template <int KS, int DVT>
struct AttnRegs { u32x4 k[(KS * 128 + NT - 1) / NT]; u32x4 v[(DVT * 256 + NT - 1) / NT]; };

template <int KS, int DVT>
__device__ __forceinline__ void attn_prefetch(AttnRegs<KS, DVT>& R, const bf16_t* __restrict__ ktile  , const bf16_t* __restrict__ vt  , size_t ldv) {
    const int tid = threadIdx.x;
#pragma unroll
    for (int i = 0; i < (KS * 128 + NT - 1) / NT; ++i) { const int id = tid + NT * i; if (id < KS * 128) R.k[i] = *(const u32x4*)(ktile + (size_t)id * 8); }
#pragma unroll
    for (int i = 0; i < (DVT * 256 + NT - 1) / NT; ++i) { const int id = tid + NT * i; if (id < DVT * 256) R.v[i] = *(const u32x4*)(vt + (size_t)(id >> 3) * ldv + (id & 7) * 8); }
}
template <int KS, int DVT>
__device__ __forceinline__ void attn_store(const AttnRegs<KS, DVT>& R, unsigned char* kl, unsigned char* vl) {
    constexpr int KP = KS * 32 + 16;
    const int tid = threadIdx.x;
#pragma unroll
    for (int i = 0; i < (KS * 128 + NT - 1) / NT; ++i) { const int id = tid + NT * i; if (id < KS * 128) { const int row = id / (2 * KS), c = id % (2 * KS); *(u32x4*)(kl + row * KP + c * 16) = R.k[i]; } }
#pragma unroll
    for (int i = 0; i < (DVT * 256 + NT - 1) / NT; ++i) { const int id = tid + NT * i; if (id < DVT * 256) *(u32x4*)(vl + (id >> 3) * 144 + (id & 7) * 16) = R.v[i]; }
}

template <int KS>
__device__ __forceinline__ void attn_scores(const unsigned char* kl, const bf16x8 (&qf)[KS], f32x16 (&s)[2], int l31, int hh, float sinit = 0.f) {
    constexpr int KP = KS * 32 + 16;
    if (KS <= 6) {
        bf16x8 kf[2][KS];
#pragma unroll
        for (int kt2 = 0; kt2 < 2; ++kt2) {
            const unsigned char* kr = kl + (32 * kt2 + kap(l31)) * KP + hh * 16;
#pragma unroll
            for (int ks = 0; ks < KS; ++ks) kf[kt2][ks] = as_bf16x8(*(const u32x4*)(kr + ks * 32));
        }
        __builtin_amdgcn_sched_barrier(0);
#pragma unroll
        for (int kt2 = 0; kt2 < 2; ++kt2) {
#pragma unroll
            for (int r = 0; r < 16; ++r) s[kt2][r] = sinit;
#pragma unroll
            for (int ks = 0; ks < KS; ++ks) s[kt2] = MFMA32(kf[kt2][ks], qf[ks], s[kt2]);
        }
    } else {
#pragma unroll
        for (int kt2 = 0; kt2 < 2; ++kt2) {
            bf16x8 kf[KS];
            const unsigned char* kr = kl + (32 * kt2 + kap(l31)) * KP + hh * 16;
#pragma unroll
            for (int ks = 0; ks < KS; ++ks) kf[ks] = as_bf16x8(*(const u32x4*)(kr + ks * 32));
            __builtin_amdgcn_sched_barrier(0);
#pragma unroll
            for (int r = 0; r < 16; ++r) s[kt2][r] = sinit;
#pragma unroll
            for (int ks = 0; ks < KS; ++ks) s[kt2] = MFMA32(kf[ks], qf[ks], s[kt2]);
        }
    }
}

template <int KS, int DVT, bool MASKED = true, class MaskF>
__device__ __forceinline__ void flash_tile(const unsigned char* kl, const unsigned char* vl, const bf16x8 (&qf)[KS], f32x16 (&o)[DVT], float& m, float& l,
                                           int l31, int hh, MaskF valid, float sinit = 0.f) {
    f32x16 s[2];
    attn_scores<KS>(kl, qf, s, l31, hh, sinit);
    f32x2 ps2 = (f32x2){0.f, 0.f};
#pragma unroll
    for (int kt2 = 0; kt2 < 2; ++kt2) {
#pragma unroll
        for (int r = 0; r < 16; r += 2) {
            float p0 = __builtin_amdgcn_exp2f(s[kt2][r]), p1 = __builtin_amdgcn_exp2f(s[kt2][r + 1]);
            if (MASKED) {
                const int key = 32 * kt2 + 16 * (r >> 3) + 8 * hh + (r & 7);
                p0 = valid(key) ? p0 : 0.f; p1 = valid(key + 1) ? p1 : 0.f;
            }
            s[kt2][r] = p0; s[kt2][r + 1] = p1;
            ps2 += (f32x2){p0, p1};
        }
        bf16x8 pf[2];
#pragma unroll
        for (int s2 = 0; s2 < 2; ++s2) {
            u32x4 w;
            w.x = pack2(s[kt2][8 * s2 + 0], s[kt2][8 * s2 + 1]); w.y = pack2(s[kt2][8 * s2 + 2], s[kt2][8 * s2 + 3]);
            w.z = pack2(s[kt2][8 * s2 + 4], s[kt2][8 * s2 + 5]); w.w = pack2(s[kt2][8 * s2 + 6], s[kt2][8 * s2 + 7]);
            pf[s2] = as_bf16x8(w);
        }
#pragma unroll
        for (int d = 0; d < DVT; ++d) {
            const unsigned char* vr = vl + (32 * d + kap(l31)) * 144 + hh * 16 + (32 * kt2) * 2;
            const bf16x8 vf0 = as_bf16x8(*(const u32x4*)vr), vf1 = as_bf16x8(*(const u32x4*)(vr + 32));
            o[d] = MFMA32(vf0, pf[0], o[d]);
            o[d] = MFMA32(vf1, pf[1], o[d]);
        }
    }
    l += ps2[0] + ps2[1];
    (void)m;
}

template <int DVT>
__device__ __forceinline__ float flash_final(f32x16 (&o)[DVT], float l) {
    const float lt = l + __shfl_xor(l, 32);
    const float inv = lt > 0.f ? 1.0f / lt : 0.f;
#pragma unroll
    for (int d = 0; d < DVT; ++d)
#pragma unroll
        for (int r = 0; r < 16; ++r) o[d][r] *= inv;
    return inv;
}

#define ATT_K_OFF 0
#define ATT_V_OFF 17408
#define ATT_X_OFF 36864
#define ATT_MISC_OFF 103424

__device__ __forceinline__ void mla_unit(const Args& a, int b, int h, int qt, unsigned char* lds) {
    unsigned char* ws = a.ws;
    int tid_ = threadIdx.x; asm volatile("" : "+v"(tid_));
    const int tid = tid_, lane = tid & 63, w = tid >> 6, l31 = lane & 31, hh = lane >> 5;
    const int qw0 = qt * 256 + 32 * w, q = qw0 + l31;
    const size_t t = (size_t)b * SEQ + q;
    const bf16_t* kb = (const bf16_t*)(ws + WS_KM) + (size_t)(b * 8 + h) * SEQ * 96;
    const bf16_t* vb = (const bf16_t*)(ws + WS_VMT) + (size_t)(b * 8 + h) * 64 * SEQ;
    AttnRegs<6, 2> R;
    attn_prefetch<6, 2>(R, kb, vb, SEQ);
    bf16x8 qf[6];
    {
        const bf16_t* qr = (const bf16_t*)(ws + WS_QMRAW) + t * 768 + h * 96 + 8 * hh;
        const float* qg = a.in[8];
        float v[6][8]; float ss = 0.f;
#pragma unroll
        for (int ks = 0; ks < 6; ++ks) { unpack8(*(const u32x4*)(qr + 16 * ks), v[ks]);
#pragma unroll
            for (int e = 0; e < 8; ++e) ss += v[ks][e] * v[ks][e]; }
        ss += __shfl_xor(ss, 32);
        const float r = rsqrtf(ss * (1.0f / 96.0f) + EPSN);
#pragma unroll
        for (int ks = 0; ks < 6; ++ks)
#pragma unroll
            for (int e = 0; e < 8; ++e) v[ks][e] = v[ks][e] * r * qg[16 * ks + 8 * hh + e];
        const f32x2* cs = (const f32x2*)(ws + WS_ROPEM) + (size_t)q * 16 + 8 * hh;
#pragma unroll
        for (int e = 0; e < 8; ++e) {
            const f32x2 c = cs[e]; const float x1 = v[4][e], x2 = v[5][e];
            v[4][e] = x1 * c[0] - x2 * c[1]; v[5][e] = x2 * c[0] + x1 * c[1];
        }
        const float sc = 0.10206207261596577f * LOG2E;
#pragma unroll
        for (int ks = 0; ks < 6; ++ks) {
#pragma unroll
            for (int e = 0; e < 8; ++e) v[ks][e] *= sc;
            qf[ks] = as_bf16x8(pack8(v[ks]));
        }
    }
    f32x16 o[2];
#pragma unroll
    for (int d = 0; d < 2; ++d)
#pragma unroll
        for (int r = 0; r < 16; ++r) o[d][r] = 0.f;
    float m = -1e30f, l = 0.f;
    const int nkt = 4 * qt + 4;
    __syncthreads();
    attn_store<6, 2>(R, lds, lds + 13312);
    __syncthreads();
    for (int it = 0; it < nkt; ++it) {
        const int k0 = it * 64;
        const unsigned char* klc = lds + (it & 1) * 22528; const unsigned char* vlc = klc + 13312;
        if (it + 1 < nkt) attn_prefetch<6, 2>(R, kb + (size_t)(k0 + 64) * 96, vb + k0 + 64, SEQ);
        if (k0 + 63 <= qw0)
            flash_tile<6, 2, false>(klc, vlc, qf, o, m, l, l31, hh, [&](int) { return true; });
        else if (k0 <= qw0 + 31)
            flash_tile<6, 2>(klc, vlc, qf, o, m, l, l31, hh, [&](int key) { return k0 + key <= q; });
        if (it + 1 < nkt) attn_store<6, 2>(R, lds + ((it + 1) & 1) * 22528, lds + ((it + 1) & 1) * 22528 + 13312);
        __syncthreads();
    }
    flash_final<2>(o, l);
    {
        float sq = 0.f;
#pragma unroll
        for (int d = 0; d < 2; ++d)
#pragma unroll
            for (int r = 0; r < 16; ++r) sq += o[d][r] * o[d][r];
        sq += __shfl_xor(sq, 32);
        if (hh == 0) ((float*)(ws + WS_SSQ))[t * 16 + h] = sq;
    }
    bf16_t* op = (bf16_t*)(ws + WS_OMIX) + t * 1024 + h * 64 + 8 * hh;
#pragma unroll
    for (int d = 0; d < 2; ++d)
#pragma unroll
        for (int j = 0; j < 2; ++j) {
            float v[8];
#pragma unroll
            for (int e = 0; e < 8; ++e) v[e] = o[d][8 * j + e];
            *(u32x4*)(op + 32 * d + 16 * j) = pack8(v);
        }
}


#define PS_PITCH 260
__device__ __forceinline__ void nsa_unit(const Args& a, int b, int g, int j, unsigned char* lds) {
    unsigned char* ws = a.ws;
    int tid_ = threadIdx.x; asm volatile("" : "+v"(tid_));
    const int tid = tid_, lane = tid & 63, w = tid >> 6, l31 = lane & 31, hh = lane >> 5;
    const int posl = lane & 7, r4 = (lane >> 3) & 3;
    const int s0 = 64 * j, qpos = s0 + 8 * w + posl, hq = 4 * g + r4, bg = b * 2 + g;
    const size_t t = (size_t)b * SEQ + qpos;
    const int cur = j;
    unsigned char* kl = lds; unsigned char* vl = lds + 9216;
    float* psum = (float*)(lds + ATT_X_OFF);
    AttnRegs<4, 2> R;
    const int ntc = (4 * j + 2) / 64 + 1;
    const bf16_t* kcb = (const bf16_t*)(ws + WS_KC) + (size_t)bg * 256 * 64;
    const bf16_t* vcb = (const bf16_t*)(ws + WS_VCT) + (size_t)bg * 64 * 256;
    attn_prefetch<4, 2>(R, kcb, vcb, 256);
    bf16x8 qf[4];
    {
        const bf16_t* qr = (const bf16_t*)(ws + WS_QN) + ((size_t)(b * 8 + hq) * SEQ + qpos) * 64 + 8 * hh;
#pragma unroll
        for (int ks = 0; ks < 4; ++ks) qf[ks] = as_bf16x8(*(const u32x4*)(qr + 16 * ks));
    }
    const float* gate = (const float*)(ws + WS_GATE) + t * 24 + hq * 3;
    const float g_c = gate[0], g_s = gate[1], g_w = gate[2];
    f32x16 acc[2];
#pragma unroll
    for (int d = 0; d < 2; ++d)
#pragma unroll
        for (int r = 0; r < 16; ++r) acc[d][r] = 0.f;
    float m_c, inv_c;
    {
        f32x16 o[2];
#pragma unroll
        for (int d = 0; d < 2; ++d)
#pragma unroll
            for (int r = 0; r < 16; ++r) o[d][r] = 0.f;
        float m = -1e30f, l = 0.f;
        __syncthreads();
        attn_store<4, 2>(R, kl, vl);
        __syncthreads();
        for (int it = 0; it < ntc; ++it) {
            const int k0 = it * 64;
            const unsigned char* klc = kl + (it & 1) * 18432; const unsigned char* vlc = klc + 9216;
            if (it + 1 < ntc) attn_prefetch<4, 2>(R, kcb + (size_t)(k0 + 64) * 64, vcb + k0 + 64, 256);
            flash_tile<4, 2>(klc, vlc, qf, o, m, l, l31, hh, [&](int key) { return 16 * (k0 + key) + 31 <= qpos; });
            if (it + 1 < ntc) attn_store<4, 2>(R, kl + ((it + 1) & 1) * 18432, kl + ((it + 1) & 1) * 18432 + 9216);
            __syncthreads();
        }
        inv_c = flash_final<2>(o, l); m_c = m;
#pragma unroll
        for (int d = 0; d < 2; ++d)
#pragma unroll
            for (int r = 0; r < 16; ++r) acc[d][r] += g_c * o[d][r];
    }
    {
        attn_prefetch<4, 2>(R, kcb, vcb, 256);
        __syncthreads();
        attn_store<4, 2>(R, kl, vl);
        __syncthreads();
        for (int it = 0; it < ntc; ++it) {
            const int k0 = it * 64;
            const unsigned char* klc = kl + (it & 1) * 18432;
            if (it + 1 < ntc) attn_prefetch<4, 2>(R, kcb + (size_t)(k0 + 64) * 64, vcb + k0 + 64, 256);
            f32x16 s[2];
            attn_scores<4>(klc, qf, s, l31, hh);
#pragma unroll
            for (int kt2 = 0; kt2 < 2; ++kt2)
#pragma unroll
                for (int r = 0; r < 16; ++r) {
                    const int key = 32 * kt2 + 16 * (r >> 3) + 8 * hh + (r & 7);
                    const bool ok = 16 * (k0 + key) + 31 <= qpos;
                    float p = ok ? __builtin_amdgcn_exp2f(s[kt2][r]) * inv_c : 0.f;
                    p += __shfl_xor(p, 8); p += __shfl_xor(p, 16);
                    s[kt2][r] = p;
                }
            if (r4 == 0) {
                float* pr = psum + (8 * w + posl) * PS_PITCH + k0 + 8 * hh;
#pragma unroll
                for (int kt2 = 0; kt2 < 2; ++kt2)
#pragma unroll
                    for (int j2 = 0; j2 < 2; ++j2) {
                        *(f32x4*)(pr + 32 * kt2 + 16 * j2) = (f32x4){s[kt2][8 * j2 + 0], s[kt2][8 * j2 + 1], s[kt2][8 * j2 + 2], s[kt2][8 * j2 + 3]};
                        *(f32x4*)(pr + 32 * kt2 + 16 * j2 + 4) = (f32x4){s[kt2][8 * j2 + 4], s[kt2][8 * j2 + 5], s[kt2][8 * j2 + 6], s[kt2][8 * j2 + 7]};
                    }
            }
            if (it + 1 < ntc) attn_store<4, 2>(R, kl + ((it + 1) & 1) * 18432, kl + ((it + 1) & 1) * 18432 + 9216);
            __syncthreads();
        }
    }
    __syncthreads();
    unsigned long long mymask, unionmask;
    {
        const int mg = lane >> 3;
        float* impb = (float*)kl + (w * 8 + posl) * 64;
        const float* pr = psum + (8 * w + posl) * PS_PITCH;
        const int nvis = (64 * ntc < 255) ? 64 * ntc : 255;
        float imp[8];
#pragma unroll
        for (int e = 0; e < 8; ++e) {
            const int m = mg * 8 + e;
            float sacc = 0.f;
#pragma unroll
            for (int d = -1; d <= 3; ++d) { const int n = 4 * m + d; if (n >= 0 && n < nvis) sacc += pr[n]; }
            imp[e] = sacc; impb[m] = sacc;
        }
        __syncthreads();
        int cnt[8];
#pragma unroll
        for (int e = 0; e < 8; ++e) cnt[e] = 0;
        const float* ib = (const float*)kl + (w * 8 + posl) * 64;
        for (int mp = 1; mp <= cur - 2; ++mp) {
            const float v = ib[mp];
#pragma unroll
            for (int e = 0; e < 8; ++e) { const int m = mg * 8 + e; cnt[e] += ((v > imp[e]) || (v == imp[e] && mp < m)) ? 1 : 0; }
        }
        const int nf = cur == 0 ? 1 : (cur == 1 ? 2 : 3);
        const int nsel = 16 - nf;
        unsigned m8 = 0;
#pragma unroll
        for (int e = 0; e < 8; ++e) {
            const int m = mg * 8 + e;
            const bool forced = (m == 0) || (m == cur) || (m == cur - 1);
            const bool sel = (m <= cur) && (forced || (m >= 1 && m <= cur - 2 && cnt[e] < nsel));
            m8 |= sel ? (1u << e) : 0u;
        }
        unsigned lo = (mg < 4) ? (m8 << (8 * mg)) : 0u, hi = (mg >= 4) ? (m8 << (8 * (mg - 4))) : 0u;
        lo |= __shfl_xor(lo, 8); hi |= __shfl_xor(hi, 8);
        lo |= __shfl_xor(lo, 16); hi |= __shfl_xor(hi, 16);
        lo |= __shfl_xor(lo, 32); hi |= __shfl_xor(hi, 32);
        mymask = ((unsigned long long)hi << 32) | lo;
        unsigned ulo = lo, uhi = hi;
        ulo |= __shfl_xor(ulo, 1); uhi |= __shfl_xor(uhi, 1);
        ulo |= __shfl_xor(ulo, 2); uhi |= __shfl_xor(uhi, 2);
        ulo |= __shfl_xor(ulo, 4); uhi |= __shfl_xor(uhi, 4);
        unsigned* misc = (unsigned*)(lds + ATT_MISC_OFF);
        if (lane == 0) { misc[2 * w] = ulo; misc[2 * w + 1] = uhi; }
        __syncthreads();
        ulo = misc[0] | misc[2] | misc[4] | misc[6] | misc[8] | misc[10] | misc[12] | misc[14]; uhi = misc[1] | misc[3] | misc[5] | misc[7] | misc[9] | misc[11] | misc[13] | misc[15];
        unionmask = ((unsigned long long)uhi << 32) | ulo;
    }
    {
        f32x16 o[2];
#pragma unroll
        for (int d = 0; d < 2; ++d)
#pragma unroll
            for (int r = 0; r < 16; ++r) o[d][r] = 0.f;
        float m = -1e30f, l = 0.f;
        const bf16_t* kb = (const bf16_t*)(ws + WS_KS) + (size_t)bg * SEQ * 64;
        const bf16_t* vb = (const bf16_t*)(ws + WS_VST) + (size_t)bg * 64 * SEQ;
        unsigned long long rem = unionmask;
        int mb = __builtin_ctzll(rem); rem &= rem - 1;
        attn_prefetch<4, 2>(R, kb + (size_t)mb * 64 * 64, vb + mb * 64, SEQ);
        __syncthreads();
        attn_store<4, 2>(R, kl, vl);
        __syncthreads();
        int cbuf = 0;
        for (;;) {
            const int k0 = mb * 64;
            const bool more = rem != 0ull;
            int mnext = 0;
            if (more) { mnext = __builtin_ctzll(rem); rem &= rem - 1; }
            const unsigned char* klc = kl + cbuf * 18432; const unsigned char* vlc = klc + 9216;
            if (more) attn_prefetch<4, 2>(R, kb + (size_t)mnext * 64 * 64, vb + mnext * 64, SEQ);
            const bool mine = (mymask >> mb) & 1ull;
            if (mb < cur) {
                if (__all(mine)) flash_tile<4, 2, false>(klc, vlc, qf, o, m, l, l31, hh, [&](int) { return true; });
                else if (__any(mine)) flash_tile<4, 2, false>(klc, vlc, qf, o, m, l, l31, hh, [&](int) { return true; }, mine ? 0.f : -1e30f);
            } else
                flash_tile<4, 2>(klc, vlc, qf, o, m, l, l31, hh, [&](int key) { return mine && (k0 + key <= qpos); });
            if (more) attn_store<4, 2>(R, kl + (cbuf ^ 1) * 18432, kl + (cbuf ^ 1) * 18432 + 9216);
            __syncthreads();
            if (!more) break;
            mb = mnext; cbuf ^= 1;
        }
        flash_final<2>(o, l);
#pragma unroll
        for (int d = 0; d < 2; ++d)
#pragma unroll
            for (int r = 0; r < 16; ++r) acc[d][r] += g_s * o[d][r];
    }
    {
        f32x16 o[2];
#pragma unroll
        for (int d = 0; d < 2; ++d)
#pragma unroll
            for (int r = 0; r < 16; ++r) o[d][r] = 0.f;
        float m = -1e30f, l = 0.f;
        const bf16_t* kb = (const bf16_t*)(ws + WS_KW) + (size_t)bg * SEQ * 64;
        const bf16_t* vb = (const bf16_t*)(ws + WS_VWT) + (size_t)bg * 64 * SEQ;
        const int lo = s0 - 511;
        const int m0 = lo <= 0 ? 0 : (lo >> 6);
        attn_prefetch<4, 2>(R, kb + (size_t)m0 * 64 * 64, vb + m0 * 64, SEQ);
        __syncthreads();
        attn_store<4, 2>(R, kl, vl);
        __syncthreads();
        for (int mb = m0; mb <= cur; ++mb) {
            const int k0 = mb * 64;
            const int cb2 = (mb - m0) & 1;
            const unsigned char* klc = kl + cb2 * 18432; const unsigned char* vlc = klc + 9216;
            if (mb + 1 <= cur) attn_prefetch<4, 2>(R, kb + (size_t)(mb + 1) * 64 * 64, vb + (mb + 1) * 64, SEQ);
            if (k0 + 63 <= s0 + 8 * w && s0 + 8 * w + 7 - k0 < 512)
                flash_tile<4, 2, false>(klc, vlc, qf, o, m, l, l31, hh, [&](int) { return true; });
            else
                flash_tile<4, 2>(klc, vlc, qf, o, m, l, l31, hh, [&](int key) { const int kp = k0 + key; return (kp <= qpos) && (qpos - kp < 512); });
            if (mb + 1 <= cur) attn_store<4, 2>(R, kl + (cb2 ^ 1) * 18432, kl + (cb2 ^ 1) * 18432 + 9216);
            __syncthreads();
        }
        flash_final<2>(o, l);
#pragma unroll
        for (int d = 0; d < 2; ++d)
#pragma unroll
            for (int r = 0; r < 16; ++r) acc[d][r] += g_w * o[d][r];
    }
    {
        float sq = 0.f;
#pragma unroll
        for (int d = 0; d < 2; ++d)
#pragma unroll
            for (int r = 0; r < 16; ++r) sq += acc[d][r] * acc[d][r];
        sq += __shfl_xor(sq, 32);
        if (hh == 0) ((float*)(ws + WS_SSQ))[t * 16 + 8 + hq] = sq;
    }
    bf16_t* op = (bf16_t*)(ws + WS_OMIX) + t * 1024 + 512 + hq * 64 + 8 * hh;
#pragma unroll
    for (int d = 0; d < 2; ++d)
#pragma unroll
        for (int j2 = 0; j2 < 2; ++j2) {
            float v[8];
#pragma unroll
            for (int e = 0; e < 8; ++e) v[e] = acc[d][8 * j2 + e];
            *(u32x4*)(op + 32 * d + 16 * j2) = pack8(v);
        }
}


__device__ __forceinline__ void xa_unit(const Args& a, int b, int head, int qt, unsigned char* lds) {
    unsigned char* ws = a.ws;
    int tid_ = threadIdx.x; asm volatile("" : "+v"(tid_));
    const int tid = tid_, lane = tid & 63, w = tid >> 6, l31 = lane & 31, hh = lane >> 5;
    const int q = qt * 256 + 32 * w + l31;
    const size_t t = (size_t)b * SEQ + q;
    unsigned char* kl = lds + ATT_K_OFF; unsigned char* vl = lds + ATT_V_OFF;
    bf16x8 qf[8];
    {
        const bf16_t* qr = (const bf16_t*)(ws + WS_QX) + t * 512 + head * 128 + 8 * hh;
        const float* qg = a.in[20];
        float ss = 0.f;
        u32x4 raw[8];
#pragma unroll
        for (int ks = 0; ks < 8; ++ks) { raw[ks] = *(const u32x4*)(qr + 16 * ks); float v[8]; unpack8(raw[ks], v);
#pragma unroll
            for (int e = 0; e < 8; ++e) ss += v[e] * v[e]; }
        ss += __shfl_xor(ss, 32);
        const float r = rsqrtf(ss * (1.0f / 128.0f) + EPSN) * 0.08838834764831845f * LOG2E;
#pragma unroll
        for (int ks = 0; ks < 8; ++ks) { float v[8]; unpack8(raw[ks], v);
#pragma unroll
            for (int e = 0; e < 8; ++e) v[e] = v[e] * r * qg[16 * ks + 8 * hh + e];
            qf[ks] = as_bf16x8(pack8(v)); }
    }
    f32x16 o[4];
#pragma unroll
    for (int d = 0; d < 4; ++d)
#pragma unroll
        for (int r = 0; r < 16; ++r) o[d][r] = 0.f;
    float m = -1e30f, l = 0.f;
    const bf16_t* kb = (const bf16_t*)(ws + WS_KX) + (size_t)(b * 4 + head) * 256 * 128;
    const bf16_t* vb = (const bf16_t*)(ws + WS_VXT) + (size_t)(b * 4 + head) * 128 * 256;
#pragma unroll 1
    for (int it = 0; it < 4; ++it) {
        const int k0 = it * 64;
        __syncthreads();
        { AttnRegs<8, 4> R; attn_prefetch<8, 4>(R, kb + (size_t)k0 * 128, vb + k0, 256); attn_store<8, 4>(R, kl, vl); }
        __syncthreads();
        flash_tile<8, 4, false>(kl, vl, qf, o, m, l, l31, hh, [&](int) { return true; });
    }
    flash_final<4>(o, l);
    bf16_t* op = (bf16_t*)(ws + WS_OX) + t * 512 + head * 128 + 8 * hh;
#pragma unroll
    for (int d = 0; d < 4; ++d)
#pragma unroll
        for (int j2 = 0; j2 < 2; ++j2) {
            float v[8];
#pragma unroll
            for (int e = 0; e < 8; ++e) v[e] = o[d][8 * j2 + e];
            *(u32x4*)(op + 32 * d + 16 * j2) = pack8(v);
        }
}

__device__ __forceinline__ int f2ord(float x) { const int b = __float_as_int(x); return b ^ ((b >> 31) & 0x7FFFFFFF); }
__device__ __forceinline__ float ord2f(int k) { return __int_as_float(k ^ ((k >> 31) & 0x7FFFFFFF)); }
#define IMIN ((int)0x80000000)

#define CEX_DESC(a_, b_) do { const int hi_ = max((a_), (b_)), lo_ = min((a_), (b_)); (a_) = hi_; (b_) = lo_; } while (0)
__device__ __forceinline__ void bitonic_sort_desc16(int (&a)[16]) {
#pragma unroll
    for (int k = 2; k <= 16; k <<= 1)
#pragma unroll
        for (int j = k >> 1; j > 0; j >>= 1)
#pragma unroll
            for (int i = 0; i < 16; ++i) {
                const int l = i ^ j;
                if (l > i) { if ((i & k) == 0) CEX_DESC(a[i], a[l]); else CEX_DESC(a[l], a[i]); }
            }
}
__device__ __forceinline__ void merge_top16(int (&a)[16], const int (&b)[16]) {
#pragma unroll
    for (int i = 0; i < 16; ++i) a[i] = max(a[i], b[15 - i]);
#pragma unroll
    for (int j = 8; j > 0; j >>= 1)
#pragma unroll
        for (int i = 0; i < 16; ++i) { const int l = i ^ j; if (l > i) CEX_DESC(a[i], a[l]); }
}
__device__ __forceinline__ void peer_top16_of_128(const bf16_t* __restrict__ kp  , const bf16x8 (&qf)[4]  , int (&lst)[16], int l31, int hh) {
    int key[4][16];
#pragma unroll
    for (int kt = 0; kt < 4; ++kt) {
        f32x16 s;
#pragma unroll
        for (int r = 0; r < 16; ++r) s[r] = 0.f;
        const bf16_t* kr = kp + (size_t)(32 * kt + kap(l31)) * 64 + 8 * hh;
#pragma unroll
        for (int ks = 0; ks < 4; ++ks) { const bf16x8 kf = as_bf16x8(*(const u32x4*)(kr + 16 * ks)); s = MFMA32(kf, qf[ks], s); }
#pragma unroll
        for (int r = 0; r < 16; ++r) {
            const int idx = 32 * kt + 16 * (r >> 3) + 8 * hh + (r & 7);
            key[kt][r] = (__float_as_int(s[r] + 64.0f) & ~0x7F) | (127 - idx);
        }
    }
    bitonic_sort_desc16(key[0]); bitonic_sort_desc16(key[1]); bitonic_sort_desc16(key[2]); bitonic_sort_desc16(key[3]);
    merge_top16(key[0], key[1]); merge_top16(key[2], key[3]); merge_top16(key[0], key[2]);
#pragma unroll
    for (int i = 0; i < 16; ++i) lst[i] = key[0][i];
}

__device__ __forceinline__ void phase_peer_route(const Args& a) {
    unsigned char* ws = a.ws;
    int tid_ = threadIdx.x; asm volatile("" : "+v"(tid_));
    const int tid = tid_, lane = tid & 63, w = tid >> 6, l31 = lane & 31, hh = lane >> 5;
    const int gw = blockIdx.x * NWV + w, nw = gridDim.x * NWV;
    const bf16_t* QP = (const bf16_t*)(ws + WS_QP);
    const bf16_t* KP = (const bf16_t*)(ws + WS_KP);
    int* EIDX = (int*)(ws + WS_EIDX);
    float* EG = (float*)(ws + WS_EG);
    for (int it = gw; it < (T_TOK / 32) * 4; it += nw) {
        const int hp = it & 3, t = (it >> 2) * 32 + l31;
        const int h = 2 * hp + hh;
        int l1[16], l2[16];
        bf16x8 qA0[4], qB0[4], qA1[4], qB1[4];
        {
            const bf16_t* qr = QP + (size_t)t * 1024 + (2 * hp) * 128 + 8 * hh;
#pragma unroll
            for (int ks = 0; ks < 4; ++ks) {
                qA0[ks] = as_bf16x8(*(const u32x4*)(qr + 16 * ks)); qA1[ks] = as_bf16x8(*(const u32x4*)(qr + 64 + 16 * ks));
                qB0[ks] = as_bf16x8(*(const u32x4*)(qr + 128 + 16 * ks)); qB1[ks] = as_bf16x8(*(const u32x4*)(qr + 192 + 16 * ks));
            }
        }
        {
            int pA[16], pB[16];
            peer_top16_of_128(KP + (size_t)((2 * hp) * 2 + 0) * 128 * 64, qA0, pA, l31, hh);
            peer_top16_of_128(KP + (size_t)((2 * hp + 1) * 2 + 0) * 128 * 64, qB0, pB, l31, hh);
#pragma unroll
            for (int i = 0; i < 16; ++i) { const u32x2 sw = __builtin_amdgcn_permlane32_swap((unsigned)pA[i], (unsigned)pB[i], false, false); l1[i] = (int)sw.x; pB[i] = (int)sw.y; }
            merge_top16(l1, pB);
        }
        {
            int pA[16], pB[16];
            peer_top16_of_128(KP + (size_t)((2 * hp) * 2 + 1) * 128 * 64, qA1, pA, l31, hh);
            peer_top16_of_128(KP + (size_t)((2 * hp + 1) * 2 + 1) * 128 * 64, qB1, pB, l31, hh);
#pragma unroll
            for (int i = 0; i < 16; ++i) { const u32x2 sw = __builtin_amdgcn_permlane32_swap((unsigned)pA[i], (unsigned)pB[i], false, false); l2[i] = (int)sw.x; pB[i] = (int)sw.y; }
            merge_top16(l2, pB);
        }
        float f1[16], f2[16];
        unsigned i1p[4] = {0u, 0u, 0u, 0u}, i2p[4] = {0u, 0u, 0u, 0u};
#pragma unroll
        for (int i = 0; i < 16; ++i) {
            f1[i] = __int_as_float(l1[i] & ~0x7F); f2[i] = __int_as_float(l2[i] & ~0x7F) - 64.0f;
            i1p[i >> 2] |= (unsigned)(127 - (l1[i] & 0x7F)) << (8 * (i & 3));
            i2p[i >> 2] |= (unsigned)(127 - (l2[i] & 0x7F)) << (8 * (i & 3));
        }
        int cg[4][16];
#pragma unroll
        for (int gq = 0; gq < 4; ++gq)
#pragma unroll
            for (int i = 0; i < 16; ++i) cg[gq][i] = IMIN;
        {
            int n0 = 0, n1 = 0, n2 = 0, n3 = 0;
#pragma unroll
            for (int ca = 0; ca < 16; ++ca)
#pragma unroll
                for (int cb = 0; cb < 16; ++cb)
                    if ((ca + 1) * (cb + 1) <= 16) {
                        const int kc = (__float_as_int(f1[ca] + f2[cb]) & ~0xFF) | (255 - (ca * 16 + cb));
                        if (ca == 0) { cg[0][n0] = kc; ++n0; }
                        else if (ca <= 2) { cg[1][n1] = kc; ++n1; }
                        else if (ca <= 7) { cg[2][n2] = kc; ++n2; }
                        else { cg[3][n3] = kc; ++n3; }
                    }
        }
        bitonic_sort_desc16(cg[1]); bitonic_sort_desc16(cg[2]); bitonic_sort_desc16(cg[3]);
        merge_top16(cg[0], cg[1]); merge_top16(cg[2], cg[3]); merge_top16(cg[0], cg[2]);
        float tv[16]; int te[16];
#pragma unroll
        for (int rd = 0; rd < 16; ++rd) {
            const int mx = cg[0][rd];
            const int code = 255 - (mx & 0xFF), ca = code >> 4, cb = code & 15;
            const unsigned wa = (ca >> 2) == 0 ? i1p[0] : (ca >> 2) == 1 ? i1p[1] : (ca >> 2) == 2 ? i1p[2] : i1p[3];
            const unsigned wb = (cb >> 2) == 0 ? i2p[0] : (cb >> 2) == 1 ? i2p[1] : (cb >> 2) == 2 ? i2p[2] : i2p[3];
            const int i1 = (wa >> (8 * (ca & 3))) & 0xFF, i2 = (wb >> (8 * (cb & 3))) & 0xFF;
            te[rd] = i1 * 128 + i2;
            tv[rd] = __int_as_float(mx & ~0xFF);
        }
        {
            const float t0 = tv[0];
            float den = 0.f;
#pragma unroll
            for (int i = 0; i < 16; ++i) { tv[i] = __expf(tv[i] - t0); den += tv[i]; }
            const float rden = 1.0f / den;
#pragma unroll
            for (int i = 0; i < 16; ++i) tv[i] *= rden;
        }
        {
            int* ep = EIDX + (size_t)t * 128 + h * 16;
            float* gp = EG + (size_t)t * 128 + h * 16;
#pragma unroll
            for (int i = 0; i < 16; i += 4) {
                *(int __attribute__((ext_vector_type(4)))*)(ep + i) = (int __attribute__((ext_vector_type(4)))){te[i], te[i + 1], te[i + 2], te[i + 3]};
                *(f32x4*)(gp + i) = (f32x4){tv[i], tv[i + 1], tv[i + 2], tv[i + 3]};
            }
        }
    }
}

#define QCTR_WORD(ph, j) (3520 + ((ph) * 8 + (j)) * 16)
#define PEER_CHUNK_TOK 32
typedef __bf16 bf2_t __attribute__((ext_vector_type(2)));
__device__ __forceinline__ float dot2bf(unsigned a, unsigned b, float c) {
    union { unsigned u; bf2_t v; } x, y; x.u = a; y.u = b;
    return __builtin_amdgcn_fdot2_f32_bf16(x.v, y.v, c, false);
}
__device__ __forceinline__ float row16_sum(float v) { v = DPP_ROR_ADD(v, 8); v = DPP_ROR_ADD(v, 4); v = DPP_ROR_ADD(v, 2); v = DPP_ROR_ADD(v, 1); return v; }
__device__ __forceinline__ int queue_grab(unsigned* ctr, volatile int* slot) {
    __syncthreads();
    if (threadIdx.x == 0) *slot = (int)__hip_atomic_fetch_add(ctr, 1u, __ATOMIC_RELAXED, __HIP_MEMORY_SCOPE_AGENT);
    __syncthreads();
    return *slot;
}

#define DPP_ADD(v, ctrl) ((v) + __builtin_bit_cast(float, __builtin_amdgcn_update_dpp(0, __builtin_bit_cast(int, (v)), (ctrl), 0xf, 0xf, false)))
template <int WHICH>
__device__ __forceinline__ void phase_peer_sliced(const Args& a, unsigned char* lds, int qph, bool dry) {
    unsigned char* ws = a.ws;
    int tid_ = threadIdx.x; asm volatile("" : "+v"(tid_));
    const int tid = tid_, lane = tid & 63, c8 = lane & 7, g8 = lane >> 3;
    const int w = __builtin_amdgcn_readfirstlane(tid >> 6);
    const bf16_t* H2B = (const bf16_t*)(ws + WS_H2B);
    const int* EIDX = (const int*)(ws + WS_EIDX);
    const unsigned* W32 = (const unsigned*)(ws + WS_EG);
    float* PART = (float*)(ws + WS_PART);
    unsigned* bar = (unsigned*)(ws + WS_BAR);
    volatile int* slot = (volatile int*)(lds + LDS_BYTES - 32);
    const int myx = (int)(xb_xcc_id() & 7u);
    for (int qq = 0; qq < 8; ++qq) {
        const int j = (myx + qq) & 7;
        const unsigned char* TB = ws + (WHICH == 0 ? WS_UB : WS_VB) + (size_t)j * 16384 * 128;
        const unsigned lofs = (unsigned)c8 * 16u;
        for (;;) {
            int ch = 0;
            if (lane == 0) ch = (int)__hip_atomic_fetch_add(bar + QCTR_WORD(qph, j), 1u, __ATOMIC_RELAXED, __HIP_MEMORY_SCOPE_AGENT);
            ch = __builtin_amdgcn_readfirstlane(ch);
            if (ch >= T_TOK / (PEER_CHUNK_TOK / 4)) break;
            const int tbase = ch * (PEER_CHUNK_TOK / 4);
            constexpr int NTOK = PEER_CHUNK_TOK / 4;
            if (WHICH == 0) {
#define E1_ISSUE(ud_, esrc_) do { \
                    _Pragma("unroll") for (int i = 0; i < 8; ++i) { \
                        const int idx = __shfl(esrc_, 8 * i + g8); \
                        ud_[i] = *(const u32x4*)(TB + ((unsigned)idx * 128u + lofs)); } } while (0)
#define E1_DOT(ud_, res_) do { \
                    _Pragma("unroll") for (int i = 0; i < 8; ++i) { \
                        int d = __builtin_amdgcn_sdot4((int)ud_[i].x, hq[0], 0, false); \
                        d = __builtin_amdgcn_sdot4((int)ud_[i].y, hq[1], d, false); \
                        d = __builtin_amdgcn_sdot4((int)ud_[i].z, hq[2], d, false); \
                        d = __builtin_amdgcn_sdot4((int)ud_[i].w, hq[3], d, false); \
                        d += __builtin_amdgcn_update_dpp(0, d, 0xB1, 0xf, 0xf, false); \
                        d += __builtin_amdgcn_update_dpp(0, d, 0x4E, 0xf, 0xf, false); \
                        d += __builtin_amdgcn_update_dpp(0, d, 0x141, 0xf, 0xf, false); \
                        if (c8 == i) res_ = d; } } while (0)
                int e0 = EIDX[(size_t)tbase * 128 + lane], e1 = EIDX[(size_t)tbase * 128 + 64 + lane];
                const unsigned char* H2Q = ws + WS_H2Q;
                u32x4 h0 = *(const u32x4*)(H2Q + (size_t)tbase * 1024 + j * 128 + c8 * 16);
                u32x4 udA[8], udB[8];
                E1_ISSUE(udA, e0);
#pragma unroll 1
                for (int tt = 0; tt < NTOK; ++tt) {
                    const int t = tbase + tt;
                    E1_ISSUE(udB, e1);
                    const int hq[4] = {(int)h0.x, (int)h0.y, (int)h0.z, (int)h0.w};
                    if (tt + 1 < NTOK) {
                        e0 = EIDX[(size_t)(t + 1) * 128 + lane]; e1 = EIDX[(size_t)(t + 1) * 128 + 64 + lane];
                        h0 = *(const u32x4*)(H2Q + (size_t)(t + 1) * 1024 + j * 128 + c8 * 16);
                    }
                    int res0 = 0, res1 = 0;
                    E1_DOT(udA, res0);
                    if (tt + 1 < NTOK) E1_ISSUE(udA, e0);
                    E1_DOT(udB, res1);
                    int* pp = (int*)PART + ((size_t)j * T_TOK + t) * 128 + 8 * c8 + g8;
                    pp[0] = res0; pp[64] = res1;
                }
#undef E1_ISSUE
#undef E1_DOT
            } else {
#define E3_ISSUE(vd_, wk_, wsrc_) do { \
                    _Pragma("unroll") for (int i = 0; i < 8; ++i) { \
                        const unsigned pk = (unsigned)__shfl((int)(wsrc_), 8 * i + g8); \
                        wk_[i] = __uint_as_float(pk & 0xFFFF0000u); \
                        vd_[i] = *(const u32x4*)(TB + ((pk & 0xFFFFu) * 128u + lofs)); } } while (0)
#define E3_FMA(vd_, wk_) do { \
                    _Pragma("unroll") for (int i = 0; i < 8; ++i) { \
                        _Pragma("unroll") for (int q = 0; q < 4; ++q) { \
                            const f32x2 lo = __builtin_amdgcn_cvt_pk_f32_fp8((int)vd_[i][q], false), hi = __builtin_amdgcn_cvt_pk_f32_fp8((int)vd_[i][q], true); \
                            acc[4 * q] += wk_[i] * lo[0]; acc[4 * q + 1] += wk_[i] * lo[1]; acc[4 * q + 2] += wk_[i] * hi[0]; acc[4 * q + 3] += wk_[i] * hi[1]; } } } while (0)
                unsigned wa = W32[(size_t)tbase * 128 + lane], wb = W32[(size_t)tbase * 128 + 64 + lane];
                u32x4 vdA[8], vdB[8]; float wkA[8], wkB[8];
                E3_ISSUE(vdA, wkA, wa);
#pragma unroll 1
                for (int tt = 0; tt < NTOK; ++tt) {
                    const int t = tbase + tt;
                    E3_ISSUE(vdB, wkB, wb);
                    if (tt + 1 < NTOK) { wa = W32[(size_t)(t + 1) * 128 + lane]; wb = W32[(size_t)(t + 1) * 128 + 64 + lane]; }
                    u32x4 hr0, hr1;
                    if (!dry && g8 == 0) { const bf16_t* hp = H2B + (size_t)t * 1024 + j * 128 + c8 * 16; hr0 = *(const u32x4*)hp; hr1 = *(const u32x4*)(hp + 8); }
                    float acc[16];
#pragma unroll
                    for (int e = 0; e < 16; ++e) acc[e] = 0.f;
                    E3_FMA(vdA, wkA);
                    if (tt + 1 < NTOK) E3_ISSUE(vdA, wkA, wa);
                    E3_FMA(vdB, wkB);
#pragma unroll
                    for (int e = 0; e < 16; ++e) { acc[e] = DPP_ADD(acc[e], 0x128); acc[e] += __shfl_xor(acc[e], 16); acc[e] += __shfl_xor(acc[e], 32); }
                    if (dry) {
#pragma unroll
                        for (int e = 0; e < 16; ++e) asm volatile("" :: "v"(acc[e]));
                    } else if (g8 == 0) {
                        float* op = a.out + (size_t)t * 1024 + j * 128 + c8 * 16;
                        float v0[8], v1[8]; unpack8(hr0, v0); unpack8(hr1, v1);
#pragma unroll
                        for (int q = 0; q < 4; ++q) {
                            f32x4 oq;
#pragma unroll
                            for (int e = 0; e < 4; ++e) oq[e] = (q < 2 ? v0[4 * q + e] : v1[4 * (q - 2) + e]) + acc[4 * q + e] * (1.0f / V_SCALE);
                            *(f32x4*)(op + 4 * q) = oq;
                        }
                    }
                }
#undef E3_ISSUE
#undef E3_FMA
            }
        }
    }
}

__device__ __forceinline__ void phase_peer_weights(const Args& a) {
    unsigned char* ws = a.ws;
    float* EG = (float*)(ws + WS_EG);
    const int* EIDX = (const int*)(ws + WS_EIDX);
    const float* PART = (const float*)(ws + WS_PART);
    const float* RSTD2 = (const float*)(ws + WS_RSTD2);
    typedef int i32x4 __attribute__((ext_vector_type(4)));
    const float* USC = (const float*)(ws + WS_USCALE);
    for (size_t i = (size_t)blockIdx.x * NT + threadIdx.x; i < (size_t)T_TOK * 128 / 4; i += (size_t)gridDim.x * NT) {
        i32x4 s = *(const i32x4*)((const int*)PART + i * 4);
#pragma unroll
        for (int j = 1; j < 8; ++j) { const i32x4 p = *(const i32x4*)((const int*)PART + (size_t)j * T_TOK * 128 + i * 4); s[0] += p[0]; s[1] += p[1]; s[2] += p[2]; s[3] += p[3]; }
        const f32x4 gq = *(const f32x4*)(EG + i * 4);
        const i32x4 ev = *(const i32x4*)(EIDX + i * 4);
        const float rs2 = RSTD2[(i * 4) >> 7];
        u32x4 o;
#pragma unroll
        for (int e = 0; e < 4; ++e) {
            const float z = (float)s[e] * USC[ev[e]] * (H2Q_CLIP / 127.0f) * rs2;
            o[e] = (f2bf(gq[e] * gelu_tanh(z)) << 16) | (unsigned)ev[e];
        }
        *(u32x4*)(EG + i * 4) = o;
    }
}

__device__ __forceinline__ void phase_mixnorm(const Args& a) {
    unsigned char* ws = a.ws;
    const int tid = threadIdx.x, lane = tid & 63, w = tid >> 6;
    const int gw = blockIdx.x * NWV + w, nw = gridDim.x * NWV;
    bf16_t* O = (bf16_t*)(ws + WS_OMIX);
    for (int t = gw; t < T_TOK; t += nw) {
        bf16_t* row = O + (size_t)t * 1024 + lane * 8;
        float x[8], y[8];
        unpack8(*(const u32x4*)row, x);
        float s1 = 0.f, s2 = 0.f;
#pragma unroll
        for (int e = 0; e < 8; ++e) s1 += x[e] * x[e];
        s1 = wave_sum(s1);
        const float r1 = rsqrtf(s1 * (1.0f / 512.0f) + EPSN);
#pragma unroll
        for (int e = 0; e < 8; ++e) x[e] *= r1;
        *(u32x4*)row = pack8(x);
#if STAGE >= 2
        unpack8(*(const u32x4*)(row + 512), y);
#pragma unroll
        for (int e = 0; e < 8; ++e) s2 += y[e] * y[e];
        s2 = wave_sum(s2);
        const float r2 = rsqrtf(s2 * (1.0f / 512.0f) + EPSN);
#pragma unroll
        for (int e = 0; e < 8; ++e) y[e] *= r2;
#else
#pragma unroll
        for (int e = 0; e < 8; ++e) y[e] = 0.f;
        (void)s2;
#endif
        *(u32x4*)(row + 512) = pack8(y);
    }
}

#define N_PHASES 17
__global__ void __launch_bounds__(NT, 2) mega(Args a) {
    extern __shared__ __attribute__((aligned(16))) unsigned char lds[];
    unsigned char* ws = a.ws;
    const int tid = threadIdx.x;
    const int G = gridDim.x, bid = blockIdx.x;
    volatile unsigned* bst = (volatile unsigned*)(lds + LDS_BYTES - 16);
    XcdBarrier bar; bar.bar = (unsigned*)(ws + WS_BAR); bar.x = 0; bar.st = bst;
    const bool multi = (a.ph_hi - a.ph_lo) > 1;
    if (multi) {
        if (tid == 0) { bst[0] = 0u; bst[1] = 0u; }
        __syncthreads();
        bar = xcd_barrier_post((unsigned*)(ws + WS_BAR), bst);
    }
#define PH(k) (a.ph_lo <= (k) && (k) < a.ph_hi)
#define SEAM(k) do { if (PH(k) && PH((k) + 1)) { xcd_barrier(bar); if ((PROBE_MASK >> 22) & 1) { xcd_barrier(bar); xcd_barrier(bar); } } } while (0)
#define GEMM_BITS ((1 << 1) | (1 << 8) | (1 << 9) | (1 << 12))
#define PMASK2 (PROBE_MASK & ~GEMM_BITS & 0xFFFFF)
#define TREP(k) (1 + ((PROBE_MASK >> (k)) & 1))
#define FOR_TILES_XCD(nM, nN, m_, n_) for (int L_ = (bid >> 3); L_ < ((nM) >> 3) * (nN); L_ += (G >> 3)) { const int m_ = (bid & 7) + 8 * (L_ / (nN)); const int n_ = L_ % (nN);
#define PHREP(k) if (PH(k)) for (int rep_ = 0; rep_ <= ((PMASK2 >> (k)) & 1); ++rep_) if (rep_ ? (xcd_barrier(bar), true) : true)
#define LASTREP(k) (rep_ == ((PMASK2 >> (k)) & 1))

    PHREP(0) phase_prep(a, lds);
    SEAM(0);
    PHREP(1) {
        Epi8InProj e1{(const float*)(ws + WS_RSTD0), (bf16_t*)(ws + WS_P), (bf16_t*)(ws + WS_QN), (bf16_t*)(ws + WS_KS), (bf16_t*)(ws + WS_KW),
                     (bf16_t*)(ws + WS_KCIN), (bf16_t*)(ws + WS_VCIN), (float*)(ws + WS_GATE), (const f32x2*)(ws + WS_ROPEN), a.in[9], a.in[10], (float*)(ws + WS_CSSQ)};
        for (int rp = 0; rp < TREP(1); ++rp) {
            gemm8((const bf16_t*)(ws + WS_XB), 1024, (const bf16_t*)(ws + WS_WIN), 1024, 1024, 256, 7, e1, lds);
            { Epi8RowScaleBf16 e2{(bf16_t*)(ws + WS_KVX), 1024, (const float*)(ws + WS_RSTDMEM)};
              gemm8((const bf16_t*)(ws + WS_MEMB), 1024, (const bf16_t*)(ws + WS_WXKV), 1024, 1024, 16, 4, e2, lds); }
        }
        if (bid == G - 1 && tid < 256) {
            float s = 0.f;
            const float* bp = (const float*)(ws + WS_BIASP);
            const int kv = tid >> 7, j = tid & 127;
            for (int i = 0; i < 32; ++i) s += bp[(kv * 32 + i) * 128 + j];
            ((float*)(ws + WS_BIAS1))[tid] = s;
        }
    }
    SEAM(1);
    PHREP(3) {
        Epi8QUp eq{(bf16_t*)(ws + WS_QMRAW), 768, (const float*)(ws + WS_CSSQ)};
        Epi8KvUp ek{(const float*)(ws + WS_CSSQ), (const bf16_t*)(ws + WS_P), (const f32x2*)(ws + WS_ROPEM), a.in[8] + 96, (bf16_t*)(ws + WS_KM), (bf16_t*)(ws + WS_KVRAW)};
#if STAGE >= 2
        for (int it = bid; it < 256; it += G) {
            const int kv = it >> 7, mi = (it >> 2) & 31, ksl = it & 3;
            EpiF32 ep{(float*)(ws + WS_PARTC) + ((size_t)(ksl * 2 + kv) * 8192) * 128, 128, 128};
            gemm_tile<false>((const bf16_t*)(ws + (kv ? WS_VCIN : WS_KCIN)) + ksl * 512, 1024, (const bf16_t*)(ws + WS_W1C) + (size_t)kv * 128 * 2048 + ksl * 512, 2048, 512, mi * 256, 0, ep, lds);
        }
#endif
        gemm8((const bf16_t*)(ws + WS_P) + C_CQ, PLD, (const bf16_t*)(ws + WS_WUQ), 256, 256, 256, 3, eq, lds);
        gemm8((const bf16_t*)(ws + WS_P) + C_CKV, PLD, (const bf16_t*)(ws + WS_WUKV), 128, 128, 256, 4, ek, lds);
#if STAGE >= 2
        for (int id0 = 2 * bid; id0 < 2 * 32 * 64; id0 += 2 * G) {
            const int idr = id0 + (tid >> 8); const bool ok = idr < 2 * 32 * 64; const int id = ok ? idr : 0;
            const int which = id >> 11, bg = (id >> 6) & 31, st = id & 63, b = bg >> 1, g = bg & 1;
            const bf16_t* src = (const bf16_t*)(ws + WS_P) + ((size_t)b * SEQ + st * 64) * PLD + (which ? C_VW : C_VS) + g * 64;
            bf16_t* dst = (bf16_t*)(ws + (which ? WS_VWT : WS_VST)) + (size_t)bg * 64 * SEQ + st * 64;
            tr_tile(src, PLD, dst, SEQ, (bf16_t*)lds, ok);
        }
#endif
    }
    SEAM(3);
    PHREP(4) {
        const bool xa_wg = false;
        const int vb = bid, VG = G;
        if (!xa_wg) for (int id0 = 2 * vb; id0 < 128 * 64; id0 += 2 * VG) {
            const int idr = id0 + (tid >> 8); const bool ok = idr < 128 * 64; const int id = ok ? idr : 0;
            const int bh = id >> 6, st = id & 63, b = bh >> 3, h = bh & 7;
            const bf16_t* src = (const bf16_t*)(ws + WS_KVRAW) + ((size_t)b * SEQ + st * 64) * 1024 + h * 128 + 64;
            bf16_t* dst = (bf16_t*)(ws + WS_VMT) + (size_t)bh * 64 * SEQ + st * 64;
            tr_tile(src, 1024, dst, SEQ, (bf16_t*)lds, ok);
        }
#if STAGE >= 2
        if (!xa_wg) for (int i = vb * NT + tid; i < 2 * 8192 * 128 / 4; i += VG * NT) {
            const float* pp = (const float*)(ws + WS_PARTC) + (size_t)i * 4;
            f32x4 s = *(const f32x4*)pp;
#pragma unroll
            for (int k = 1; k < 4; ++k) { const f32x4 p = *(const f32x4*)(pp + (size_t)k * 2 * 8192 * 128); s[0] += p[0]; s[1] += p[1]; s[2] += p[2]; s[3] += p[3]; }
            const int kv = i >> 18, col = (i * 4) & 127;
            const f32x4 bq = *(const f32x4*)((const float*)(ws + WS_BIAS1) + kv * 128 + col);
            float v[4];
#pragma unroll
            for (int e = 0; e < 4; ++e) v[e] = gelu_tanh(s[e] + bq[e]);
            *(u32x2*)((bf16_t*)(ws + WS_HID) + (size_t)i * 4) = pack4(v);
        }
#endif
    }
    SEAM(4);
#if STAGE >= 2
    PHREP(5) {
#if STAGE >= 3
        {
            const bool cmp_wg = G > 64 && bid < 64;
            const int vb = G > 64 ? bid - 64 : bid, VG = G > 64 ? G - 64 : G;
            if (!cmp_wg) {
                phase_xa_k(a, vb, VG);
                for (int id0 = 2 * vb; id0 < 16 * 4 * 8; id0 += 2 * VG) {
                    const int idr = id0 + (tid >> 8); const bool ok = idr < 16 * 4 * 8; const int id = ok ? idr : 0;
                    const int b = id >> 5, mt = (id >> 3) & 3, ct = id & 7;
                    const bf16_t* src = (const bf16_t*)(ws + WS_KVX) + ((size_t)b * 256 + mt * 64) * 1024 + 512 + ct * 64;
                    bf16_t* dst = (bf16_t*)(ws + WS_VXT) + ((size_t)b * 512 + ct * 64) * 256 + mt * 64;
                    tr_tile(src, 1024, dst, 256, (bf16_t*)lds, ok);
                }
            }
        }
#endif
        for (int it = bid; it < 64; it += G) {
            const int kv = it >> 5, mi = it & 31;
            EpiCmpFin ec{kv, (const f32x2*)(ws + WS_ROPEN), a.in[10], (bf16_t*)(ws + WS_KC), (bf16_t*)(ws + WS_VCT)};
            gemm_tile<false>((const bf16_t*)(ws + WS_HID) + (size_t)kv * 8192 * 128, 128, (const bf16_t*)(ws + WS_W2C) + (size_t)kv * 128 * 128, 128, 128, mi * 256, 0, ec, lds);
        }
    }
#endif
    SEAM(5);
    PHREP(6) {
        if (G == 256) {
            const int x = bid & 7, r = bid >> 3;
            for (int rp = 0; rp < TREP(20); ++rp)
                for (int i = 0; i < 8; ++i) {
                    const int bh = x + 8 * (2 * i + (r >> 4));
                    const int qt = (i & 1) ? 15 - (r & 15) : (r & 15);
                    mla_unit(a, bh >> 3, bh & 7, qt, lds);
                }
#if STAGE >= 2
            for (int rp = 0; rp < TREP(21); ++rp)
                for (int i = 0; i < 8; ++i) {
                    const int bg = x + 8 * (i >> 1);
                    const int jq = (i & 1) ? 63 - r : r;
                    nsa_unit(a, bg >> 1, bg & 1, jq, lds);
                }
#endif
        } else {
            for (int u = bid; u < 2048; u += G) {
                const int qt = 15 - (u >> 7), bh = u & 127;
                mla_unit(a, bh >> 3, bh & 7, qt, lds);
            }
#if STAGE >= 2
            for (int u = bid; u < 2048; u += G) {
                const int jq = 63 - (u >> 5), bg = u & 31;
                nsa_unit(a, bg >> 1, bg & 1, jq, lds);
            }
#endif
        }
    }
    SEAM(6);
    PHREP(8) {
        Epi8ResBf16S er{(const bf16_t*)(ws + WS_XB), (bf16_t*)(ws + WS_H1B), (float*)(ws + WS_H1SSQ)};
        for (int rp = 0; rp < TREP(8); ++rp) {
            gemm8<Epi8ResBf16S, true>((const bf16_t*)(ws + WS_OMIX), 1024, (const bf16_t*)(ws + WS_WOUT), 1024, 1024, 256, 4, er, lds, (const float*)(ws + WS_SSQ)); }
    }
    SEAM(8);
#if STAGE >= 3
    PHREP(9) {
        Epi8RssScaleBf16 eq{(bf16_t*)(ws + WS_QX), 512, (const float*)(ws + WS_H1SSQ), nullptr};
        for (int rp = 0; rp < TREP(9); ++rp) {
            gemm8((const bf16_t*)(ws + WS_H1B), 1024, (const bf16_t*)(ws + WS_WXQ), 1024, 1024, 256, 2, eq, lds); }
    }
    SEAM(9);
    PHREP(10) {
        for (int u = bid; u < 1024; u += G) xa_unit(a, u >> 6, (u >> 4) & 3, u & 15, lds);
    }
    SEAM(10);
    PHREP(11) {
        Epi8ResBf16Q er{(const bf16_t*)(ws + WS_H1B), (bf16_t*)(ws + WS_H2B), (unsigned*)(ws + WS_H2Q), (float*)(ws + WS_H2SSQ)};
        gemm8(( const bf16_t*)(ws + WS_OX), 512, (const bf16_t*)(ws + WS_WXO), 512, 512, 256, 4, er, lds);
    }
    SEAM(11);
#endif
#if STAGE >= 4
    PHREP(12) {
        Epi8RssScaleBf16 eq{(bf16_t*)(ws + WS_QP), 1024, (const float*)(ws + WS_H2SSQ), (float*)(ws + WS_RSTD2)};
        for (int rp = 0; rp < TREP(12); ++rp) {
            gemm8((const bf16_t*)(ws + WS_H2B), 1024, (const bf16_t*)(ws + WS_WPQ), 1024, 1024, 256, 4, eq, lds); }
    }
    SEAM(12);
    PHREP(13) phase_peer_route(a);
    SEAM(13);
    PHREP(14) phase_peer_sliced<0>(a, lds, rep_, false);
    SEAM(14);
    PHREP(15) phase_peer_weights(a);
    SEAM(15);
    PHREP(16) phase_peer_sliced<1>(a, lds, 2 + rep_, !LASTREP(16));
#endif
#undef PH
#undef SEAM
}

extern "C" void kernel_launch(void* const* d_in, const int* in_sizes, int n_in, void* d_out, int out_size, void* d_ws, size_t ws_size, hipStream_t stream) {
    static int grid = 0;
    if (grid == 0) {
        if (n_in != 27 || ws_size < WS_END) { fprintf(stderr, "kernel_launch: unexpected n_in %d or ws_size %zu (< %zu)\n", n_in, ws_size, (size_t)WS_END); grid = -1; return; }
        int dev = 0, cus = 0, per_cu = 0;
        hipGetDevice(&dev);
        hipDeviceGetAttribute(&cus, hipDeviceAttributeMultiprocessorCount, dev);
        hipFuncSetAttribute((const void*)mega, hipFuncAttributeMaxDynamicSharedMemorySize, LDS_BYTES);
        if (hipOccupancyMaxActiveBlocksPerMultiprocessor(&per_cu, (const void*)mega, NT, LDS_BYTES) != hipSuccess || per_cu < 1) per_cu = 1;
        (void)hipGetLastError();
        if (per_cu > 1) per_cu = 1;
        grid = cus * per_cu;
    }
    if (grid < 0) return;
    hipMemsetAsync((unsigned char*)d_ws + WS_BAR, 0, 16384, stream);
    Args a{};
    for (int i = 0; i < 27; ++i) a.in[i] = (const float*)d_in[i];
    a.out = (float*)d_out; a.ws = (unsigned char*)d_ws;
#if ONE_LAUNCH
    a.ph_lo = 0; a.ph_hi = N_PHASES;
    hipLaunchKernelGGL(mega, dim3(grid), dim3(NT), LDS_BYTES, stream, a);
#else
    for (int p = 0; p < N_PHASES; ++p) {
        a.ph_lo = p; a.ph_hi = p + 1;
        hipLaunchKernelGGL(mega, dim3(grid), dim3(NT), LDS_BYTES, stream, a);
    }
#endif
}
```

```cpp
#include <hip/hip_runtime.h>
#include <cstdio>
#include <cstdint>

#ifndef STAGE
#define STAGE 4
#endif
#ifndef ONE_LAUNCH
#define ONE_LAUNCH 1
#endif
#ifndef PROBE_MASK
#define PROBE_MASK 0
#endif

typedef unsigned short bf16_t;
typedef short bf16x8 __attribute__((ext_vector_type(8)));
typedef float f32x16 __attribute__((ext_vector_type(16)));
typedef float f32x4 __attribute__((ext_vector_type(4)));
typedef float f32x2 __attribute__((ext_vector_type(2)));
typedef unsigned u32x4 __attribute__((ext_vector_type(4)));
typedef unsigned u32x2 __attribute__((ext_vector_type(2)));

#define T_TOK 65536
#define SEQ 4096
#define NBATCH 16
#define DM 1024
#define INC 1720
#define PLD 1728
#define INP 1792
#define C_CQ 1280
#define C_CKV 1536
#define C_KPE 1664
#define C_QN 416
#define C_KC 928
#define C_VC 1056
#define C_KS 1184
#define C_VS 1024
#define C_KW 1440
#define C_VW 1152
#define C_GATE 1696
#define EPSN 1e-6f
#define LOG2E 1.4426950408889634f

#define MIB (1024ull * 1024ull)
constexpr size_t WS_R1   = 0;
constexpr size_t WS_R2   = WS_R1 + 128 * MIB;
constexpr size_t WS_R3   = WS_R2 + 216 * MIB;
constexpr size_t WS_R4   = WS_R3 + 96 * MIB;
constexpr size_t WS_R5   = WS_R4 + 128 * MIB;
constexpr size_t WS_R6   = WS_R5 + 96 * MIB;
constexpr size_t WS_R7   = WS_R6 + 64 * MIB;
constexpr size_t WS_KS   = WS_R7 + 64 * MIB;
constexpr size_t WS_KW   = WS_KS + 16 * MIB;
constexpr size_t WS_VST  = WS_KW + 16 * MIB;
constexpr size_t WS_VWT  = WS_VST + 16 * MIB;
constexpr size_t WS_KCIN = WS_VWT + 16 * MIB;
constexpr size_t WS_VCIN = WS_KCIN + 16 * MIB;
constexpr size_t WS_PAD0 = WS_VCIN + 16 * MIB;
constexpr size_t WS_HID  = WS_PAD0 + 65536;
constexpr size_t WS_CRAW = WS_HID + 4 * MIB;
constexpr size_t WS_KC   = WS_CRAW + 4 * MIB;
constexpr size_t WS_VCT  = WS_KC + 1 * MIB;
constexpr size_t WS_GATE = WS_VCT + 1 * MIB;
constexpr size_t WS_RSTD0 = WS_GATE + 6 * MIB;
constexpr size_t WS_RSTDCQ = WS_RSTD0 + 262144;
constexpr size_t WS_RSTDCKV = WS_RSTDCQ + 262144;
constexpr size_t WS_RSTD2 = WS_RSTDCKV + 262144;
constexpr size_t WS_RSTDMEM = WS_RSTD2 + 262144;
constexpr size_t WS_UB   = WS_RSTDMEM + 16384;
constexpr size_t WS_VB   = WS_UB + 16 * MIB;
constexpr size_t WS_PARTC = WS_UB + 32 * MIB;
constexpr size_t WS_WIN  = WS_UB + 64 * MIB;
constexpr size_t WS_WUQ  = WS_WIN + 1792 * 1024 * 2;
constexpr size_t WS_WUKV = WS_WUQ + 768 * 256 * 2;
constexpr size_t WS_W1C  = WS_WUKV + 1024 * 128 * 2;
constexpr size_t WS_W2C  = WS_W1C + 2 * 128 * 2048 * 2;
constexpr size_t WS_WOUT = WS_W2C + 2 * 128 * 128 * 2;
constexpr size_t WS_WXQ  = WS_WOUT + 2 * MIB;
constexpr size_t WS_WXKV = WS_WXQ + 1 * MIB;
constexpr size_t WS_WXO  = WS_WXKV + 2 * MIB;
constexpr size_t WS_WPQ  = WS_WXO + 1 * MIB;
constexpr size_t WS_KP   = WS_WPQ + 2 * MIB;
constexpr size_t WS_MEMB = WS_KP + 262144;
constexpr size_t WS_KVX  = WS_MEMB + 8 * MIB;
constexpr size_t WS_KX   = WS_KVX + 8 * MIB;
constexpr size_t WS_VXT  = WS_KX + 4 * MIB;
constexpr size_t WS_ROPEM = WS_VXT + 4 * MIB;
constexpr size_t WS_ROPEN = WS_ROPEM + 524288;
constexpr size_t WS_BIASP = WS_ROPEN + 262144;
constexpr size_t WS_BIAS1 = WS_BIASP + 32768;
constexpr size_t WS_BAR  = WS_BIAS1 + 1024;
constexpr size_t WS_END  = WS_BAR + 16384;
constexpr size_t WS_XB = WS_R1, WS_H1B = WS_R1;
constexpr size_t WS_P = WS_R2, WS_OMIX = WS_R2, WS_QP = WS_R2, WS_QX = WS_R2 + 128 * MIB;
constexpr size_t WS_QMRAW = WS_R3, WS_OX = WS_R3;
constexpr size_t WS_KVRAW = WS_R4, WS_H2B = WS_R4;
constexpr size_t WS_KM = WS_R5, WS_EIDX = WS_R5, WS_EG = WS_R5 + 32 * MIB;
constexpr size_t WS_VMT = WS_R6, WS_QN = WS_R7;
constexpr size_t WS_SSQ = WS_CRAW;
constexpr size_t WS_USCALE = WS_RSTDCQ;
constexpr size_t WS_H2Q = WS_R6;
constexpr size_t WS_H2SSQ = WS_GATE;
constexpr size_t WS_H1SSQ = WS_HID;
constexpr size_t WS_CSSQ = WS_R6;
constexpr size_t WS_PART = WS_R2;

#define NT 512
#define NWV 8
#define LDS_BYTES 151552

__device__ __forceinline__ unsigned f2bf(float f) { unsigned u = __float_as_uint(f); u += 0x7FFFu + ((u >> 16) & 1u); return u >> 16; }
typedef __bf16 bf2n_t __attribute__((ext_vector_type(2)));
__device__ __forceinline__ unsigned pack2(float lo, float hi) { bf2n_t v; v[0] = (__bf16)lo; v[1] = (__bf16)hi; return __builtin_bit_cast(unsigned, v); }
__device__ __forceinline__ float bflo(unsigned w) { return __uint_as_float(w << 16); }
__device__ __forceinline__ float bfhi(unsigned w) { return __uint_as_float(w & 0xFFFF0000u); }
__device__ __forceinline__ float bf2f(bf16_t b) { return __uint_as_float(((unsigned)b) << 16); }
__device__ __forceinline__ void unpack8(const u32x4& r, float (&v)[8]) {
    v[0] = bflo(r.x); v[1] = bfhi(r.x); v[2] = bflo(r.y); v[3] = bfhi(r.y);
    v[4] = bflo(r.z); v[5] = bfhi(r.z); v[6] = bflo(r.w); v[7] = bfhi(r.w);
}
__device__ __forceinline__ u32x4 pack8(const float (&v)[8]) {
    u32x4 r; r.x = pack2(v[0], v[1]); r.y = pack2(v[2], v[3]); r.z = pack2(v[4], v[5]); r.w = pack2(v[6], v[7]); return r;
}
__device__ __forceinline__ int kap(int p) { return (p & ~0xC) | ((p & 4) << 1) | ((p & 8) >> 1); }
__device__ __forceinline__ float wave_sum(float v) {
    v += __shfl_xor(v, 32); v += __shfl_xor(v, 16); v += __shfl_xor(v, 8); v += __shfl_xor(v, 4); v += __shfl_xor(v, 2); v += __shfl_xor(v, 1); return v;
}
__device__ __forceinline__ float gelu_tanh(float x) {
    const float u = 0.7978845608028654f * (x + 0.044715f * x * x * x);
    const float e = __expf(2.0f * u);
    const float t = 1.0f - 2.0f / (e + 1.0f);
    return 0.5f * x * (1.0f + t);
}
__device__ __forceinline__ bf16x8 as_bf16x8(const u32x4& r) { union { u32x4 u; bf16x8 b; } c; c.u = r; return c.b; }
#define DPP_ROR_ADD(v, n) ((v) + __builtin_bit_cast(float, __builtin_amdgcn_update_dpp(0, __builtin_bit_cast(int, (v)), 0x120 + (n), 0xf, 0xf, false)))
#define MFMA32(a, b, c) __builtin_amdgcn_mfma_f32_32x32x16_bf16((a), (b), (c), 0, 0, 0)

struct Args {
    const float* in[27];
    float* out;
    unsigned char* ws;
    int ph_lo, ph_hi;
};

#define XB_TMO      128
#define XB_XCNT(j)  (256  + 64 * (j))
#define XB_XSUB(j)  (1280 + 64 * (j))
#define XB_XGEN(j)  (2304 + 64 * (j))
#define XB_TOP      3328
#define XB_TOPGEN   3392
#define XCD_BAR_WORDS 3456
#define XB_SPIN_CAP (1u << 22)
#define LAS __attribute__((address_space(3)))
__device__ __forceinline__ unsigned xb_ld(unsigned* p)              { return __hip_atomic_load(p, __ATOMIC_RELAXED, __HIP_MEMORY_SCOPE_AGENT); }
__device__ __forceinline__ unsigned xb_add(unsigned* p, unsigned v) { return __hip_atomic_fetch_add(p, v, __ATOMIC_RELAXED, __HIP_MEMORY_SCOPE_AGENT); }
__device__ __forceinline__ unsigned xb_xcc_id() { return (unsigned)__builtin_amdgcn_s_getreg((3 << 11) | 20) & 0xFu; }
#define XB_SPIN(cond, bar) do { unsigned _sp = 0; while (cond) { __builtin_amdgcn_s_sleep(1); \
    if ((++_sp & 255u) == 0u) { if (xb_ld(&(bar)[XB_TMO])) break; if (_sp > XB_SPIN_CAP) { atomicAdd(&(bar)[XB_TMO], 1u); break; } } } } while (0)
struct XcdBarrier { unsigned* bar; unsigned x; volatile unsigned* st; };
__device__ __forceinline__ XcdBarrier xcd_barrier_post(unsigned* bar, volatile unsigned* st) {
    XcdBarrier b; b.bar = bar; b.x = xb_xcc_id(); b.st = st;
    if (threadIdx.x == 0) (void)xb_add(&bar[XB_XCNT(b.x)], 1u);
    return b;
}
__device__ __forceinline__ void xcd_barrier_complete(unsigned* bar, unsigned x, unsigned& nloc, unsigned& nx) {
    const unsigned G = gridDim.x;
    unsigned sum, cnt, mine, sp = 0u;
    for (;;) {
        sum = 0u; cnt = 0u; mine = 0u;
#pragma unroll
        for (unsigned j = 0; j < 16; ++j) { const unsigned c = xb_ld(&bar[XB_XCNT(j)]); sum += c; cnt += (c > 0u) ? 1u : 0u; mine = (j == x) ? c : mine; }
        if (sum == G) break;
        __builtin_amdgcn_s_sleep(1);
        if ((++sp & 255u) == 0u) { if (xb_ld(&bar[XB_TMO])) break; if (sp > XB_SPIN_CAP) { atomicAdd(&bar[XB_TMO], 1u); break; } }
    }
    nloc = mine > 0u ? mine : 1u; nx = cnt > 0u ? cnt : 1u;
}
__device__ __forceinline__ void xcd_barrier(const XcdBarrier& b) {
    asm volatile("s_waitcnt vmcnt(0)" ::: "memory");
    __syncthreads();
    if (threadIdx.x == 0) {
        unsigned* bar = b.bar;
        __builtin_amdgcn_s_waitcnt(0);
        unsigned nloc = b.st[0], nx = b.st[1];
        if (nloc == 0u) { xcd_barrier_complete(bar, b.x, nloc, nx); b.st[0] = nloc; b.st[1] = nx; }
        const unsigned old = xb_add(&bar[XB_XSUB(b.x)], 1u);
        const unsigned gen = old / nloc;
        if (old + 1u == (gen + 1u) * nloc) {
            __builtin_amdgcn_fence(__ATOMIC_RELEASE, "agent");
            asm volatile("s_waitcnt vmcnt(0)" ::: "memory");
            const unsigned og = xb_add(&bar[XB_TOP], 1u);
            const unsigned tg = og / nx;
            if (og + 1u == (tg + 1u) * nx) xb_add(&bar[XB_TOPGEN], 1u);
            else XB_SPIN(xb_ld(&bar[XB_TOPGEN]) == tg, bar);
            __builtin_amdgcn_fence(__ATOMIC_ACQUIRE, "agent");
            xb_add(&bar[XB_XGEN(b.x)], 1u);
            asm volatile("s_waitcnt vmcnt(0)" ::: "memory");
        } else {
            XB_SPIN(xb_ld(&bar[XB_XGEN(b.x)]) == gen, bar);
            __builtin_amdgcn_fence(__ATOMIC_ACQUIRE, "agent");
            asm volatile("s_waitcnt vmcnt(0)" ::: "memory");
        }
    }
    __syncthreads();
}

#define GEMM_XBYTES 36864
#define GEMM_STAGE_BYTES 73728
#define GEMM_MISC_OFF 147456
template <bool ROWSS, class Epi, bool MIXN = false>
__device__ __forceinline__ void gemm_tile(const bf16_t* __restrict__ A, int lda, const bf16_t* __restrict__ Bt, int ldb, int K,
                                          int m0, int n0, Epi& epi, unsigned char* lds, const float* __restrict__ ssq16 = nullptr) {
    int tid_ = threadIdx.x; asm volatile("" : "+v"(tid_));
    const int tid = tid_, lane = tid & 63, w = tid >> 6;
    const int wm = w & 1, wn = w >> 1, l31 = lane & 31, hh = lane >> 5;
    const int lrow = tid >> 3, lc = tid & 7;
    const bf16_t* ag = A + (size_t)(m0 + lrow) * lda + lc * 8;
    const bf16_t* bg = Bt + (size_t)(n0 + lrow) * ldb + lc * 8;
    u32x4 ra[4], rb[4];
    f32x16 acc[2][4];
#pragma unroll
    for (int i = 0; i < 2; ++i)
#pragma unroll
        for (int j = 0; j < 4; ++j)
#pragma unroll
            for (int r = 0; r < 16; ++r) acc[i][j][r] = 0.f;
    float ssq[4] = {0.f, 0.f, 0.f, 0.f};
    const int nk = K >> 6;
#pragma unroll
    for (int i = 0; i < 4; ++i) { ra[i] = *(const u32x4*)(ag + (size_t)i * 64 * lda); rb[i] = *(const u32x4*)(bg + (size_t)i * 64 * ldb); }
    float* rs = (float*)(lds + GEMM_MISC_OFF);
    float* rtab = (float*)(lds + GEMM_MISC_OFF + 1024);
    __syncthreads();
#define GEMM_STORE(stage_) do { \
        unsigned char* sb_ = lds + (stage_) * GEMM_STAGE_BYTES; \
        _Pragma("unroll") for (int i_ = 0; i_ < 4; ++i_) { \
            *(u32x4*)(sb_ + (lrow + 64 * i_) * 144 + lc * 16) = ra[i_]; \
            *(u32x4*)(sb_ + GEMM_XBYTES + (lrow + 64 * i_) * 144 + lc * 16) = rb[i_]; } \
        if (ROWSS) { _Pragma("unroll") for (int i_ = 0; i_ < 4; ++i_) { float v_[8]; unpack8(ra[i_], v_); \
            _Pragma("unroll") for (int e_ = 0; e_ < 8; ++e_) ssq[i_] += v_[e_] * v_[e_]; } } } while (0)
    GEMM_STORE(0);
    if (MIXN && tid < 256) {
        const float* sp = ssq16 + (size_t)(m0 + tid) * 16;
        const f32x4 a0 = *(const f32x4*)sp, a1 = *(const f32x4*)(sp + 4), b0 = *(const f32x4*)(sp + 8), b1 = *(const f32x4*)(sp + 12);
        const float s1 = ((a0[0] + a0[1]) + (a0[2] + a0[3])) + ((a1[0] + a1[1]) + (a1[2] + a1[3]));
        const float s2 = ((b0[0] + b0[1]) + (b0[2] + b0[3])) + ((b1[0] + b1[1]) + (b1[2] + b1[3]));
        const float r1 = rsqrtf(s1 * (1.0f / 512.0f) + EPSN), r2 = rsqrtf(s2 * (1.0f / 512.0f) + EPSN);
        rtab[tid] = r1 / r2; rtab[256 + tid] = r2;
    }
    __syncthreads();
    const int xoff = (wm * 128 + l31) * 144 + hh * 16;
    const int woff = GEMM_XBYTES + (wn * 64 + kap(l31)) * 144 + hh * 16;
#pragma unroll 1
    for (int kt = 0; kt < nk; ++kt) {
        const bool more = kt + 1 < nk;
        if (more) {
#pragma unroll
            for (int i = 0; i < 4; ++i) { ra[i] = *(const u32x4*)(ag + (size_t)i * 64 * lda + (kt + 1) * 64); rb[i] = *(const u32x4*)(bg + (size_t)i * 64 * ldb + (kt + 1) * 64); }
        }
        if (MIXN && kt == (nk >> 1)) {
#pragma unroll
            for (int mt = 0; mt < 4; ++mt) {
                const float f = rtab[wm * 128 + mt * 32 + l31];
#pragma unroll
                for (int nf = 0; nf < 2; ++nf)
#pragma unroll
                    for (int r = 0; r < 16; ++r) acc[nf][mt][r] *= f;
            }
        }
        const unsigned char* st = lds + (kt & 1) * GEMM_STAGE_BYTES;
#pragma unroll
        for (int ks = 0; ks < 4; ++ks) {
            bf16x8 xf[4], wf[2];
#pragma unroll
            for (int mt = 0; mt < 4; ++mt) xf[mt] = as_bf16x8(*(const u32x4*)(st + xoff + mt * 32 * 144 + ks * 32));
#pragma unroll
            for (int nf = 0; nf < 2; ++nf) wf[nf] = as_bf16x8(*(const u32x4*)(st + woff + nf * 32 * 144 + ks * 32));
#pragma unroll
            for (int nf = 0; nf < 2; ++nf)
#pragma unroll
                for (int mt = 0; mt < 4; ++mt) acc[nf][mt] = MFMA32(wf[nf], xf[mt], acc[nf][mt]);
        }
        if (more) GEMM_STORE((kt + 1) & 1);
        __syncthreads();
    }
#undef GEMM_STORE
    if (ROWSS) {
#pragma unroll
        for (int i = 0; i < 4; ++i) { float s = ssq[i]; s += __shfl_xor(s, 1); s += __shfl_xor(s, 2); s += __shfl_xor(s, 4); if (lc == 0) rs[lrow + 64 * i] = s; }
        __syncthreads();
    }
    unsigned char* stg = lds + w * 8704;
    const int rrow = lane >> 4, rch = lane & 15;
#pragma unroll
    for (int mt = 0; mt < 4; ++mt) {
#pragma unroll
        for (int nf = 0; nf < 2; ++nf)
#pragma unroll
            for (int j = 0; j < 2; ++j) {
                float* sp = (float*)(stg + l31 * 272 + (nf * 32 + 16 * j + 8 * hh) * 4);
                *(f32x4*)sp = (f32x4){acc[nf][mt][8 * j + 0], acc[nf][mt][8 * j + 1], acc[nf][mt][8 * j + 2], acc[nf][mt][8 * j + 3]};
                *(f32x4*)(sp + 4) = (f32x4){acc[nf][mt][8 * j + 4], acc[nf][mt][8 * j + 5], acc[nf][mt][8 * j + 6], acc[nf][mt][8 * j + 7]};
            }
#pragma unroll
        for (int i = 0; i < 8; ++i) {
            const int r = 4 * i + rrow;
            const f32x4 v4 = *(const f32x4*)(stg + r * 272 + rch * 16);
            const int rl = wm * 128 + mt * 32 + r;
            float v[4] = {v4[0], v4[1], v4[2], v4[3]};
            epi(m0 + rl, n0 + wn * 64 + rch * 4, v, ROWSS ? rs[rl] : (MIXN ? rtab[256 + rl] : 0.f));
        }
    }
}
template <bool ROWSS, class Epi, bool MIXN = false>
__device__ __forceinline__ void gemm_tiles_xcd(const bf16_t* __restrict__ A, int lda, const bf16_t* __restrict__ Bt, int ldb, int K, int nM, int nN,
                                               Epi& epi, unsigned char* lds, const float* __restrict__ ssq16 = nullptr) {
    const int bid = blockIdx.x, x = bid & 7, stride = gridDim.x >> 3, cnt = (nM >> 3) * nN;
    for (int L = bid >> 3; L < cnt; L += stride) {
        const int m = x + 8 * (L / nN), n = L % nN;
        gemm_tile<ROWSS, Epi, MIXN>(A, lda, Bt, ldb, K, m * 256, n * 256, epi, lds, ssq16);
    }
}

__device__ __forceinline__ u32x2 pack4(const float (&v)[4]) { u32x2 r; r.x = pack2(v[0], v[1]); r.y = pack2(v[2], v[3]); return r; }
struct EpiRowScaleBf16 {
    bf16_t* out; int ld; const float* scale; int ncol;
    __device__ __forceinline__ void operator()(int row, int col, float (&v)[4], float) const {
        if (col >= ncol) return;
        const float s = scale ? scale[row] : 1.0f;
#pragma unroll
        for (int e = 0; e < 4; ++e) v[e] *= s;
        *(u32x2*)(out + (size_t)row * ld + col) = pack4(v);
    }
};
struct EpiBiasGeluBf16 {
    bf16_t* out; int ld; const float* bias;
    __device__ __forceinline__ void operator()(int row, int col, float (&v)[4], float) const {
#pragma unroll
        for (int e = 0; e < 4; ++e) v[e] = gelu_tanh(v[e] + bias[col + e]);
        *(u32x2*)(out + (size_t)row * ld + col) = pack4(v);
    }
};
struct EpiF32 {
    float* out; int ld; int ncol;
    __device__ __forceinline__ void operator()(int row, int col, float (&v)[4], float) const {
        if (col >= ncol) return;
        *(f32x4*)(out + (size_t)row * ld + col) = (f32x4){v[0], v[1], v[2], v[3]};
    }
};
struct EpiResidual {
    const float* res_in; float* res_out; bf16_t* hb;
    __device__ __forceinline__ void operator()(int row, int col, float (&v)[4], float) const {
        const f32x4 a = *(const f32x4*)(res_in + (size_t)row * DM + col);
        v[0] += a[0]; v[1] += a[1]; v[2] += a[2]; v[3] += a[3];
        *(f32x4*)(res_out + (size_t)row * DM + col) = (f32x4){v[0], v[1], v[2], v[3]};
        if (hb) *(u32x2*)(hb + (size_t)row * DM + col) = pack4(v);
    }
};
struct EpiInProj {
    const float* rstd0; bf16_t* P; bf16_t* QN; bf16_t* KS; bf16_t* KW; bf16_t* KCIN; bf16_t* VCIN; float* GATE;
    const f32x2* ropen; const float* qg; const float* kg;
    __device__ __forceinline__ void operator()(int row, int col, float (&v)[4], float) const {
        const float rs = rstd0[row];
#pragma unroll
        for (int e = 0; e < 4; ++e) v[e] *= rs;
        const int seg = col >> 6, c64 = col & 63;
        const int b = row >> 12, s = row & 4095;
        if (seg < 12) {
            float ss = v[0] * v[0] + v[1] * v[1] + v[2] * v[2] + v[3] * v[3];
            ss = DPP_ROR_ADD(ss, 8); ss = DPP_ROR_ADD(ss, 4); ss = DPP_ROR_ADD(ss, 2); ss = DPP_ROR_ADD(ss, 1);
            const float rr = rsqrtf(ss * (1.0f / 64.0f) + EPSN);
            const float* g = seg < 8 ? qg : (seg < 10 ? kg + 64 : kg + 128);
            const f32x4 g4 = *(const f32x4*)(g + c64);
#pragma unroll
            for (int e = 0; e < 4; ++e) v[e] = v[e] * rr * g4[e];
            const bool lowhalf = c64 < 8, rot = c64 < 16;
            const float sc = seg < 8 ? 0.125f * LOG2E : 1.0f;
#pragma unroll
            for (int e = 0; e < 4; ++e) {
                const float o = __builtin_bit_cast(float, __builtin_amdgcn_update_dpp(0, __builtin_bit_cast(int, v[e]), 0x4E, 0xf, 0xf, false));
                const f32x2 c = ropen[(size_t)s * 8 + ((c64 & 7) + e)];
                const float r = lowhalf ? (v[e] * c[0] - o * c[1]) : (v[e] * c[0] + o * c[1]);
                v[e] = (rot ? r : v[e]) * sc;
            }
            bf16_t* dst = seg < 8 ? QN + ((size_t)(b * 8 + seg) * SEQ + s) * 64
                        : seg < 10 ? KS + ((size_t)(b * 2 + (seg - 8)) * SEQ + s) * 64 : KW + ((size_t)(b * 2 + (seg - 10)) * SEQ + s) * 64;
            *(u32x2*)(dst + c64) = pack4(v);
        } else if (seg < 16) {
            bf16_t* dst = seg < 14 ? KCIN + ((size_t)(b * 2 + (seg - 12)) * SEQ + s) * 64 : VCIN + ((size_t)(b * 2 + (seg - 14)) * SEQ + s) * 64;
            *(u32x2*)(dst + c64) = pack4(v);
        } else if (col < 1696) {
            *(u32x2*)(P + (size_t)row * PLD + col) = pack4(v);
        } else if (col < 1720) {
            float* gp = GATE + (size_t)row * 24 + (col - 1696);
#pragma unroll
            for (int e = 0; e < 4; ++e) gp[e] = 1.0f / (1.0f + __expf(-v[e]));
        }
    }
};
struct EpiRssNScaleBf16 {
    bf16_t* out; int ld; float inv_n;
    __device__ __forceinline__ void operator()(int row, int col, float (&v)[4], float rss) const {
        const float s = rsqrtf(rss * inv_n + EPSN);
#pragma unroll
        for (int e = 0; e < 4; ++e) v[e] *= s;
        *(u32x2*)(out + (size_t)row * ld + col) = pack4(v);
    }
};
struct EpiNull {
    __device__ __forceinline__ void operator()(int, int, float (&v)[4], float) const { asm volatile("" :: "v"(v[0]), "v"(v[1]), "v"(v[2]), "v"(v[3])); }
};
struct EpiCmpFin {
    int kv; const f32x2* ropen; const float* gain; bf16_t* KC; bf16_t* VCT;
    __device__ __forceinline__ void operator()(int row, int col, float (&v)[4], float) const {
        if (col >= 64) return;
        const int n = row & 255, bg = row >> 8;
        if (n == 255) { v[0] = 0.f; v[1] = 0.f; v[2] = 0.f; v[3] = 0.f; }
        if (kv == 0) {
            float ss = v[0] * v[0] + v[1] * v[1] + v[2] * v[2] + v[3] * v[3];
            ss = DPP_ROR_ADD(ss, 8); ss = DPP_ROR_ADD(ss, 4); ss = DPP_ROR_ADD(ss, 2); ss = DPP_ROR_ADD(ss, 1);
            const float rr = rsqrtf(ss * (1.0f / 64.0f) + EPSN);
            const f32x4 g4 = *(const f32x4*)(gain + col);
#pragma unroll
            for (int e = 0; e < 4; ++e) v[e] = v[e] * rr * g4[e];
            int pos = 16 * n + 31; if (pos > 4095) pos = 4095;
            const bool lowhalf = col < 8, rot = col < 16;
#pragma unroll
            for (int e = 0; e < 4; ++e) {
                const float o = __builtin_bit_cast(float, __builtin_amdgcn_update_dpp(0, __builtin_bit_cast(int, v[e]), 0x4E, 0xf, 0xf, false));
                const f32x2 c = ropen[(size_t)pos * 8 + ((col & 7) + e)];
                const float r = lowhalf ? (v[e] * c[0] - o * c[1]) : (v[e] * c[0] + o * c[1]);
                v[e] = rot ? r : v[e];
            }
            if (n == 255) { v[0] = 0.f; v[1] = 0.f; v[2] = 0.f; v[3] = 0.f; }
            *(u32x2*)(KC + ((size_t)bg * 256 + n) * 64 + col) = pack4(v);
        } else {
#pragma unroll
            for (int e = 0; e < 4; ++e) VCT[((size_t)bg * 64 + col + e) * 256 + n] = (bf16_t)f2bf(v[e]);
        }
    }
};
template <bool USE_RSS>
struct EpiResBf16T {
    const bf16_t* hb_in; bf16_t* hb_out;
    __device__ __forceinline__ void operator()(int row, int col, float (&v)[4], float rss) const {
        const u32x2 a = *(const u32x2*)(hb_in + (size_t)row * DM + col);
        const float sc = USE_RSS ? rss : 1.0f;
        v[0] = v[0] * sc + bflo(a.x); v[1] = v[1] * sc + bfhi(a.x); v[2] = v[2] * sc + bflo(a.y); v[3] = v[3] * sc + bfhi(a.y);
        *(u32x2*)(hb_out + (size_t)row * DM + col) = pack4(v);
    }
};
#define H2Q_CLIP 8.0f
struct EpiResBf16Q {
    const bf16_t* hb_in; bf16_t* hb_out; unsigned* hq;
    __device__ __forceinline__ void operator()(int row, int col, float (&v)[4], float) const {
        const u32x2 a = *(const u32x2*)(hb_in + (size_t)row * DM + col);
        v[0] += bflo(a.x); v[1] += bfhi(a.x); v[2] += bflo(a.y); v[3] += bfhi(a.y);
        *(u32x2*)(hb_out + (size_t)row * DM + col) = pack4(v);
        unsigned w = 0u;
#pragma unroll
        for (int e = 0; e < 4; ++e) {
            const int qi = (int)rintf(fminf(fmaxf(v[e] * (127.0f / H2Q_CLIP), -127.0f), 127.0f));
            w |= ((unsigned)qi & 0xFFu) << (8 * e);
        }
        hq[((size_t)row * DM + col) >> 2] = w;
    }
};
struct EpiRssScaleBf16 {
    bf16_t* out; int ld; float* rstd_out;
    __device__ __forceinline__ void operator()(int row, int col, float (&v)[4], float rss) const {
        const float s = rsqrtf(rss * (1.0f / 1024.0f) + EPSN);
#pragma unroll
        for (int e = 0; e < 4; ++e) v[e] *= s;
        *(u32x2*)(out + (size_t)row * ld + col) = pack4(v);
        if (rstd_out && col == 0) rstd_out[row] = s;
    }
};

#define G8_HTB 16384
#define G8_MISC_OFF 131072
__device__ __forceinline__ int g8_lds_byte(int r, int c) { const int st = (r >> 4) * 2 + (c >> 5), rr = r & 15, cc = c & 31, ob = rr * 64 + cc * 2; return st * 1024 + (ob ^ (((ob >> 9) & 1) << 5)); }
__device__ __forceinline__ void g8_stage_rc(int b, int& R, int& C) { const int st = b / 1024, sb = b % 1024, swz = sb ^ (((sb >> 9) & 1) << 5); R = (st >> 1) * 16 + swz / 64; C = (st & 1) * 32 + (swz % 64) / 2; }
__device__ __forceinline__ int g8_perm32(int rho) { const int n = rho >> 4, i = rho & 15; return 8 * (i >> 2) + 4 * n + (i & 3); }
typedef float f32x4a __attribute__((ext_vector_type(4)));
template <class Epi, bool MIXN = false>
__device__ __forceinline__ void gemm8(const bf16_t* __restrict__ A, int lda, const bf16_t* __restrict__ Bt, int ldb, int K, int nM, int nN,
                                      const Epi& E, unsigned char* lds_gen, const float* __restrict__ ssq16 = nullptr) {
    LAS unsigned char* lds = (LAS unsigned char*)lds_gen;
    const int tid = threadIdx.x, wid = __builtin_amdgcn_readfirstlane(tid >> 6), lane = tid & 63, wr = wid >> 2, wc = wid & 3, fr = lane & 15, fq = lane >> 4;
    int nt_ = K >> 6; asm volatile("" : "+s"(nt_));
    const int nt = nt_;
    const int bid = blockIdx.x, xg = bid & 7, ustride = gridDim.x >> 3, ucnt = (nM >> 3) * nN;
    int L = bid >> 3;
    if (L >= ucnt) return;
    __syncthreads();
    unsigned voffA[2], voffB[2];
#pragma unroll
    for (int i = 0; i < 2; ++i) { int R, C; g8_stage_rc(tid * 16 + i * 8192, R, C);
        voffA[i] = (unsigned)(R * lda + C) * 2u; voffB[i] = (unsigned)((64 * (R >> 5) + g8_perm32(R & 31)) * ldb + C) * 2u; }
    const size_t kstep = 128;
    const size_t hstepA = (size_t)128 * lda * 2, tstepA = 2 * hstepA;
    const size_t hstepB = (size_t)32 * ldb * 2, tstepB = (size_t)256 * ldb * 2;
    const unsigned ldsw = (unsigned)wid * 1024u;
    const int aoff = g8_lds_byte(wr * 64 + fr, fq * 8), boff = g8_lds_byte(wc * 32 + fr, fq * 8);
    LAS float* rtab = (LAS float*)(lds + G8_MISC_OFF);
#define G8_SA(b, h) (((b) * 2 + (h)) * G8_HTB)
#define G8_SB(b, h) ((4 + (b) * 2 + (h)) * G8_HTB)
#define G8_STAGE(bufoff, gbase, voff) do { _Pragma("unroll") for (int _i = 0; _i < 2; ++_i) \
        __builtin_amdgcn_global_load_lds((const unsigned*)((const char*)(gbase) + (voff)[_i]), (LAS unsigned*)(lds + (bufoff) + ldsw + _i * 8192), 16, 0, 0); } while (0)
#define G8_LDA(dst, b, h) do { _Pragma("unroll") for (int m = 0; m < 4; ++m) _Pragma("unroll") for (int k = 0; k < 2; ++k) dst[m][k] = *(const LAS bf16x8*)(lds + G8_SA(b, h) + aoff + m * 2048 + k * 1024); } while (0)
#define G8_LDB(dst, b, h) do { _Pragma("unroll") for (int n = 0; n < 2; ++n) _Pragma("unroll") for (int k = 0; k < 2; ++k) dst[n][k] = *(const LAS bf16x8*)(lds + G8_SB(b, h) + boff + n * 2048 + k * 1024); } while (0)
#define G8_MMA(ai, bj, At, Bt_) do { __builtin_amdgcn_s_setprio(1); _Pragma("unroll") for (int m = 0; m < 4; ++m) _Pragma("unroll") for (int n = 0; n < 2; ++n) _Pragma("unroll") for (int k = 0; k < 2; ++k) \
        acc[ai][bj][m][n] = __builtin_amdgcn_mfma_f32_16x16x32_bf16(Bt_[n][k], At[m][k], acc[ai][bj][m][n], 0, 0, 0); __builtin_amdgcn_s_setprio(0); } while (0)
#define G8_WAIT_V(n) asm volatile("s_waitcnt vmcnt(" #n ")" ::: "memory")
#define G8_WAIT_L(n) asm volatile("s_waitcnt lgkmcnt(" #n ")" ::: "memory")
#define G8_BAR __builtin_amdgcn_s_barrier()
#define G8_SCHED __builtin_amdgcn_sched_barrier(0)
#define G8_RTAB_FILL(pm_, par_) do { if (MIXN && tid < 256) { \
        const float* sp_ = ssq16 + (size_t)((pm_) * 256 + tid) * 16; \
        const f32x4 a0_ = *(const f32x4*)sp_, a1_ = *(const f32x4*)(sp_ + 4), b0_ = *(const f32x4*)(sp_ + 8), b1_ = *(const f32x4*)(sp_ + 12); \
        const float s1_ = ((a0_[0] + a0_[1]) + (a0_[2] + a0_[3])) + ((a1_[0] + a1_[1]) + (a1_[2] + a1_[3])); \
        const float s2_ = ((b0_[0] + b0_[1]) + (b0_[2] + b0_[3])) + ((b1_[0] + b1_[1]) + (b1_[2] + b1_[3])); \
        const float r1_ = rsqrtf(s1_ * (1.0f / 512.0f) + EPSN), r2_ = rsqrtf(s2_ * (1.0f / 512.0f) + EPSN); \
        rtab[(par_) * 512 + tid] = r1_ / r2_; rtab[(par_) * 512 + 256 + tid] = r2_; } } while (0)
    int pm = xg + 8 * (L / nN), pn = L % nN, npm = 0, npn = 0, ui = 0;
    f32x4a acc[2][2][4][2];
#pragma unroll
    for (int a = 0; a < 2; ++a)
#pragma unroll
        for (int b = 0; b < 2; ++b)
#pragma unroll
            for (int m = 0; m < 4; ++m)
#pragma unroll
                for (int n = 0; n < 2; ++n) acc[a][b][m][n] = (f32x4a){0.f, 0.f, 0.f, 0.f};
    bf16x8 At[4][2], B0[2][2], B1[2][2];
    const char* cA = (const char*)A + (size_t)pm * tstepA; const char* cB = (const char*)Bt + (size_t)pn * tstepB;
    G8_RTAB_FILL(pm, 0);
    G8_STAGE(G8_SB(0, 0), cB, voffB); G8_STAGE(G8_SA(0, 0), cA, voffA); G8_STAGE(G8_SB(0, 1), cB + hstepB, voffB); G8_STAGE(G8_SA(0, 1), cA + hstepA, voffA);
    if (wr == 1) G8_BAR;
    G8_WAIT_V(4); G8_BAR;
    G8_STAGE(G8_SB(1, 0), cB + kstep, voffB); G8_STAGE(G8_SA(1, 0), cA + kstep, voffA); G8_STAGE(G8_SB(1, 1), cB + hstepB + kstep, voffB);
    G8_WAIT_V(6); G8_BAR;
    for (;;) {
        const int Ln = L + ustride;
        const bool has_next = Ln < ucnt;
        if (has_next) { npm = xg + 8 * (Ln / nN); npn = Ln % nN; }
        const char* nA = has_next ? (const char*)A + (size_t)npm * tstepA : cA; const char* nB = has_next ? (const char*)Bt + (size_t)npn * tstepB : cB;
        for (int t = 0; t < nt; t += 2) {
            const bool last = (t == nt - 2);
            const char* a1 = cA + (size_t)(t + 1) * kstep;
            const char* a2 = last ? nA : cA + (size_t)(t + 2) * kstep; const char* b2 = last ? nB : cB + (size_t)(t + 2) * kstep;
            const char* a3 = a2 + kstep; const char* b3 = b2 + kstep;
            if (MIXN && t == (nt >> 1)) {
#pragma unroll
                for (int ai = 0; ai < 2; ++ai)
#pragma unroll
                    for (int m = 0; m < 4; ++m) { const float f = rtab[(ui & 1) * 512 + ai * 128 + wr * 64 + m * 16 + (tid & 15)];
#pragma unroll
                        for (int bj = 0; bj < 2; ++bj)
#pragma unroll
                            for (int n = 0; n < 2; ++n) acc[ai][bj][m][n] *= f; }
            }
            if (MIXN && last && has_next) G8_RTAB_FILL(npm, (ui + 1) & 1);
            G8_LDB(B0, 0, 0); G8_SCHED; G8_LDA(At, 0, 0); G8_STAGE(G8_SA(1, 1), a1 + hstepA, voffA);
            G8_WAIT_L(8); G8_BAR; G8_WAIT_L(0); G8_MMA(0, 0, At, B0); G8_BAR; G8_SCHED;
            G8_LDB(B1, 0, 1); G8_STAGE(G8_SB(0, 0), b2, voffB);
            G8_BAR; G8_WAIT_L(0); G8_MMA(0, 1, At, B1); G8_BAR;
            G8_LDA(At, 0, 1); G8_STAGE(G8_SA(0, 0), a2, voffA);
            G8_BAR; G8_WAIT_L(0); G8_MMA(1, 0, At, B0); G8_BAR; G8_SCHED;
            G8_STAGE(G8_SB(0, 1), b2 + hstepB, voffB);
            G8_WAIT_V(6); G8_BAR; G8_MMA(1, 1, At, B1); G8_BAR;
            G8_LDB(B0, 1, 0); G8_SCHED; G8_LDA(At, 1, 0); G8_STAGE(G8_SA(0, 1), a2 + hstepA, voffA);
            G8_WAIT_L(8); G8_BAR; G8_WAIT_L(0); G8_MMA(0, 0, At, B0); G8_BAR; G8_SCHED;
            G8_LDB(B1, 1, 1); G8_STAGE(G8_SB(1, 0), b3, voffB);
            G8_BAR; G8_WAIT_L(0); G8_MMA(0, 1, At, B1); G8_BAR;
            G8_LDA(At, 1, 1); G8_STAGE(G8_SA(1, 0), a3, voffA);
            G8_BAR; G8_WAIT_L(0); G8_MMA(1, 0, At, B0); G8_BAR; G8_SCHED;
            G8_STAGE(G8_SB(1, 1), b3 + hstepB, voffB);
            G8_WAIT_V(6); G8_BAR; G8_MMA(1, 1, At, B1); G8_BAR;
        }
        {
            const int col0 = pn * 256 + wc * 64;
            int tid_e = tid; asm volatile("" : "+v"(tid_e));
            const int fr_e = tid_e & 15, fq_e = (tid_e >> 4) & 3;
            typename Epi::Pre pre[2][4];
#pragma unroll
            for (int ai = 0; ai < 2; ++ai)
#pragma unroll
                for (int m = 0; m < 4; ++m) pre[ai][m] = E.pre(pm * 256 + ai * 128 + wr * 64 + m * 16 + fr_e, col0, fq_e);
#pragma unroll
            for (int ai = 0; ai < 2; ++ai)
#pragma unroll
                for (int m = 0; m < 4; ++m) {
                    const int rl = ai * 128 + wr * 64 + m * 16 + fr_e;
                    float v[2][8];
#pragma unroll
                    for (int bj = 0; bj < 2; ++bj)
#pragma unroll
                        for (int n = 0; n < 2; ++n)
#pragma unroll
                            for (int e = 0; e < 4; ++e) v[bj][4 * n + e] = acc[ai][bj][m][n][e];
                    E(pm * 256 + rl, col0, fq_e, v, MIXN ? rtab[(ui & 1) * 512 + 256 + rl] : 0.f, pre[ai][m]);
                }
        }
        if (!has_next) break;
#pragma unroll
        for (int a = 0; a < 2; ++a)
#pragma unroll
            for (int b = 0; b < 2; ++b)
#pragma unroll
                for (int m = 0; m < 4; ++m)
#pragma unroll
                    for (int n = 0; n < 2; ++n) acc[a][b][m][n] = (f32x4a){0.f, 0.f, 0.f, 0.f};
        pm = npm; pn = npn; cA = nA; cB = nB; L = Ln; ++ui;
    }
    G8_WAIT_V(0);
    if (wr == 0) G8_BAR;
    G8_BAR;
#undef G8_SA
#undef G8_SB
#undef G8_STAGE
#undef G8_LDA
#undef G8_LDB
#undef G8_MMA
#undef G8_WAIT_V
#undef G8_WAIT_L
#undef G8_BAR
#undef G8_SCHED
#undef G8_RTAB_FILL
}

#ifndef FULL_LINE
#define FULL_LINE 0
#endif
__device__ __forceinline__ void rows16_xchg(u32x4& a0, u32x4& a1, bool hi) {
    if (!FULL_LINE) return;
    u32x4 send, recv;
#pragma unroll
    for (int q = 0; q < 4; ++q) send[q] = hi ? a0[q] : a1[q];
#pragma unroll
    for (int q = 0; q < 4; ++q) recv[q] = (unsigned)__builtin_amdgcn_update_dpp(0, (int)send[q], 0x128, 0xf, 0xf, false);
#pragma unroll
    for (int q = 0; q < 4; ++q) { a0[q] = hi ? recv[q] : a0[q]; a1[q] = hi ? a1[q] : recv[q]; }
}
__device__ __forceinline__ void rows16_xchg2(u32x2& a0, u32x2& a1, bool hi) {
    if (!FULL_LINE) return;
    u32x2 send, recv;
#pragma unroll
    for (int q = 0; q < 2; ++q) send[q] = hi ? a0[q] : a1[q];
#pragma unroll
    for (int q = 0; q < 2; ++q) recv[q] = (unsigned)__builtin_amdgcn_update_dpp(0, (int)send[q], 0x128, 0xf, 0xf, false);
#pragma unroll
    for (int q = 0; q < 2; ++q) { a0[q] = hi ? recv[q] : a0[q]; a1[q] = hi ? a1[q] : recv[q]; }
}
__device__ __forceinline__ bf16_t* rows16_ptr(bf16_t* own, size_t ld, int fr, int fq) { return FULL_LINE ? own - (size_t)(fr & 8) * ld + 32 * (fr >> 3) + 8 * fq : own + 8 * fq; }
__device__ __forceinline__ const bf16_t* rows16_ptr(const bf16_t* own, size_t ld, int fr, int fq) { return FULL_LINE ? own - (size_t)(fr & 8) * ld + 32 * (fr >> 3) + 8 * fq : own + 8 * fq; }
__device__ __forceinline__ size_t rows16_step(size_t ld) { return FULL_LINE ? 8 * ld : 32; }
__device__ __forceinline__ void st_rows16(bf16_t* own, size_t ld, int fr, int fq, u32x4 a0, u32x4 a1) {
    rows16_xchg(a0, a1, fr >= 8);
    bf16_t* p = rows16_ptr(own, ld, fr, fq);
    *(u32x4*)p = a0; *(u32x4*)(p + rows16_step(ld)) = a1;
}
__device__ __forceinline__ float fq_sum(float x) {
    u32x2 s = __builtin_amdgcn_permlane16_swap(__float_as_uint(x), __float_as_uint(x), false, false);
    x = __uint_as_float(s.x) + __uint_as_float(s.y);
    s = __builtin_amdgcn_permlane32_swap(__float_as_uint(x), __float_as_uint(x), false, false);
    return __uint_as_float(s.x) + __uint_as_float(s.y);
}
__device__ __forceinline__ float fq_xor1(float x, int fq) {
    const u32x2 s = __builtin_amdgcn_permlane16_swap(__float_as_uint(x), __float_as_uint(x), false, false);
    return __uint_as_float((fq & 1) ? s.x : s.y);
}
__device__ __forceinline__ void fq_bcast23(float x, float& r2, float& r3) {
    const u32x2 s = __builtin_amdgcn_permlane32_swap(__float_as_uint(x), __float_as_uint(x), false, false);
    const u32x2 t = __builtin_amdgcn_permlane16_swap(s.y, s.y, false, false);
    r2 = __uint_as_float(t.x); r3 = __uint_as_float(t.y);
}
struct Epi8ResBf16Q {
    const bf16_t* hb_in; bf16_t* hb_out; unsigned* hq; float* ssq;
    struct Pre { u32x4 r[2]; };
    __device__ __forceinline__ Pre pre(int row, int col0, int fq) const {
        Pre p; const bf16_t* s = rows16_ptr(hb_in + (size_t)row * DM + col0, DM, row & 15, fq); p.r[0] = *(const u32x4*)s; p.r[1] = *(const u32x4*)(s + rows16_step(DM)); return p; }
    __device__ __forceinline__ void operator()(int row, int col0, int fq, float (&v)[2][8], float, const Pre& p) const {
        float ss = 0.f;
        const int fr = row & 15;
        u32x4 hin[2] = {p.r[0], p.r[1]};
        rows16_xchg(hin[0], hin[1], fr >= 8);
        u32x4 ob[2]; u32x2 oq[2];
#pragma unroll
        for (int bj = 0; bj < 2; ++bj) {
            float x[8]; unpack8(hin[bj], x);
#pragma unroll
            for (int e = 0; e < 8; ++e) { v[bj][e] += x[e]; ss += v[bj][e] * v[bj][e]; }
            ob[bj] = pack8(v[bj]);
            unsigned w[2] = {0u, 0u};
#pragma unroll
            for (int e = 0; e < 8; ++e) {
                const int qi = (int)rintf(fminf(fmaxf(v[bj][e] * (127.0f / H2Q_CLIP), -127.0f), 127.0f));
                w[e >> 2] |= ((unsigned)qi & 0xFFu) << (8 * (e & 3));
            }
            oq[bj] = (u32x2){w[0], w[1]};
        }
        st_rows16(hb_out + (size_t)row * DM + col0, DM, fr, fq, ob[0], ob[1]);
        rows16_xchg2(oq[0], oq[1], fr >= 8);
        {
            unsigned char* qp = FULL_LINE ? (unsigned char*)hq + (size_t)(row - (fr & 8)) * DM + col0 + 32 * (fr >> 3) + 8 * fq : (unsigned char*)hq + (size_t)row * DM + col0 + 8 * fq;
            *(u32x2*)qp = oq[0]; *(u32x2*)(qp + rows16_step(DM)) = oq[1];
        }
        ss = fq_sum(ss);
        if (fq == 0) ssq[(size_t)row * 16 + (col0 >> 6)] = ss;
    }
};
struct Epi8RssScaleBf16 {
    bf16_t* out; int ld; const float* ssq; float* rstd_out;
    struct Pre { f32x4 s; };
    __device__ __forceinline__ Pre pre(int row, int, int fq) const { Pre p; p.s = *(const f32x4*)(ssq + (size_t)row * 16 + 4 * fq); return p; }
    __device__ __forceinline__ void operator()(int row, int col0, int fq, float (&v)[2][8], float, const Pre& p) const {
        float t = (p.s[0] + p.s[1]) + (p.s[2] + p.s[3]);
        t = fq_sum(t);
        const float s = rsqrtf(t * (1.0f / 1024.0f) + EPSN);
#pragma unroll
        for (int bj = 0; bj < 2; ++bj)
#pragma unroll
            for (int e = 0; e < 8; ++e) v[bj][e] *= s;
        st_rows16(out + (size_t)row * ld + col0, ld, row & 15, fq, pack8(v[0]), pack8(v[1]));
        if (rstd_out && col0 == 0 && fq == 0) rstd_out[row] = s;
    }
};
struct Epi8ResBf16S {
    const bf16_t* hb_in; bf16_t* hb_out; float* ssq;
    struct Pre { u32x4 r[2]; };
    __device__ __forceinline__ Pre pre(int row, int col0, int fq) const {
        Pre p; const bf16_t* s = rows16_ptr(hb_in + (size_t)row * DM + col0, DM, row & 15, fq); p.r[0] = *(const u32x4*)s; p.r[1] = *(const u32x4*)(s + rows16_step(DM)); return p; }
    __device__ __forceinline__ void operator()(int row, int col0, int fq, float (&v)[2][8], float aux, const Pre& p) const {
        float ss = 0.f;
        const int fr = row & 15;
        u32x4 hin[2] = {p.r[0], p.r[1]};
        rows16_xchg(hin[0], hin[1], fr >= 8);
#pragma unroll
        for (int bj = 0; bj < 2; ++bj) {
            float x[8]; unpack8(hin[bj], x);
#pragma unroll
            for (int e = 0; e < 8; ++e) { v[bj][e] = v[bj][e] * aux + x[e]; ss += v[bj][e] * v[bj][e]; }
        }
        st_rows16(hb_out + (size_t)row * DM + col0, DM, fr, fq, pack8(v[0]), pack8(v[1]));
        ss = fq_sum(ss);
        if (fq == 0) ssq[(size_t)row * 16 + (col0 >> 6)] = ss;
    }
};
struct Epi8RowScaleBf16 {
    bf16_t* out; int ld; const float* scale;
    struct Pre { float s; };
    __device__ __forceinline__ Pre pre(int row, int, int) const { Pre p; p.s = scale[row]; return p; }
    __device__ __forceinline__ void operator()(int row, int col0, int fq, float (&v)[2][8], float, const Pre& p) const {
#pragma unroll
        for (int bj = 0; bj < 2; ++bj)
#pragma unroll
            for (int e = 0; e < 8; ++e) v[bj][e] *= p.s;
        st_rows16(out + (size_t)row * ld + col0, ld, row & 15, fq, pack8(v[0]), pack8(v[1]));
    }
};
struct Epi8InProj {
    const float* rstd0; bf16_t* P; bf16_t* QN; bf16_t* KS; bf16_t* KW; bf16_t* KCIN; bf16_t* VCIN; float* GATE;
    const f32x2* ropen; const float* qg; const float* kg; float* CSSQ;
    struct Pre { float rs; };
    __device__ __forceinline__ Pre pre(int row, int, int) const { Pre p; p.rs = rstd0[row]; return p; }
    __device__ __forceinline__ void operator()(int row, int col0, int fq, float (&v)[2][8], float, const Pre& p) const {
        const int seg = col0 >> 6;
        const int b = row >> 12, s = row & 4095;
#pragma unroll
        for (int bj = 0; bj < 2; ++bj)
#pragma unroll
            for (int e = 0; e < 8; ++e) v[bj][e] *= p.rs;
        if (seg < 12) {
            float ss = 0.f;
#pragma unroll
            for (int bj = 0; bj < 2; ++bj)
#pragma unroll
                for (int e = 0; e < 8; ++e) ss += v[bj][e] * v[bj][e];
            ss = fq_sum(ss);
            const float rr = rsqrtf(ss * (1.0f / 64.0f) + EPSN);
            const float* g = seg < 8 ? qg : (seg < 10 ? kg + 64 : kg + 128);
#pragma unroll
            for (int bj = 0; bj < 2; ++bj) {
                const f32x4 g0 = *(const f32x4*)(g + 32 * bj + 8 * fq), g1 = *(const f32x4*)(g + 32 * bj + 8 * fq + 4);
#pragma unroll
                for (int e = 0; e < 4; ++e) { v[bj][e] *= rr * g0[e]; v[bj][4 + e] *= rr * g1[e]; }
            }
            const f32x4* rp = (const f32x4*)(ropen + (size_t)s * 8);
            const f32x4 c01 = rp[0], c23 = rp[1], c45 = rp[2], c67 = rp[3];
            const float cs[8] = {c01[0], c01[2], c23[0], c23[2], c45[0], c45[2], c67[0], c67[2]};
            const float sn[8] = {c01[1], c01[3], c23[1], c23[3], c45[1], c45[3], c67[1], c67[3]};
            const float sc = seg < 8 ? 0.125f * LOG2E : 1.0f;
#pragma unroll
            for (int j = 0; j < 8; ++j) {
                const float o = fq_xor1(v[0][j], fq);
                const float r = fq == 0 ? (v[0][j] * cs[j] - o * sn[j]) : (v[0][j] * cs[j] + o * sn[j]);
                v[0][j] = fq < 2 ? r : v[0][j];
            }
#pragma unroll
            for (int bj = 0; bj < 2; ++bj)
#pragma unroll
                for (int e = 0; e < 8; ++e) v[bj][e] *= sc;
            bf16_t* dst = seg < 8 ? QN + ((size_t)(b * 8 + seg) * SEQ + s) * 64
                        : seg < 10 ? KS + ((size_t)(b * 2 + (seg - 8)) * SEQ + s) * 64 : KW + ((size_t)(b * 2 + (seg - 10)) * SEQ + s) * 64;
            st_rows16(dst, 64, row & 15, fq, pack8(v[0]), pack8(v[1]));
        } else if (seg < 16) {
            bf16_t* dst = seg < 14 ? KCIN + ((size_t)(b * 2 + (seg - 12)) * SEQ + s) * 64 : VCIN + ((size_t)(b * 2 + (seg - 14)) * SEQ + s) * 64;
            st_rows16(dst, 64, row & 15, fq, pack8(v[0]), pack8(v[1]));
        } else if (seg < 26) {
            bf16_t* dst = P + (size_t)row * PLD + col0;
            st_rows16(dst, PLD, row & 15, fq, pack8(v[0]), pack8(v[1]));
            if (seg >= 20) {
                float ss = 0.f;
#pragma unroll
                for (int bj = 0; bj < 2; ++bj)
#pragma unroll
                    for (int e = 0; e < 8; ++e) ss += v[bj][e] * v[bj][e];
                ss = fq_sum(ss);
                if (fq == 0) CSSQ[(size_t)row * 8 + (seg - 20)] = ss;
            }
        } else if (seg == 26) {
            *(u32x4*)(P + (size_t)row * PLD + col0 + 8 * fq) = pack8(v[0]);
            {
                float ss = 0.f;
#pragma unroll
                for (int e = 0; e < 8; ++e) ss += v[0][e] * v[0][e];
                ss = fq_sum(ss);
                if (fq == 0) CSSQ[(size_t)row * 8 + 6] = ss;
            }
            if (fq < 3) {
                float* gp = GATE + (size_t)row * 24 + 8 * fq;
                f32x4 a, c;
#pragma unroll
                for (int e = 0; e < 4; ++e) { a[e] = 1.0f / (1.0f + __expf(-v[1][e])); c[e] = 1.0f / (1.0f + __expf(-v[1][4 + e])); }
                *(f32x4*)gp = a; *(f32x4*)(gp + 4) = c;
            }
        }
    }
};
struct Epi8QUp {
    bf16_t* out; int ld; const float* cssq;
    struct Pre { float s; };
    __device__ __forceinline__ Pre pre(int row, int, int fq) const { Pre p; p.s = cssq[(size_t)row * 8 + fq]; return p; }
    __device__ __forceinline__ void operator()(int row, int col0, int fq, float (&v)[2][8], float, const Pre& p) const {
        const float t = fq_sum(p.s);
        const float s = rsqrtf(t * (1.0f / 256.0f) + EPSN);
#pragma unroll
        for (int bj = 0; bj < 2; ++bj)
#pragma unroll
            for (int e = 0; e < 8; ++e) v[bj][e] *= s;
        st_rows16(out + (size_t)row * ld + col0, ld, row & 15, fq, pack8(v[0]), pack8(v[1]));
    }
};
struct Epi8KvUp {
    const float* cssq; const bf16_t* P; const f32x2* ropem; const float* kg; bf16_t* KM; bf16_t* KVR;
    struct Pre { f32x2 s; };
    __device__ __forceinline__ Pre pre(int row, int, int fq) const { Pre p; p.s = *(const f32x2*)(cssq + (size_t)row * 8 + 2 * fq); return p; }
    __device__ __forceinline__ void operator()(int row, int col0, int fq, float (&v)[2][8], float, const Pre& p) const {
        float ckv, kpe, dummy;
        fq_bcast23(p.s[0] + p.s[1], ckv, dummy);
        fq_bcast23(p.s[0], dummy, kpe);
        const float rc = rsqrtf(ckv * (1.0f / 128.0f) + EPSN);
#pragma unroll
        for (int bj = 0; bj < 2; ++bj)
#pragma unroll
            for (int e = 0; e < 8; ++e) v[bj][e] *= rc;
        const int seg = col0 >> 6, head = seg >> 1;
        if (seg & 1) {
            bf16_t* dst = KVR + (size_t)row * 1024 + head * 128 + 64;
            st_rows16(dst, 1024, row & 15, fq, pack8(v[0]), pack8(v[1]));
        } else {
            const int b = row >> 12, s = row & 4095;
            float ss = 0.f;
#pragma unroll
            for (int bj = 0; bj < 2; ++bj)
#pragma unroll
                for (int e = 0; e < 8; ++e) ss += v[bj][e] * v[bj][e];
            ss = fq_sum(ss);
            const float r = rsqrtf((ss + kpe) * (1.0f / 96.0f) + EPSN);
            bf16_t* kp = KM + ((size_t)(b * 8 + head) * SEQ + s) * 96;
#pragma unroll
            for (int bj = 0; bj < 2; ++bj) {
                const f32x4 g0 = *(const f32x4*)(kg + 32 * bj + 8 * fq), g1 = *(const f32x4*)(kg + 32 * bj + 8 * fq + 4);
#pragma unroll
                for (int e = 0; e < 4; ++e) { v[bj][e] *= r * g0[e]; v[bj][4 + e] *= r * g1[e]; }
            }
            st_rows16(kp, 96, row & 15, fq, pack8(v[0]), pack8(v[1]));
            const u32x2 x1w = *(const u32x2*)(P + (size_t)row * PLD + C_KPE + 4 * fq), x2w = *(const u32x2*)(P + (size_t)row * PLD + C_KPE + 16 + 4 * fq);
            const f32x4 cs0 = *(const f32x4*)(ropem + (size_t)s * 16 + 4 * fq), cs1 = *(const f32x4*)(ropem + (size_t)s * 16 + 4 * fq + 2);
            const f32x4 ga = *(const f32x4*)(kg + 64 + 4 * fq), gb = *(const f32x4*)(kg + 80 + 4 * fq);
            const float x1[4] = {bflo(x1w.x), bfhi(x1w.x), bflo(x1w.y), bfhi(x1w.y)}, x2[4] = {bflo(x2w.x), bfhi(x2w.x), bflo(x2w.y), bfhi(x2w.y)};
            const float cc[4] = {cs0[0], cs0[2], cs1[0], cs1[2]}, sn[4] = {cs0[1], cs0[3], cs1[1], cs1[3]};
            float y1[4], y2[4];
#pragma unroll
            for (int e = 0; e < 4; ++e) { const float a1 = x1[e] * r * ga[e], a2 = x2[e] * r * gb[e]; y1[e] = a1 * cc[e] - a2 * sn[e]; y2[e] = a2 * cc[e] + a1 * sn[e]; }
            *(u32x2*)(kp + 64 + 4 * fq) = pack4(y1); *(u32x2*)(kp + 80 + 4 * fq) = pack4(y2);
        }
    }
};

__device__ __forceinline__ int inproj_src_col(int n) {
    if (n < 512) return 416 + n;
    if (n < 640) return 1184 + (n - 512);
    if (n < 768) return 1440 + (n - 640);
    if (n < 896) return 928 + (n - 768);
    if (n < 1024) return 1056 + (n - 896);
    if (n < 1152) return 1312 + (n - 1024);
    if (n < 1280) return 1568 + (n - 1152);
    if (n < 1536) return n - 1280;
    if (n < 1664) return 256 + (n - 1536);
    if (n < 1696) return 384 + (n - 1664);
    if (n < 1720) return n;
    return -1;
}
template <bool PERM = false>
__device__ __forceinline__ void wt_tile(const float* __restrict__ W, int N, const float* __restrict__ gain, bf16_t* __restrict__ Wt, int ldt,
                                        int kt, int nt, float* tile, bool valid) {
    const int tid = threadIdx.x & 255;
    tile += (threadIdx.x >> 8) * (64 * 65);
    __syncthreads();
    if (valid) {
        const int i = tid >> 4, j4 = (tid & 15) * 4;
#pragma unroll
        for (int rr = 0; rr < 4; ++rr) {
            const int k = kt * 64 + i + 16 * rr, nd = nt * 64 + j4;
            const int n = PERM ? inproj_src_col(nd) : (nd < N ? nd : -1);
            f32x4 v = (f32x4){0.f, 0.f, 0.f, 0.f};
            if (n >= 0) v = *(const f32x4*)(W + (size_t)k * N + n);
            const float g = gain ? gain[k] : 1.0f;
            float* tp = tile + (i + 16 * rr) * 65 + j4;
            tp[0] = v[0] * g; tp[1] = v[1] * g; tp[2] = v[2] * g; tp[3] = v[3] * g;
        }
    }
    __syncthreads();
    if (valid) {
        const int j = tid >> 2, ic = (tid & 3) * 16;
        float a[8], b[8];
#pragma unroll
        for (int e = 0; e < 8; ++e) { a[e] = tile[(ic + e) * 65 + j]; b[e] = tile[(ic + 8 + e) * 65 + j]; }
        bf16_t* dp = Wt + (size_t)(nt * 64 + j) * ldt + kt * 64 + ic;
        *(u32x4*)dp = pack8(a); *(u32x4*)(dp + 8) = pack8(b);
    }
    __syncthreads();
}

__device__ __forceinline__ void tr_tile(const bf16_t* __restrict__ src, size_t src_ld, bf16_t* __restrict__ dst, size_t dst_ld, bf16_t* tile, bool valid) {
    const int tid = threadIdx.x & 255;
    tile += (threadIdx.x >> 8) * (64 * 66);
    __syncthreads();
    if (valid) {
        const int r = tid >> 2, c = (tid & 3) * 16;
        const u32x4 a = *(const u32x4*)(src + (size_t)r * src_ld + c), b = *(const u32x4*)(src + (size_t)r * src_ld + c + 8);
        unsigned* tp = (unsigned*)(tile + r * 66 + c);
        tp[0] = a.x; tp[1] = a.y; tp[2] = a.z; tp[3] = a.w; tp[4] = b.x; tp[5] = b.y; tp[6] = b.z; tp[7] = b.w;
    }
    __syncthreads();
    if (valid) {
        const int c = tid >> 2, r0 = (tid & 3) * 16;
        unsigned o[8];
#pragma unroll
        for (int e = 0; e < 8; ++e) o[e] = (unsigned)tile[(r0 + 2 * e) * 66 + c] | ((unsigned)tile[(r0 + 2 * e + 1) * 66 + c] << 16);
        bf16_t* dp = dst + (size_t)c * dst_ld + r0;
        *(u32x4*)dp = (u32x4){o[0], o[1], o[2], o[3]}; *(u32x4*)(dp + 8) = (u32x4){o[4], o[5], o[6], o[7]};
    }
    __syncthreads();
}

static __device__ const double INV_MLA[16] = {1.0, 0.44036660267178046, 0.19392274474868576, 0.08539710028576561, 0.03760603093086393, 0.016560440080994446,
    0.007292664737217109, 0.003211445994752591, 0.001414213562373095, 0.000622772421914596, 0.0002742481756762073, 0.00012076973741146504,
    5.318295896944988e-05, 2.341999896140934e-05, 1.031338537721246e-05, 4.5416704806078695e-06};
__device__ __forceinline__ f32x2 rope_cs(int pos, double inv) {
    double rev = (double)pos * inv * 0.15915494309189535;
    rev -= __builtin_floor(rev);
    const float rf = (float)rev;
    return (f32x2){__builtin_amdgcn_cosf(rf), __builtin_amdgcn_sinf(rf)};
}

__device__ __forceinline__ void rows_to_bf16(const float* __restrict__ x, bf16_t* __restrict__ xb, float* __restrict__ rstd, const float* __restrict__ gain,
                                             int nrows, int gw, int nw, int lane) {
    for (int r = gw; r < nrows; r += nw) {
        const float* xp = x + (size_t)r * 1024 + lane * 8;
        const f32x4 a = *(const f32x4*)xp, b = *(const f32x4*)(xp + 4), c = *(const f32x4*)(xp + 512), d = *(const f32x4*)(xp + 516);
        float v0[8] = {a[0], a[1], a[2], a[3], b[0], b[1], b[2], b[3]}, v1[8] = {c[0], c[1], c[2], c[3], d[0], d[1], d[2], d[3]};
        if (rstd) {
            float s = 0.f;
#pragma unroll
            for (int e = 0; e < 8; ++e) s += v0[e] * v0[e] + v1[e] * v1[e];
            s = wave_sum(s);
            if (lane == 0) rstd[r] = rsqrtf(s * (1.0f / 1024.0f) + EPSN);
        }
        if (gain) {
            const f32x4 ga = *(const f32x4*)(gain + lane * 8), gb = *(const f32x4*)(gain + lane * 8 + 4), gc = *(const f32x4*)(gain + 512 + lane * 8), gd = *(const f32x4*)(gain + 516 + lane * 8);
#pragma unroll
            for (int e = 0; e < 4; ++e) { v0[e] *= ga[e]; v0[4 + e] *= gb[e]; v1[e] *= gc[e]; v1[4 + e] *= gd[e]; }
        }
        bf16_t* op = xb + (size_t)r * 1024 + lane * 8;
        *(u32x4*)op = pack8(v0); *(u32x4*)(op + 512) = pack8(v1);
    }
}

#define U_SCALE 64.0f
#define V_SCALE 8.0f
__device__ __forceinline__ void rows_to_slices(const float* __restrict__ x, unsigned char* __restrict__ dst, const float* __restrict__ gain, float scale, int gw, int nw, int lane) {
    for (int r = gw; r < 16384; r += nw) {
        const float* xp = x + (size_t)r * 1024 + lane * 8;
        const f32x4 a = *(const f32x4*)xp, b = *(const f32x4*)(xp + 4), c = *(const f32x4*)(xp + 512), d = *(const f32x4*)(xp + 516);
        float v0[8] = {a[0], a[1], a[2], a[3], b[0], b[1], b[2], b[3]}, v1[8] = {c[0], c[1], c[2], c[3], d[0], d[1], d[2], d[3]};
        if (gain) {
            const f32x4 ga = *(const f32x4*)(gain + lane * 8), gb = *(const f32x4*)(gain + lane * 8 + 4), gc = *(const f32x4*)(gain + 512 + lane * 8), gd = *(const f32x4*)(gain + 516 + lane * 8);
#pragma unroll
            for (int e = 0; e < 4; ++e) { v0[e] *= ga[e]; v0[4 + e] *= gb[e]; v1[e] *= gc[e]; v1[4 + e] *= gd[e]; }
        }
#pragma unroll
        for (int e = 0; e < 8; ++e) { v0[e] *= scale; v1[e] *= scale; }
        u32x2 p0, p1;
        { int t = __builtin_amdgcn_cvt_pk_fp8_f32(v0[0], v0[1], 0, false); t = __builtin_amdgcn_cvt_pk_fp8_f32(v0[2], v0[3], t, true); p0.x = (unsigned)t;
          t = __builtin_amdgcn_cvt_pk_fp8_f32(v0[4], v0[5], 0, false); t = __builtin_amdgcn_cvt_pk_fp8_f32(v0[6], v0[7], t, true); p0.y = (unsigned)t;
          t = __builtin_amdgcn_cvt_pk_fp8_f32(v1[0], v1[1], 0, false); t = __builtin_amdgcn_cvt_pk_fp8_f32(v1[2], v1[3], t, true); p1.x = (unsigned)t;
          t = __builtin_amdgcn_cvt_pk_fp8_f32(v1[4], v1[5], 0, false); t = __builtin_amdgcn_cvt_pk_fp8_f32(v1[6], v1[7], t, true); p1.y = (unsigned)t; }
        const int sl = lane >> 4, off = (lane & 15) * 8;
        *(u32x2*)(dst + ((size_t)sl * 16384 + r) * 128 + off) = p0;
        *(u32x2*)(dst + ((size_t)(4 + sl) * 16384 + r) * 128 + off) = p1;
    }
}

__device__ __forceinline__ void rows_to_slices_i8(const float* __restrict__ x, unsigned char* __restrict__ dst, const float* __restrict__ gain, float* __restrict__ row_scale,
                                                  int gw, int nw, int lane) {
    for (int r = gw; r < 16384; r += nw) {
        const float* xp = x + (size_t)r * 1024 + lane * 8;
        const f32x4 a = *(const f32x4*)xp, b = *(const f32x4*)(xp + 4), c = *(const f32x4*)(xp + 512), d = *(const f32x4*)(xp + 516);
        float v0[8] = {a[0], a[1], a[2], a[3], b[0], b[1], b[2], b[3]}, v1[8] = {c[0], c[1], c[2], c[3], d[0], d[1], d[2], d[3]};
        const f32x4 ga = *(const f32x4*)(gain + lane * 8), gb = *(const f32x4*)(gain + lane * 8 + 4), gc = *(const f32x4*)(gain + 512 + lane * 8), gd = *(const f32x4*)(gain + 516 + lane * 8);
        float mx = 0.f;
#pragma unroll
        for (int e = 0; e < 4; ++e) { v0[e] *= ga[e]; v0[4 + e] *= gb[e]; v1[e] *= gc[e]; v1[4 + e] *= gd[e]; }
#pragma unroll
        for (int e = 0; e < 8; ++e) mx = fmaxf(mx, fmaxf(fabsf(v0[e]), fabsf(v1[e])));
        mx = fmaxf(mx, __shfl_xor(mx, 32)); mx = fmaxf(mx, __shfl_xor(mx, 16)); mx = fmaxf(mx, __shfl_xor(mx, 8));
        mx = fmaxf(mx, __shfl_xor(mx, 4)); mx = fmaxf(mx, __shfl_xor(mx, 2)); mx = fmaxf(mx, __shfl_xor(mx, 1));
        const float inv = mx > 0.f ? 127.0f / mx : 0.f;
        unsigned w[4] = {0u, 0u, 0u, 0u};
#pragma unroll
        for (int e = 0; e < 8; ++e) {
            const int q0 = (int)rintf(v0[e] * inv), q1 = (int)rintf(v1[e] * inv);
            w[e >> 2] |= ((unsigned)q0 & 0xFFu) << (8 * (e & 3));
            w[2 + (e >> 2)] |= ((unsigned)q1 & 0xFFu) << (8 * (e & 3));
        }
        const int sl = lane >> 4, off = (lane & 15) * 8;
        *(u32x2*)(dst + ((size_t)sl * 16384 + r) * 128 + off) = (u32x2){w[0], w[1]};
        *(u32x2*)(dst + ((size_t)(4 + sl) * 16384 + r) * 128 + off) = (u32x2){w[2], w[3]};
        if (lane == 0) row_scale[r] = mx * (1.0f / 127.0f);
    }
}

struct WtJob { const float* W; int K, N, Npad; const float* gain; bf16_t* Wt; int ldt; };

__device__ __forceinline__ void phase_prep(const Args& a, unsigned char* lds) {
    unsigned char* ws = a.ws;
    const int tid = threadIdx.x, lane = tid & 63, w = tid >> 6;
    const int gw = blockIdx.x * NWV + w, nw = gridDim.x * NWV;
    rows_to_bf16(a.in[0], (bf16_t*)(ws + WS_XB), (float*)(ws + WS_RSTD0), nullptr, T_TOK, gw, nw, lane);
    rows_to_bf16(a.in[1], (bf16_t*)(ws + WS_MEMB), (float*)(ws + WS_RSTDMEM), nullptr, 4096, gw, nw, lane);
    rows_to_slices_i8(a.in[25], ws + WS_UB, a.in[22], (float*)(ws + WS_USCALE), gw, nw, lane);
    rows_to_slices(a.in[26], ws + WS_VB, nullptr, V_SCALE, gw, nw, lane);
    for (int i = blockIdx.x * NT + tid; i < 131072 / 8; i += gridDim.x * NT) {
        const float* kp = a.in[24] + (size_t)i * 8;
        const f32x4 p = *(const f32x4*)kp, q = *(const f32x4*)(kp + 4);
        float v[8] = {p[0], p[1], p[2], p[3], q[0], q[1], q[2], q[3]};
        *(u32x4*)((bf16_t*)(ws + WS_KP) + (size_t)i * 8) = pack8(v);
    }
    for (int i = blockIdx.x * NT + tid; i < 4096 * 16; i += gridDim.x * NT) {
        const int pos = i >> 4, f = i & 15;
        ((f32x2*)(ws + WS_ROPEM))[i] = rope_cs(pos, INV_MLA[f]);
        if (f < 8) ((f32x2*)(ws + WS_ROPEN))[pos * 8 + f] = rope_cs(pos, INV_MLA[2 * f]);
    }
    for (int it = blockIdx.x; it < 32; it += gridDim.x) {
        const int kv = it >> 4, s16 = it & 15;
        if (tid >= 256) continue;
        const int j = tid & 127, kh = tid >> 7;
        const int sl = s16 * 2 + kh;
        const float* pe = a.in[11] + (size_t)kv * 2048 + sl * 64;
        const float* w1 = a.in[12] + ((size_t)kv * 2048 + sl * 64) * 128 + j;
        float s = 0.f;
        for (int k = 0; k < 64; ++k) s += pe[k] * w1[(size_t)k * 128];
        ((float*)(ws + WS_BIASP))[(kv * 32 + sl) * 128 + j] = s;
    }
    {
        float* tile = (float*)lds;
        const WtJob jobs[11] = {
            {a.in[3],  1024, INC,  INP,  a.in[2],  (bf16_t*)(ws + WS_WIN),  1024},
            {a.in[6],  256,  768,  768,  a.in[4],  (bf16_t*)(ws + WS_WUQ),  256},
            {a.in[7],  128,  1024, 1024, a.in[5],  (bf16_t*)(ws + WS_WUKV), 128},
            {a.in[12], 2048, 128,  128,  nullptr,  (bf16_t*)(ws + WS_W1C),  2048},
            {a.in[12] + 2048 * 128, 2048, 128, 128, nullptr, (bf16_t*)(ws + WS_W1C) + 128 * 2048, 2048},
            {a.in[13], 128,  64,   128,  nullptr,  (bf16_t*)(ws + WS_W2C),  128},
            {a.in[13] + 128 * 64, 128, 64, 128, nullptr, (bf16_t*)(ws + WS_W2C) + 128 * 128, 128},
            {a.in[15], 1024, 1024, 1024, a.in[14], (bf16_t*)(ws + WS_WOUT), 1024},
            {a.in[18], 1024, 512,  512,  a.in[16], (bf16_t*)(ws + WS_WXQ),  1024},
            {a.in[19], 1024, 1024, 1024, a.in[17], (bf16_t*)(ws + WS_WXKV), 1024},
            {a.in[21], 512,  1024, 1024, nullptr,  (bf16_t*)(ws + WS_WXO),  512},
        };
        int base = 0;
#pragma unroll
        for (int jb = 0; jb < 12; ++jb) {
            WtJob J;
            if (jb < 11) J = jobs[jb]; else J = WtJob{a.in[23], 1024, 1024, 1024, a.in[22], (bf16_t*)(ws + WS_WPQ), 1024};
            const int nkt = J.K / 64, nnt = J.Npad / 64, ntile = nkt * nnt;
            const int half = tid >> 8;
            for (int t0 = 2 * (int)blockIdx.x; t0 < ntile; t0 += 2 * (int)gridDim.x) {
                const int t = t0 + half; const bool ok = t < ntile; const int tt = ok ? t : 0;
                if (jb == 0) wt_tile<true>(J.W, J.N, J.gain, J.Wt, J.ldt, tt % nkt, tt / nkt, tile, ok); else wt_tile<false>(J.W, J.N, J.gain, J.Wt, J.ldt, tt % nkt, tt / nkt, tile, ok);
            }
            base += ntile;
        }
    }
}

__device__ __forceinline__ void norm_rope64(float (&v)[8], int p, const float* __restrict__ gain, const f32x2* __restrict__ cs, float scale, bool do_norm) {
    float s = 0.f;
#pragma unroll
    for (int e = 0; e < 8; ++e) s += v[e] * v[e];
    s += __shfl_xor(s, 1); s += __shfl_xor(s, 2); s += __shfl_xor(s, 4);
    const float r = rsqrtf(s * (1.0f / 64.0f) + EPSN);
    float g[8];
    { const f32x4 g0 = *(const f32x4*)(gain + p * 8), g1 = *(const f32x4*)(gain + p * 8 + 4);
      g[0] = g0[0]; g[1] = g0[1]; g[2] = g0[2]; g[3] = g0[3]; g[4] = g1[0]; g[5] = g1[1]; g[6] = g1[2]; g[7] = g1[3]; }
    if (do_norm) {
#pragma unroll
        for (int e = 0; e < 8; ++e) v[e] = v[e] * r * g[e];
    }
    float o[8];
#pragma unroll
    for (int e = 0; e < 8; ++e) o[e] = __shfl_xor(v[e], 1);
    if (do_norm && p < 2) {
#pragma unroll
        for (int e = 0; e < 8; ++e) {
            const f32x2 c = cs[e];
            v[e] = (p == 0) ? (v[e] * c[0] - o[e] * c[1]) : (v[e] * c[0] + o[e] * c[1]);
        }
    }
#pragma unroll
    for (int e = 0; e < 8; ++e) v[e] *= scale;
}

__device__ __forceinline__ void phase_tokpass(const Args& a) {
    unsigned char* ws = a.ws;
    const int tid = threadIdx.x, lane = tid & 63, w = tid >> 6;
    const int gw = blockIdx.x * NWV + w, nw = gridDim.x * NWV;
    const bf16_t* P = (const bf16_t*)(ws + WS_P);
    const f32x2* ropen = (const f32x2*)(ws + WS_ROPEN);
    const float* qn_gain = a.in[9];
    const float* kn_gain = a.in[10];
    for (int t = gw; t < T_TOK; t += nw) {
        const bf16_t* pr = P + (size_t)t * PLD;
        const int b = t >> 12, s = t & 4095;
        {
            const u32x2 q = *(const u32x2*)(pr + C_CQ + lane * 4);
            const unsigned kk = *(const unsigned*)(pr + C_CKV + lane * 2);
            float s1 = bflo(q.x) * bflo(q.x) + bfhi(q.x) * bfhi(q.x) + bflo(q.y) * bflo(q.y) + bfhi(q.y) * bfhi(q.y);
            float s2 = bflo(kk) * bflo(kk) + bfhi(kk) * bfhi(kk);
            s1 = wave_sum(s1); s2 = wave_sum(s2);
            if (lane == 0) { ((float*)(ws + WS_RSTDCQ))[t] = rsqrtf(s1 * (1.0f / 256.0f) + EPSN); ((float*)(ws + WS_RSTDCKV))[t] = rsqrtf(s2 * (1.0f / 128.0f) + EPSN); }
        }
        const f32x2* cs = ropen + (size_t)s * 8;
        {
            const int head = lane >> 3, p = lane & 7;
            float v[8]; unpack8(*(const u32x4*)(pr + C_QN + lane * 8), v);
            norm_rope64(v, p, qn_gain, cs, 0.125f * LOG2E, true);
            *(u32x4*)((bf16_t*)(ws + WS_QN) + ((size_t)(b * 8 + head) * SEQ + s) * 64 + p * 8) = pack8(v);
        }
        {
            const int which = lane >> 4, g = (lane >> 3) & 1, p = lane & 7;
            const int col = (which == 0 ? C_KS : which == 1 ? C_KW : which == 2 ? C_KC : C_VC) + g * 64 + p * 8;
            float v[8]; unpack8(*(const u32x4*)(pr + col), v);
            const float* gain = kn_gain + (which == 1 ? 128 : 64);
            norm_rope64(v, p, gain, cs, 1.0f, which < 2);
            bf16_t* dst = (bf16_t*)(ws + (which == 0 ? WS_KS : which == 1 ? WS_KW : which == 2 ? WS_KCIN : WS_VCIN));
            *(u32x4*)(dst + ((size_t)(b * 2 + g) * SEQ + s) * 64 + p * 8) = pack8(v);
        }
        if (lane < 24) {
            const float x = bf2f(pr[C_GATE + lane]);
            ((float*)(ws + WS_GATE))[(size_t)t * 24 + lane] = 1.0f / (1.0f + __expf(-x));
        }
    }
}

__device__ __forceinline__ void phase_mla_k(const Args& a) {
    unsigned char* ws = a.ws;
    const int tid = threadIdx.x, lane = tid & 63, w = tid >> 6;
    const int gw = blockIdx.x * NWV + w, nw = gridDim.x * NWV;
    const bf16_t* P = (const bf16_t*)(ws + WS_P);
    const bf16_t* KV = (const bf16_t*)(ws + WS_KVRAW);
    const f32x2* ropem = (const f32x2*)(ws + WS_ROPEM);
    const float* kg = a.in[8] + 96;
    const int head = lane >> 3, p = lane & 7;
    for (int t = gw; t < T_TOK; t += nw) {
        const int b = t >> 12, s = t & 4095;
        float v[8]; unpack8(*(const u32x4*)(KV + (size_t)t * 1024 + head * 128 + p * 8), v);
        const unsigned x1w = *(const unsigned*)(P + (size_t)t * PLD + C_KPE + 2 * p);
        const unsigned x2w = *(const unsigned*)(P + (size_t)t * PLD + C_KPE + 16 + 2 * p);
        float x1[2] = {bflo(x1w), bfhi(x1w)}, x2[2] = {bflo(x2w), bfhi(x2w)};
        float ss = x1[0] * x1[0] + x1[1] * x1[1] + x2[0] * x2[0] + x2[1] * x2[1];
#pragma unroll
        for (int e = 0; e < 8; ++e) ss += v[e] * v[e];
        ss += __shfl_xor(ss, 1); ss += __shfl_xor(ss, 2); ss += __shfl_xor(ss, 4);
        const float r = rsqrtf(ss * (1.0f / 96.0f) + EPSN);
#pragma unroll
        for (int e = 0; e < 8; ++e) v[e] = v[e] * r * kg[p * 8 + e];
        const f32x4 cs = *(const f32x4*)(ropem + (size_t)s * 16 + 2 * p);
        float y1[2], y2[2];
#pragma unroll
        for (int e = 0; e < 2; ++e) {
            const float a1 = x1[e] * r * kg[64 + 2 * p + e], a2 = x2[e] * r * kg[80 + 2 * p + e];
            const float c = cs[2 * e], sn = cs[2 * e + 1];
            y1[e] = a1 * c - a2 * sn; y2[e] = a2 * c + a1 * sn;
        }
        bf16_t* kp = (bf16_t*)(ws + WS_KM) + ((size_t)(b * 8 + head) * SEQ + s) * 96;
        *(u32x4*)(kp + p * 8) = pack8(v);
        *(unsigned*)(kp + 64 + 2 * p) = pack2(y1[0], y1[1]);
        *(unsigned*)(kp + 80 + 2 * p) = pack2(y2[0], y2[1]);
    }
}

__device__ __forceinline__ void phase_xa_k(const Args& a, int vb, int VG) {
    unsigned char* ws = a.ws;
    const int tid = threadIdx.x, lane = tid & 63, w = tid >> 6;
    const int gw = vb * NWV + w, nw = VG * NWV;
    const bf16_t* KVX = (const bf16_t*)(ws + WS_KVX);
    const float* kg = a.in[20] + 128;
    const int head = lane >> 4, p = lane & 15;
    for (int r = gw; r < 4096; r += nw) {
        const int b = r >> 8, m = r & 255;
        float v[8]; unpack8(*(const u32x4*)(KVX + (size_t)r * 1024 + head * 128 + p * 8), v);
        float ss = 0.f;
#pragma unroll
        for (int e = 0; e < 8; ++e) ss += v[e] * v[e];
        ss += __shfl_xor(ss, 1); ss += __shfl_xor(ss, 2); ss += __shfl_xor(ss, 4); ss += __shfl_xor(ss, 8);
        const float rr = rsqrtf(ss * (1.0f / 128.0f) + EPSN);
#pragma unroll
        for (int e = 0; e < 8; ++e) v[e] = v[e] * rr * kg[p * 8 + e];
        *(u32x4*)((bf16_t*)(ws + WS_KX) + ((size_t)(b * 4 + head) * 256 + m) * 128 + p * 8) = pack8(v);
    }
}

__device__ __forceinline__ void phase_cmp_fin(const Args& a) {
    unsigned char* ws = a.ws;
    const int tid = threadIdx.x, lane = tid & 63, w = tid >> 6;
    const int gw = blockIdx.x * NWV + w, nw = gridDim.x * NWV;
    const float* CR = (const float*)(ws + WS_CRAW);
    const f32x2* ropen = (const f32x2*)(ws + WS_ROPEN);
    const float* kg = a.in[10];
    for (int r = gw; r < 16384; r += nw) {
        const int kv = r >> 13, row = r & 8191, bg = row >> 8, n = row & 255;
        float x = CR[(size_t)r * 64 + lane];
        if (n == 255) x = 0.f;
        if (kv == 0) {
            float ss = wave_sum(x * x);
            const float rr = rsqrtf(ss * (1.0f / 64.0f) + EPSN);
            x = x * rr * kg[lane];
            const float o = __shfl_xor(x, 8);
            int pos = 16 * n + 31; if (pos > 4095) pos = 4095;
            if (lane < 16) {
                const f32x2 c = ropen[(size_t)pos * 8 + (lane & 7)];
                x = (lane < 8) ? (x * c[0] - o * c[1]) : (x * c[0] + o * c[1]);
            }
            if (n == 255) x = 0.f;
            ((bf16_t*)(ws + WS_KC))[((size_t)bg * 256 + n) * 64 + lane] = (bf16_t)f2bf(x);
        } else {
            ((bf16_t*)(ws + WS_VCT))[((size_t)bg * 64 + lane) * 256 + n] = (bf16_t)f2bf(x);
        }
    }
}

template <int KS, int DVT>
struct AttnRegs { u32x4 k[(KS * 128 + NT - 1) / NT]; u32x4 v[(DVT * 256 + NT - 1) / NT]; };

template <int KS, int DVT>
__device__ __forceinline__ void attn_prefetch(AttnRegs<KS, DVT>& R, const bf16_t* __restrict__ ktile  , const bf16_t* __restrict__ vt  , size_t ldv) {
    const int tid = threadIdx.x;
#pragma unroll
    for (int i = 0; i < (KS * 128 + NT - 1) / NT; ++i) { const int id = tid + NT * i; if (id < KS * 128) R.k[i] = *(const u32x4*)(ktile + (size_t)id * 8); }
#pragma unroll
    for (int i = 0; i < (DVT * 256 + NT - 1) / NT; ++i) { const int id = tid + NT * i; if (id < DVT * 256) R.v[i] = *(const u32x4*)(vt + (size_t)(id >> 3) * ldv + (id & 7) * 8); }
}
template <int KS, int DVT>
__device__ __forceinline__ void attn_store(const AttnRegs<KS, DVT>& R, unsigned char* kl, unsigned char* vl) {
    constexpr int KP = KS * 32 + 16;
    const int tid = threadIdx.x;
#pragma unroll
    for (int i = 0; i < (KS * 128 + NT - 1) / NT; ++i) { const int id = tid + NT * i; if (id < KS * 128) { const int row = id / (2 * KS), c = id % (2 * KS); *(u32x4*)(kl + row * KP + c * 16) = R.k[i]; } }
#pragma unroll
    for (int i = 0; i < (DVT * 256 + NT - 1) / NT; ++i) { const int id = tid + NT * i; if (id < DVT * 256) *(u32x4*)(vl + (id >> 3) * 144 + (id & 7) * 16) = R.v[i]; }
}

template <int KS>
__device__ __forceinline__ void attn_scores(const unsigned char* kl, const bf16x8 (&qf)[KS], f32x16 (&s)[2], int l31, int hh, float sinit = 0.f) {
    constexpr int KP = KS * 32 + 16;
    if (KS <= 6) {
        bf16x8 kf[2][KS];
#pragma unroll
        for (int kt2 = 0; kt2 < 2; ++kt2) {
            const unsigned char* kr = kl + (32 * kt2 + kap(l31)) * KP + hh * 16;
#pragma unroll
            for (int ks = 0; ks < KS; ++ks) kf[kt2][ks] = as_bf16x8(*(const u32x4*)(kr + ks * 32));
        }
        __builtin_amdgcn_sched_barrier(0);
#pragma unroll
        for (int kt2 = 0; kt2 < 2; ++kt2) {
#pragma unroll
            for (int r = 0; r < 16; ++r) s[kt2][r] = sinit;
#pragma unroll
            for (int ks = 0; ks < KS; ++ks) s[kt2] = MFMA32(kf[kt2][ks], qf[ks], s[kt2]);
        }
    } else {
#pragma unroll
        for (int kt2 = 0; kt2 < 2; ++kt2) {
            bf16x8 kf[KS];
            const unsigned char* kr = kl + (32 * kt2 + kap(l31)) * KP + hh * 16;
#pragma unroll
            for (int ks = 0; ks < KS; ++ks) kf[ks] = as_bf16x8(*(const u32x4*)(kr + ks * 32));
            __builtin_amdgcn_sched_barrier(0);
#pragma unroll
            for (int r = 0; r < 16; ++r) s[kt2][r] = sinit;
#pragma unroll
            for (int ks = 0; ks < KS; ++ks) s[kt2] = MFMA32(kf[ks], qf[ks], s[kt2]);
        }
    }
}

template <int KS, int DVT, bool MASKED = true, class MaskF>
__device__ __forceinline__ void flash_tile(const unsigned char* kl, const unsigned char* vl, const bf16x8 (&qf)[KS], f32x16 (&o)[DVT], float& m, float& l,
                                           int l31, int hh, MaskF valid, float sinit = 0.f) {
    f32x16 s[2];
    attn_scores<KS>(kl, qf, s, l31, hh, sinit);
    f32x2 ps2 = (f32x2){0.f, 0.f};
#pragma unroll
    for (int kt2 = 0; kt2 < 2; ++kt2) {
#pragma unroll
        for (int r = 0; r < 16; r += 2) {
            float p0 = __builtin_amdgcn_exp2f(s[kt2][r]), p1 = __builtin_amdgcn_exp2f(s[kt2][r + 1]);
            if (MASKED) {
                const int key = 32 * kt2 + 16 * (r >> 3) + 8 * hh + (r & 7);
                p0 = valid(key) ? p0 : 0.f; p1 = valid(key + 1) ? p1 : 0.f;
            }
            s[kt2][r] = p0; s[kt2][r + 1] = p1;
            ps2 += (f32x2){p0, p1};
        }
        bf16x8 pf[2];
#pragma unroll
        for (int s2 = 0; s2 < 2; ++s2) {
            u32x4 w;
            w.x = pack2(s[kt2][8 * s2 + 0], s[kt2][8 * s2 + 1]); w.y = pack2(s[kt2][8 * s2 + 2], s[kt2][8 * s2 + 3]);
            w.z = pack2(s[kt2][8 * s2 + 4], s[kt2][8 * s2 + 5]); w.w = pack2(s[kt2][8 * s2 + 6], s[kt2][8 * s2 + 7]);
            pf[s2] = as_bf16x8(w);
        }
#pragma unroll
        for (int d = 0; d < DVT; ++d) {
            const unsigned char* vr = vl + (32 * d + kap(l31)) * 144 + hh * 16 + (32 * kt2) * 2;
            const bf16x8 vf0 = as_bf16x8(*(const u32x4*)vr), vf1 = as_bf16x8(*(const u32x4*)(vr + 32));
            o[d] = MFMA32(vf0, pf[0], o[d]);
            o[d] = MFMA32(vf1, pf[1], o[d]);
        }
    }
    l += ps2[0] + ps2[1];
    (void)m;
}

template <int DVT>
__device__ __forceinline__ float flash_final(f32x16 (&o)[DVT], float l) {
    const float lt = l + __shfl_xor(l, 32);
    const float inv = lt > 0.f ? 1.0f / lt : 0.f;
#pragma unroll
    for (int d = 0; d < DVT; ++d)
#pragma unroll
        for (int r = 0; r < 16; ++r) o[d][r] *= inv;
    return inv;
}

#define ATT_K_OFF 0
#define ATT_V_OFF 17408
#define ATT_X_OFF 36864
#define ATT_MISC_OFF 103424

__device__ __forceinline__ void mla_unit(const Args& a, int b, int h, int qt, unsigned char* lds) {
    unsigned char* ws = a.ws;
    int tid_ = threadIdx.x; asm volatile("" : "+v"(tid_));
    const int tid = tid_, lane = tid & 63, w = tid >> 6, l31 = lane & 31, hh = lane >> 5;
    const int qw0 = qt * 256 + 32 * w, q = qw0 + l31;
    const size_t t = (size_t)b * SEQ + q;
    const bf16_t* kb = (const bf16_t*)(ws + WS_KM) + (size_t)(b * 8 + h) * SEQ * 96;
    const bf16_t* vb = (const bf16_t*)(ws + WS_VMT) + (size_t)(b * 8 + h) * 64 * SEQ;
    AttnRegs<6, 2> R;
    attn_prefetch<6, 2>(R, kb, vb, SEQ);
    bf16x8 qf[6];
    {
        const bf16_t* qr = (const bf16_t*)(ws + WS_QMRAW) + t * 768 + h * 96 + 8 * hh;
        const float* qg = a.in[8];
        float v[6][8]; float ss = 0.f;
#pragma unroll
        for (int ks = 0; ks < 6; ++ks) { unpack8(*(const u32x4*)(qr + 16 * ks), v[ks]);
#pragma unroll
            for (int e = 0; e < 8; ++e) ss += v[ks][e] * v[ks][e]; }
        ss += __shfl_xor(ss, 32);
        const float r = rsqrtf(ss * (1.0f / 96.0f) + EPSN);
#pragma unroll
        for (int ks = 0; ks < 6; ++ks)
#pragma unroll
            for (int e = 0; e < 8; ++e) v[ks][e] = v[ks][e] * r * qg[16 * ks + 8 * hh + e];
        const f32x2* cs = (const f32x2*)(ws + WS_ROPEM) + (size_t)q * 16 + 8 * hh;
#pragma unroll
        for (int e = 0; e < 8; ++e) {
            const f32x2 c = cs[e]; const float x1 = v[4][e], x2 = v[5][e];
            v[4][e] = x1 * c[0] - x2 * c[1]; v[5][e] = x2 * c[0] + x1 * c[1];
        }
        const float sc = 0.10206207261596577f * LOG2E;
#pragma unroll
        for (int ks = 0; ks < 6; ++ks) {
#pragma unroll
            for (int e = 0; e < 8; ++e) v[ks][e] *= sc;
            qf[ks] = as_bf16x8(pack8(v[ks]));
        }
    }
    f32x16 o[2];
#pragma unroll
    for (int d = 0; d < 2; ++d)
#pragma unroll
        for (int r = 0; r < 16; ++r) o[d][r] = 0.f;
    float m = -1e30f, l = 0.f;
    const int nkt = 4 * qt + 4;
    __syncthreads();
    attn_store<6, 2>(R, lds, lds + 13312);
    __syncthreads();
    for (int it = 0; it < nkt; ++it) {
        const int k0 = it * 64;
        const unsigned char* klc = lds + (it & 1) * 22528; const unsigned char* vlc = klc + 13312;
        if (it + 1 < nkt) attn_prefetch<6, 2>(R, kb + (size_t)(k0 + 64) * 96, vb + k0 + 64, SEQ);
        if (k0 + 63 <= qw0)
            flash_tile<6, 2, false>(klc, vlc, qf, o, m, l, l31, hh, [&](int) { return true; });
        else if (k0 <= qw0 + 31)
            flash_tile<6, 2>(klc, vlc, qf, o, m, l, l31, hh, [&](int key) { return k0 + key <= q; });
        if (it + 1 < nkt) attn_store<6, 2>(R, lds + ((it + 1) & 1) * 22528, lds + ((it + 1) & 1) * 22528 + 13312);
        __syncthreads();
    }
    flash_final<2>(o, l);
    {
        float sq = 0.f;
#pragma unroll
        for (int d = 0; d < 2; ++d)
#pragma unroll
            for (int r = 0; r < 16; ++r) sq += o[d][r] * o[d][r];
        sq += __shfl_xor(sq, 32);
        if (hh == 0) ((float*)(ws + WS_SSQ))[t * 16 + h] = sq;
    }
    bf16_t* op = (bf16_t*)(ws + WS_OMIX) + t * 1024 + h * 64 + 8 * hh;
#pragma unroll
    for (int d = 0; d < 2; ++d)
#pragma unroll
        for (int j = 0; j < 2; ++j) {
            float v[8];
#pragma unroll
            for (int e = 0; e < 8; ++e) v[e] = o[d][8 * j + e];
            *(u32x4*)(op + 32 * d + 16 * j) = pack8(v);
        }
}


#define PS_PITCH 260
__device__ __forceinline__ void nsa_unit(const Args& a, int b, int g, int j, unsigned char* lds) {
    unsigned char* ws = a.ws;
    int tid_ = threadIdx.x; asm volatile("" : "+v"(tid_));
    const int tid = tid_, lane = tid & 63, w = tid >> 6, l31 = lane & 31, hh = lane >> 5;
    const int posl = lane & 7, r4 = (lane >> 3) & 3;
    const int s0 = 64 * j, qpos = s0 + 8 * w + posl, hq = 4 * g + r4, bg = b * 2 + g;
    const size_t t = (size_t)b * SEQ + qpos;
    const int cur = j;
    unsigned char* kl = lds; unsigned char* vl = lds + 9216;
    float* psum = (float*)(lds + ATT_X_OFF);
    AttnRegs<4, 2> R;
    const int ntc = (4 * j + 2) / 64 + 1;
    const bf16_t* kcb = (const bf16_t*)(ws + WS_KC) + (size_t)bg * 256 * 64;
    const bf16_t* vcb = (const bf16_t*)(ws + WS_VCT) + (size_t)bg * 64 * 256;
    attn_prefetch<4, 2>(R, kcb, vcb, 256);
    bf16x8 qf[4];
    {
        const bf16_t* qr = (const bf16_t*)(ws + WS_QN) + ((size_t)(b * 8 + hq) * SEQ + qpos) * 64 + 8 * hh;
#pragma unroll
        for (int ks = 0; ks < 4; ++ks) qf[ks] = as_bf16x8(*(const u32x4*)(qr + 16 * ks));
    }
    const float* gate = (const float*)(ws + WS_GATE) + t * 24 + hq * 3;
    const float g_c = gate[0], g_s = gate[1], g_w = gate[2];
    f32x16 acc[2];
#pragma unroll
    for (int d = 0; d < 2; ++d)
#pragma unroll
        for (int r = 0; r < 16; ++r) acc[d][r] = 0.f;
    float m_c, inv_c;
    {
        f32x16 o[2];
#pragma unroll
        for (int d = 0; d < 2; ++d)
#pragma unroll
            for (int r = 0; r < 16; ++r) o[d][r] = 0.f;
        float m = -1e30f, l = 0.f;
        __syncthreads();
        attn_store<4, 2>(R, kl, vl);
        __syncthreads();
        for (int it = 0; it < ntc; ++it) {
            const int k0 = it * 64;
            const unsigned char* klc = kl + (it & 1) * 18432; const unsigned char* vlc = klc + 9216;
            if (it + 1 < ntc) attn_prefetch<4, 2>(R, kcb + (size_t)(k0 + 64) * 64, vcb + k0 + 64, 256);
            flash_tile<4, 2>(klc, vlc, qf, o, m, l, l31, hh, [&](int key) { return 16 * (k0 + key) + 31 <= qpos; });
            if (it + 1 < ntc) attn_store<4, 2>(R, kl + ((it + 1) & 1) * 18432, kl + ((it + 1) & 1) * 18432 + 9216);
            __syncthreads();
        }
        inv_c = flash_final<2>(o, l); m_c = m;
#pragma unroll
        for (int d = 0; d < 2; ++d)
#pragma unroll
            for (int r = 0; r < 16; ++r) acc[d][r] += g_c * o[d][r];
    }
    {
        attn_prefetch<4, 2>(R, kcb, vcb, 256);
        __syncthreads();
        attn_store<4, 2>(R, kl, vl);
        __syncthreads();
        for (int it = 0; it < ntc; ++it) {
            const int k0 = it * 64;
            const unsigned char* klc = kl + (it & 1) * 18432;
            if (it + 1 < ntc) attn_prefetch<4, 2>(R, kcb + (size_t)(k0 + 64) * 64, vcb + k0 + 64, 256);
            f32x16 s[2];
            attn_scores<4>(klc, qf, s, l31, hh);
#pragma unroll
            for (int kt2 = 0; kt2 < 2; ++kt2)
#pragma unroll
                for (int r = 0; r < 16; ++r) {
                    const int key = 32 * kt2 + 16 * (r >> 3) + 8 * hh + (r & 7);
                    const bool ok = 16 * (k0 + key) + 31 <= qpos;
                    float p = ok ? __builtin_amdgcn_exp2f(s[kt2][r]) * inv_c : 0.f;
                    p += __shfl_xor(p, 8); p += __shfl_xor(p, 16);
                    s[kt2][r] = p;
                }
            if (r4 == 0) {
                float* pr = psum + (8 * w + posl) * PS_PITCH + k0 + 8 * hh;
#pragma unroll
                for (int kt2 = 0; kt2 < 2; ++kt2)
#pragma unroll
                    for (int j2 = 0; j2 < 2; ++j2) {
                        *(f32x4*)(pr + 32 * kt2 + 16 * j2) = (f32x4){s[kt2][8 * j2 + 0], s[kt2][8 * j2 + 1], s[kt2][8 * j2 + 2], s[kt2][8 * j2 + 3]};
                        *(f32x4*)(pr + 32 * kt2 + 16 * j2 + 4) = (f32x4){s[kt2][8 * j2 + 4], s[kt2][8 * j2 + 5], s[kt2][8 * j2 + 6], s[kt2][8 * j2 + 7]};
                    }
            }
            if (it + 1 < ntc) attn_store<4, 2>(R, kl + ((it + 1) & 1) * 18432, kl + ((it + 1) & 1) * 18432 + 9216);
            __syncthreads();
        }
    }
    __syncthreads();
    unsigned long long mymask, unionmask;
    {
        const int mg = lane >> 3;
        float* impb = (float*)kl + (w * 8 + posl) * 64;
        const float* pr = psum + (8 * w + posl) * PS_PITCH;
        const int nvis = (64 * ntc < 255) ? 64 * ntc : 255;
        float imp[8];
#pragma unroll
        for (int e = 0; e < 8; ++e) {
            const int m = mg * 8 + e;
            float sacc = 0.f;
#pragma unroll
            for (int d = -1; d <= 3; ++d) { const int n = 4 * m + d; if (n >= 0 && n < nvis) sacc += pr[n]; }
            imp[e] = sacc; impb[m] = sacc;
        }
        __syncthreads();
        int cnt[8];
#pragma unroll
        for (int e = 0; e < 8; ++e) cnt[e] = 0;
        const float* ib = (const float*)kl + (w * 8 + posl) * 64;
        for (int mp = 1; mp <= cur - 2; ++mp) {
            const float v = ib[mp];
#pragma unroll
            for (int e = 0; e < 8; ++e) { const int m = mg * 8 + e; cnt[e] += ((v > imp[e]) || (v == imp[e] && mp < m)) ? 1 : 0; }
        }
        const int nf = cur == 0 ? 1 : (cur == 1 ? 2 : 3);
        const int nsel = 16 - nf;
        unsigned m8 = 0;
#pragma unroll
        for (int e = 0; e < 8; ++e) {
            const int m = mg * 8 + e;
            const bool forced = (m == 0) || (m == cur) || (m == cur - 1);
            const bool sel = (m <= cur) && (forced || (m >= 1 && m <= cur - 2 && cnt[e] < nsel));
            m8 |= sel ? (1u << e) : 0u;
        }
        unsigned lo = (mg < 4) ? (m8 << (8 * mg)) : 0u, hi = (mg >= 4) ? (m8 << (8 * (mg - 4))) : 0u;
        lo |= __shfl_xor(lo, 8); hi |= __shfl_xor(hi, 8);
        lo |= __shfl_xor(lo, 16); hi |= __shfl_xor(hi, 16);
        lo |= __shfl_xor(lo, 32); hi |= __shfl_xor(hi, 32);
        mymask = ((unsigned long long)hi << 32) | lo;
        unsigned ulo = lo, uhi = hi;
        ulo |= __shfl_xor(ulo, 1); uhi |= __shfl_xor(uhi, 1);
        ulo |= __shfl_xor(ulo, 2); uhi |= __shfl_xor(uhi, 2);
        ulo |= __shfl_xor(ulo, 4); uhi |= __shfl_xor(uhi, 4);
        unsigned* misc = (unsigned*)(lds + ATT_MISC_OFF);
        if (lane == 0) { misc[2 * w] = ulo; misc[2 * w + 1] = uhi; }
        __syncthreads();
        ulo = misc[0] | misc[2] | misc[4] | misc[6] | misc[8] | misc[10] | misc[12] | misc[14]; uhi = misc[1] | misc[3] | misc[5] | misc[7] | misc[9] | misc[11] | misc[13] | misc[15];
        unionmask = ((unsigned long long)uhi << 32) | ulo;
    }
    {
        f32x16 o[2];
#pragma unroll
        for (int d = 0; d < 2; ++d)
#pragma unroll
            for (int r = 0; r < 16; ++r) o[d][r] = 0.f;
        float m = -1e30f, l = 0.f;
        const bf16_t* kb = (const bf16_t*)(ws + WS_KS) + (size_t)bg * SEQ * 64;
        const bf16_t* vb = (const bf16_t*)(ws + WS_VST) + (size_t)bg * 64 * SEQ;
        unsigned long long rem = unionmask;
        int mb = __builtin_ctzll(rem); rem &= rem - 1;
        attn_prefetch<4, 2>(R, kb + (size_t)mb * 64 * 64, vb + mb * 64, SEQ);
        __syncthreads();
        attn_store<4, 2>(R, kl, vl);
        __syncthreads();
        int cbuf = 0;
        for (;;) {
            const int k0 = mb * 64;
            const bool more = rem != 0ull;
            int mnext = 0;
            if (more) { mnext = __builtin_ctzll(rem); rem &= rem - 1; }
            const unsigned char* klc = kl + cbuf * 18432; const unsigned char* vlc = klc + 9216;
            if (more) attn_prefetch<4, 2>(R, kb + (size_t)mnext * 64 * 64, vb + mnext * 64, SEQ);
            const bool mine = (mymask >> mb) & 1ull;
            if (mb < cur) {
                if (__all(mine)) flash_tile<4, 2, false>(klc, vlc, qf, o, m, l, l31, hh, [&](int) { return true; });
                else if (__any(mine)) flash_tile<4, 2, false>(klc, vlc, qf, o, m, l, l31, hh, [&](int) { return true; }, mine ? 0.f : -1e30f);
            } else
                flash_tile<4, 2>(klc, vlc, qf, o, m, l, l31, hh, [&](int key) { return mine && (k0 + key <= qpos); });
            if (more) attn_store<4, 2>(R, kl + (cbuf ^ 1) * 18432, kl + (cbuf ^ 1) * 18432 + 9216);
            __syncthreads();
            if (!more) break;
            mb = mnext; cbuf ^= 1;
        }
        flash_final<2>(o, l);
#pragma unroll
        for (int d = 0; d < 2; ++d)
#pragma unroll
            for (int r = 0; r < 16; ++r) acc[d][r] += g_s * o[d][r];
    }
    {
        f32x16 o[2];
#pragma unroll
        for (int d = 0; d < 2; ++d)
#pragma unroll
            for (int r = 0; r < 16; ++r) o[d][r] = 0.f;
        float m = -1e30f, l = 0.f;
        const bf16_t* kb = (const bf16_t*)(ws + WS_KW) + (size_t)bg * SEQ * 64;
        const bf16_t* vb = (const bf16_t*)(ws + WS_VWT) + (size_t)bg * 64 * SEQ;
        const int lo = s0 - 511;
        const int m0 = lo <= 0 ? 0 : (lo >> 6);
        attn_prefetch<4, 2>(R, kb + (size_t)m0 * 64 * 64, vb + m0 * 64, SEQ);
        __syncthreads();
        attn_store<4, 2>(R, kl, vl);
        __syncthreads();
        for (int mb = m0; mb <= cur; ++mb) {
            const int k0 = mb * 64;
            const int cb2 = (mb - m0) & 1;
            const unsigned char* klc = kl + cb2 * 18432; const unsigned char* vlc = klc + 9216;
            if (mb + 1 <= cur) attn_prefetch<4, 2>(R, kb + (size_t)(mb + 1) * 64 * 64, vb + (mb + 1) * 64, SEQ);
            if (k0 + 63 <= s0 + 8 * w && s0 + 8 * w + 7 - k0 < 512)
                flash_tile<4, 2, false>(klc, vlc, qf, o, m, l, l31, hh, [&](int) { return true; });
            else
                flash_tile<4, 2>(klc, vlc, qf, o, m, l, l31, hh, [&](int key) { const int kp = k0 + key; return (kp <= qpos) && (qpos - kp < 512); });
            if (mb + 1 <= cur) attn_store<4, 2>(R, kl + (cb2 ^ 1) * 18432, kl + (cb2 ^ 1) * 18432 + 9216);
            __syncthreads();
        }
        flash_final<2>(o, l);
#pragma unroll
        for (int d = 0; d < 2; ++d)
#pragma unroll
            for (int r = 0; r < 16; ++r) acc[d][r] += g_w * o[d][r];
    }
    {
        float sq = 0.f;
#pragma unroll
        for (int d = 0; d < 2; ++d)
#pragma unroll
            for (int r = 0; r < 16; ++r) sq += acc[d][r] * acc[d][r];
        sq += __shfl_xor(sq, 32);
        if (hh == 0) ((float*)(ws + WS_SSQ))[t * 16 + 8 + hq] = sq;
    }
    bf16_t* op = (bf16_t*)(ws + WS_OMIX) + t * 1024 + 512 + hq * 64 + 8 * hh;
#pragma unroll
    for (int d = 0; d < 2; ++d)
#pragma unroll
        for (int j2 = 0; j2 < 2; ++j2) {
            float v[8];
#pragma unroll
            for (int e = 0; e < 8; ++e) v[e] = acc[d][8 * j2 + e];
            *(u32x4*)(op + 32 * d + 16 * j2) = pack8(v);
        }
}


__device__ __forceinline__ void xa_unit(const Args& a, int b, int head, int qt, unsigned char* lds) {
    unsigned char* ws = a.ws;
    int tid_ = threadIdx.x; asm volatile("" : "+v"(tid_));
    const int tid = tid_, lane = tid & 63, w = tid >> 6, l31 = lane & 31, hh = lane >> 5;
    const int q = qt * 256 + 32 * w + l31;
    const size_t t = (size_t)b * SEQ + q;
    unsigned char* kl = lds + ATT_K_OFF; unsigned char* vl = lds + ATT_V_OFF;
    bf16x8 qf[8];
    {
        const bf16_t* qr = (const bf16_t*)(ws + WS_QX) + t * 512 + head * 128 + 8 * hh;
        const float* qg = a.in[20];
        float ss = 0.f;
        u32x4 raw[8];
#pragma unroll
        for (int ks = 0; ks < 8; ++ks) { raw[ks] = *(const u32x4*)(qr + 16 * ks); float v[8]; unpack8(raw[ks], v);
#pragma unroll
            for (int e = 0; e < 8; ++e) ss += v[e] * v[e]; }
        ss += __shfl_xor(ss, 32);
        const float r = rsqrtf(ss * (1.0f / 128.0f) + EPSN) * 0.08838834764831845f * LOG2E;
#pragma unroll
        for (int ks = 0; ks < 8; ++ks) { float v[8]; unpack8(raw[ks], v);
#pragma unroll
            for (int e = 0; e < 8; ++e) v[e] = v[e] * r * qg[16 * ks + 8 * hh + e];
            qf[ks] = as_bf16x8(pack8(v)); }
    }
    f32x16 o[4];
#pragma unroll
    for (int d = 0; d < 4; ++d)
#pragma unroll
        for (int r = 0; r < 16; ++r) o[d][r] = 0.f;
    float m = -1e30f, l = 0.f;
    const bf16_t* kb = (const bf16_t*)(ws + WS_KX) + (size_t)(b * 4 + head) * 256 * 128;
    const bf16_t* vb = (const bf16_t*)(ws + WS_VXT) + (size_t)(b * 4 + head) * 128 * 256;
#pragma unroll 1
    for (int it = 0; it < 4; ++it) {
        const int k0 = it * 64;
        __syncthreads();
        { AttnRegs<8, 4> R; attn_prefetch<8, 4>(R, kb + (size_t)k0 * 128, vb + k0, 256); attn_store<8, 4>(R, kl, vl); }
        __syncthreads();
        flash_tile<8, 4, false>(kl, vl, qf, o, m, l, l31, hh, [&](int) { return true; });
    }
    flash_final<4>(o, l);
    bf16_t* op = (bf16_t*)(ws + WS_OX) + t * 512 + head * 128 + 8 * hh;
#pragma unroll
    for (int d = 0; d < 4; ++d)
#pragma unroll
        for (int j2 = 0; j2 < 2; ++j2) {
            float v[8];
#pragma unroll
            for (int e = 0; e < 8; ++e) v[e] = o[d][8 * j2 + e];
            *(u32x4*)(op + 32 * d + 16 * j2) = pack8(v);
        }
}

__device__ __forceinline__ int f2ord(float x) { const int b = __float_as_int(x); return b ^ ((b >> 31) & 0x7FFFFFFF); }
__device__ __forceinline__ float ord2f(int k) { return __int_as_float(k ^ ((k >> 31) & 0x7FFFFFFF)); }
#define IMIN ((int)0x80000000)

#define CEX_DESC(a_, b_) do { const int hi_ = max((a_), (b_)), lo_ = min((a_), (b_)); (a_) = hi_; (b_) = lo_; } while (0)
__device__ __forceinline__ void bitonic_sort_desc16(int (&a)[16]) {
#pragma unroll
    for (int k = 2; k <= 16; k <<= 1)
#pragma unroll
        for (int j = k >> 1; j > 0; j >>= 1)
#pragma unroll
            for (int i = 0; i < 16; ++i) {
                const int l = i ^ j;
                if (l > i) { if ((i & k) == 0) CEX_DESC(a[i], a[l]); else CEX_DESC(a[l], a[i]); }
            }
}
__device__ __forceinline__ void merge_top16(int (&a)[16], const int (&b)[16]) {
#pragma unroll
    for (int i = 0; i < 16; ++i) a[i] = max(a[i], b[15 - i]);
#pragma unroll
    for (int j = 8; j > 0; j >>= 1)
#pragma unroll
        for (int i = 0; i < 16; ++i) { const int l = i ^ j; if (l > i) CEX_DESC(a[i], a[l]); }
}
__device__ __forceinline__ void peer_top16_of_128(const bf16_t* __restrict__ kp  , const bf16x8 (&qf)[4]  , int (&lst)[16], int l31, int hh) {
    int key[4][16];
#pragma unroll
    for (int kt = 0; kt < 4; ++kt) {
        f32x16 s;
#pragma unroll
        for (int r = 0; r < 16; ++r) s[r] = 0.f;
        const bf16_t* kr = kp + (size_t)(32 * kt + kap(l31)) * 64 + 8 * hh;
#pragma unroll
        for (int ks = 0; ks < 4; ++ks) { const bf16x8 kf = as_bf16x8(*(const u32x4*)(kr + 16 * ks)); s = MFMA32(kf, qf[ks], s); }
#pragma unroll
        for (int r = 0; r < 16; ++r) {
            const int idx = 32 * kt + 16 * (r >> 3) + 8 * hh + (r & 7);
            key[kt][r] = (__float_as_int(s[r] + 64.0f) & ~0x7F) | (127 - idx);
        }
    }
    bitonic_sort_desc16(key[0]); bitonic_sort_desc16(key[1]); bitonic_sort_desc16(key[2]); bitonic_sort_desc16(key[3]);
    merge_top16(key[0], key[1]); merge_top16(key[2], key[3]); merge_top16(key[0], key[2]);
#pragma unroll
    for (int i = 0; i < 16; ++i) lst[i] = key[0][i];
}

__device__ __forceinline__ void phase_peer_route(const Args& a) {
    unsigned char* ws = a.ws;
    int tid_ = threadIdx.x; asm volatile("" : "+v"(tid_));
    const int tid = tid_, lane = tid & 63, w = tid >> 6, l31 = lane & 31, hh = lane >> 5;
    const int gw = blockIdx.x * NWV + w, nw = gridDim.x * NWV;
    const bf16_t* QP = (const bf16_t*)(ws + WS_QP);
    const bf16_t* KP = (const bf16_t*)(ws + WS_KP);
    int* EIDX = (int*)(ws + WS_EIDX);
    float* EG = (float*)(ws + WS_EG);
    for (int it = gw; it < (T_TOK / 32) * 4; it += nw) {
        const int hp = it & 3, t = (it >> 2) * 32 + l31;
        const int h = 2 * hp + hh;
        int l1[16], l2[16];
        bf16x8 qA0[4], qB0[4], qA1[4], qB1[4];
        {
            const bf16_t* qr = QP + (size_t)t * 1024 + (2 * hp) * 128 + 8 * hh;
#pragma unroll
            for (int ks = 0; ks < 4; ++ks) {
                qA0[ks] = as_bf16x8(*(const u32x4*)(qr + 16 * ks)); qA1[ks] = as_bf16x8(*(const u32x4*)(qr + 64 + 16 * ks));
                qB0[ks] = as_bf16x8(*(const u32x4*)(qr + 128 + 16 * ks)); qB1[ks] = as_bf16x8(*(const u32x4*)(qr + 192 + 16 * ks));
            }
        }
        {
            int pA[16], pB[16];
            peer_top16_of_128(KP + (size_t)((2 * hp) * 2 + 0) * 128 * 64, qA0, pA, l31, hh);
            peer_top16_of_128(KP + (size_t)((2 * hp + 1) * 2 + 0) * 128 * 64, qB0, pB, l31, hh);
#pragma unroll
            for (int i = 0; i < 16; ++i) { const u32x2 sw = __builtin_amdgcn_permlane32_swap((unsigned)pA[i], (unsigned)pB[i], false, false); l1[i] = (int)sw.x; pB[i] = (int)sw.y; }
            merge_top16(l1, pB);
        }
        {
            int pA[16], pB[16];
            peer_top16_of_128(KP + (size_t)((2 * hp) * 2 + 1) * 128 * 64, qA1, pA, l31, hh);
            peer_top16_of_128(KP + (size_t)((2 * hp + 1) * 2 + 1) * 128 * 64, qB1, pB, l31, hh);
#pragma unroll
            for (int i = 0; i < 16; ++i) { const u32x2 sw = __builtin_amdgcn_permlane32_swap((unsigned)pA[i], (unsigned)pB[i], false, false); l2[i] = (int)sw.x; pB[i] = (int)sw.y; }
            merge_top16(l2, pB);
        }
        float f1[16], f2[16];
        unsigned i1p[4] = {0u, 0u, 0u, 0u}, i2p[4] = {0u, 0u, 0u, 0u};
#pragma unroll
        for (int i = 0; i < 16; ++i) {
            f1[i] = __int_as_float(l1[i] & ~0x7F); f2[i] = __int_as_float(l2[i] & ~0x7F) - 64.0f;
            i1p[i >> 2] |= (unsigned)(127 - (l1[i] & 0x7F)) << (8 * (i & 3));
            i2p[i >> 2] |= (unsigned)(127 - (l2[i] & 0x7F)) << (8 * (i & 3));
        }
        int cg[4][16];
#pragma unroll
        for (int gq = 0; gq < 4; ++gq)
#pragma unroll
            for (int i = 0; i < 16; ++i) cg[gq][i] = IMIN;
        {
            int n0 = 0, n1 = 0, n2 = 0, n3 = 0;
#pragma unroll
            for (int ca = 0; ca < 16; ++ca)
#pragma unroll
                for (int cb = 0; cb < 16; ++cb)
                    if ((ca + 1) * (cb + 1) <= 16) {
                        const int kc = (__float_as_int(f1[ca] + f2[cb]) & ~0xFF) | (255 - (ca * 16 + cb));
                        if (ca == 0) { cg[0][n0] = kc; ++n0; }
                        else if (ca <= 2) { cg[1][n1] = kc; ++n1; }
                        else if (ca <= 7) { cg[2][n2] = kc; ++n2; }
                        else { cg[3][n3] = kc; ++n3; }
                    }
        }
        bitonic_sort_desc16(cg[1]); bitonic_sort_desc16(cg[2]); bitonic_sort_desc16(cg[3]);
        merge_top16(cg[0], cg[1]); merge_top16(cg[2], cg[3]); merge_top16(cg[0], cg[2]);
        float tv[16]; int te[16];
#pragma unroll
        for (int rd = 0; rd < 16; ++rd) {
            const int mx = cg[0][rd];
            const int code = 255 - (mx & 0xFF), ca = code >> 4, cb = code & 15;
            const unsigned wa = (ca >> 2) == 0 ? i1p[0] : (ca >> 2) == 1 ? i1p[1] : (ca >> 2) == 2 ? i1p[2] : i1p[3];
            const unsigned wb = (cb >> 2) == 0 ? i2p[0] : (cb >> 2) == 1 ? i2p[1] : (cb >> 2) == 2 ? i2p[2] : i2p[3];
            const int i1 = (wa >> (8 * (ca & 3))) & 0xFF, i2 = (wb >> (8 * (cb & 3))) & 0xFF;
            te[rd] = i1 * 128 + i2;
            tv[rd] = __int_as_float(mx & ~0xFF);
        }
        {
            const float t0 = tv[0];
            float den = 0.f;
#pragma unroll
            for (int i = 0; i < 16; ++i) { tv[i] = __expf(tv[i] - t0); den += tv[i]; }
            const float rden = 1.0f / den;
#pragma unroll
            for (int i = 0; i < 16; ++i) tv[i] *= rden;
        }
        {
            int* ep = EIDX + (size_t)t * 128 + h * 16;
            float* gp = EG + (size_t)t * 128 + h * 16;
#pragma unroll
            for (int i = 0; i < 16; i += 4) {
                *(int __attribute__((ext_vector_type(4)))*)(ep + i) = (int __attribute__((ext_vector_type(4)))){te[i], te[i + 1], te[i + 2], te[i + 3]};
                *(f32x4*)(gp + i) = (f32x4){tv[i], tv[i + 1], tv[i + 2], tv[i + 3]};
            }
        }
    }
}

#define QCTR_WORD(ph, j) (3520 + ((ph) * 8 + (j)) * 16)
#define PEER_CHUNK_TOK 32
typedef __bf16 bf2_t __attribute__((ext_vector_type(2)));
__device__ __forceinline__ float dot2bf(unsigned a, unsigned b, float c) {
    union { unsigned u; bf2_t v; } x, y; x.u = a; y.u = b;
    return __builtin_amdgcn_fdot2_f32_bf16(x.v, y.v, c, false);
}
__device__ __forceinline__ float row16_sum(float v) { v = DPP_ROR_ADD(v, 8); v = DPP_ROR_ADD(v, 4); v = DPP_ROR_ADD(v, 2); v = DPP_ROR_ADD(v, 1); return v; }
__device__ __forceinline__ int queue_grab(unsigned* ctr, volatile int* slot) {
    __syncthreads();
    if (threadIdx.x == 0) *slot = (int)__hip_atomic_fetch_add(ctr, 1u, __ATOMIC_RELAXED, __HIP_MEMORY_SCOPE_AGENT);
    __syncthreads();
    return *slot;
}

#define DPP_ADD(v, ctrl) ((v) + __builtin_bit_cast(float, __builtin_amdgcn_update_dpp(0, __builtin_bit_cast(int, (v)), (ctrl), 0xf, 0xf, false)))
template <int WHICH>
__device__ __forceinline__ void phase_peer_sliced(const Args& a, unsigned char* lds, int qph, bool dry) {
    unsigned char* ws = a.ws;
    int tid_ = threadIdx.x; asm volatile("" : "+v"(tid_));
    const int tid = tid_, lane = tid & 63, c8 = lane & 7, g8 = lane >> 3;
    const int w = __builtin_amdgcn_readfirstlane(tid >> 6);
    const bf16_t* H2B = (const bf16_t*)(ws + WS_H2B);
    const int* EIDX = (const int*)(ws + WS_EIDX);
    const unsigned* W32 = (const unsigned*)(ws + WS_EG);
    float* PART = (float*)(ws + WS_PART);
    unsigned* bar = (unsigned*)(ws + WS_BAR);
    volatile int* slot = (volatile int*)(lds + LDS_BYTES - 32);
    const int myx = (int)(xb_xcc_id() & 7u);
    for (int qq = 0; qq < 8; ++qq) {
        const int j = (myx + qq) & 7;
        const unsigned char* TB = ws + (WHICH == 0 ? WS_UB : WS_VB) + (size_t)j * 16384 * 128;
        const unsigned lofs = (unsigned)c8 * 16u;
        for (;;) {
            int ch = 0;
            if (lane == 0) ch = (int)__hip_atomic_fetch_add(bar + QCTR_WORD(qph, j), 1u, __ATOMIC_RELAXED, __HIP_MEMORY_SCOPE_AGENT);
            ch = __builtin_amdgcn_readfirstlane(ch);
            if (ch >= T_TOK / (PEER_CHUNK_TOK / 4)) break;
            const int tbase = ch * (PEER_CHUNK_TOK / 4);
            constexpr int NTOK = PEER_CHUNK_TOK / 4;
            if (WHICH == 0) {
#define E1_ISSUE(ud_, esrc_) do { \
                    _Pragma("unroll") for (int i = 0; i < 8; ++i) { \
                        const int idx = __shfl(esrc_, 8 * i + g8); \
                        ud_[i] = *(const u32x4*)(TB + ((unsigned)idx * 128u + lofs)); } } while (0)
#define E1_DOT(ud_, res_) do { \
                    _Pragma("unroll") for (int i = 0; i < 8; ++i) { \
                        int d = __builtin_amdgcn_sdot4((int)ud_[i].x, hq[0], 0, false); \
                        d = __builtin_amdgcn_sdot4((int)ud_[i].y, hq[1], d, false); \
                        d = __builtin_amdgcn_sdot4((int)ud_[i].z, hq[2], d, false); \
                        d = __builtin_amdgcn_sdot4((int)ud_[i].w, hq[3], d, false); \
                        d += __builtin_amdgcn_update_dpp(0, d, 0xB1, 0xf, 0xf, false); \
                        d += __builtin_amdgcn_update_dpp(0, d, 0x4E, 0xf, 0xf, false); \
                        d += __builtin_amdgcn_update_dpp(0, d, 0x141, 0xf, 0xf, false); \
                        if (c8 == i) res_ = d; } } while (0)
                int e0 = EIDX[(size_t)tbase * 128 + lane], e1 = EIDX[(size_t)tbase * 128 + 64 + lane];
                const unsigned char* H2Q = ws + WS_H2Q;
                u32x4 h0 = *(const u32x4*)(H2Q + (size_t)tbase * 1024 + j * 128 + c8 * 16);
                u32x4 udA[8], udB[8];
                E1_ISSUE(udA, e0);
#pragma unroll 1
                for (int tt = 0; tt < NTOK; ++tt) {
                    const int t = tbase + tt;
                    E1_ISSUE(udB, e1);
                    const int hq[4] = {(int)h0.x, (int)h0.y, (int)h0.z, (int)h0.w};
                    if (tt + 1 < NTOK) {
                        e0 = EIDX[(size_t)(t + 1) * 128 + lane]; e1 = EIDX[(size_t)(t + 1) * 128 + 64 + lane];
                        h0 = *(const u32x4*)(H2Q + (size_t)(t + 1) * 1024 + j * 128 + c8 * 16);
                    }
                    int res0 = 0, res1 = 0;
                    E1_DOT(udA, res0);
                    if (tt + 1 < NTOK) E1_ISSUE(udA, e0);
                    E1_DOT(udB, res1);
                    int* pp = (int*)PART + ((size_t)j * T_TOK + t) * 128 + 8 * c8 + g8;
                    pp[0] = res0; pp[64] = res1;
                }
#undef E1_ISSUE
#undef E1_DOT
            } else {
#define E3_ISSUE(vd_, wk_, wsrc_) do { \
                    _Pragma("unroll") for (int i = 0; i < 8; ++i) { \
                        const unsigned pk = (unsigned)__shfl((int)(wsrc_), 8 * i + g8); \
                        wk_[i] = __uint_as_float(pk & 0xFFFF0000u); \
                        vd_[i] = *(const u32x4*)(TB + ((pk & 0xFFFFu) * 128u + lofs)); } } while (0)
#define E3_FMA(vd_, wk_) do { \
                    _Pragma("unroll") for (int i = 0; i < 8; ++i) { \
                        _Pragma("unroll") for (int q = 0; q < 4; ++q) { \
                            const f32x2 lo = __builtin_amdgcn_cvt_pk_f32_fp8((int)vd_[i][q], false), hi = __builtin_amdgcn_cvt_pk_f32_fp8((int)vd_[i][q], true); \
                            acc[4 * q] += wk_[i] * lo[0]; acc[4 * q + 1] += wk_[i] * lo[1]; acc[4 * q + 2] += wk_[i] * hi[0]; acc[4 * q + 3] += wk_[i] * hi[1]; } } } while (0)
                unsigned wa = W32[(size_t)tbase * 128 + lane], wb = W32[(size_t)tbase * 128 + 64 + lane];
                u32x4 vdA[8], vdB[8]; float wkA[8], wkB[8];
                E3_ISSUE(vdA, wkA, wa);
#pragma unroll 1
                for (int tt = 0; tt < NTOK; ++tt) {
                    const int t = tbase + tt;
                    E3_ISSUE(vdB, wkB, wb);
                    if (tt + 1 < NTOK) { wa = W32[(size_t)(t + 1) * 128 + lane]; wb = W32[(size_t)(t + 1) * 128 + 64 + lane]; }
                    u32x4 hr0, hr1;
                    if (!dry && g8 == 0) { const bf16_t* hp = H2B + (size_t)t * 1024 + j * 128 + c8 * 16; hr0 = *(const u32x4*)hp; hr1 = *(const u32x4*)(hp + 8); }
                    float acc[16];
#pragma unroll
                    for (int e = 0; e < 16; ++e) acc[e] = 0.f;
                    E3_FMA(vdA, wkA);
                    if (tt + 1 < NTOK) E3_ISSUE(vdA, wkA, wa);
                    E3_FMA(vdB, wkB);
#pragma unroll
                    for (int e = 0; e < 16; ++e) { acc[e] = DPP_ADD(acc[e], 0x128); acc[e] += __shfl_xor(acc[e], 16); acc[e] += __shfl_xor(acc[e], 32); }
                    if (dry) {
#pragma unroll
                        for (int e = 0; e < 16; ++e) asm volatile("" :: "v"(acc[e]));
                    } else if (g8 == 0) {
                        float* op = a.out + (size_t)t * 1024 + j * 128 + c8 * 16;
                        float v0[8], v1[8]; unpack8(hr0, v0); unpack8(hr1, v1);
#pragma unroll
                        for (int q = 0; q < 4; ++q) {
                            f32x4 oq;
#pragma unroll
                            for (int e = 0; e < 4; ++e) oq[e] = (q < 2 ? v0[4 * q + e] : v1[4 * (q - 2) + e]) + acc[4 * q + e] * (1.0f / V_SCALE);
                            *(f32x4*)(op + 4 * q) = oq;
                        }
                    }
                }
#undef E3_ISSUE
#undef E3_FMA
            }
        }
    }
}

__device__ __forceinline__ void phase_peer_weights(const Args& a) {
    unsigned char* ws = a.ws;
    float* EG = (float*)(ws + WS_EG);
    const int* EIDX = (const int*)(ws + WS_EIDX);
    const float* PART = (const float*)(ws + WS_PART);
    const float* RSTD2 = (const float*)(ws + WS_RSTD2);
    typedef int i32x4 __attribute__((ext_vector_type(4)));
    const float* USC = (const float*)(ws + WS_USCALE);
    for (size_t i = (size_t)blockIdx.x * NT + threadIdx.x; i < (size_t)T_TOK * 128 / 4; i += (size_t)gridDim.x * NT) {
        i32x4 s = *(const i32x4*)((const int*)PART + i * 4);
#pragma unroll
        for (int j = 1; j < 8; ++j) { const i32x4 p = *(const i32x4*)((const int*)PART + (size_t)j * T_TOK * 128 + i * 4); s[0] += p[0]; s[1] += p[1]; s[2] += p[2]; s[3] += p[3]; }
        const f32x4 gq = *(const f32x4*)(EG + i * 4);
        const i32x4 ev = *(const i32x4*)(EIDX + i * 4);
        const float rs2 = RSTD2[(i * 4) >> 7];
        u32x4 o;
#pragma unroll
        for (int e = 0; e < 4; ++e) {
            const float z = (float)s[e] * USC[ev[e]] * (H2Q_CLIP / 127.0f) * rs2;
            o[e] = (f2bf(gq[e] * gelu_tanh(z)) << 16) | (unsigned)ev[e];
        }
        *(u32x4*)(EG + i * 4) = o;
    }
}

__device__ __forceinline__ void phase_mixnorm(const Args& a) {
    unsigned char* ws = a.ws;
    const int tid = threadIdx.x, lane = tid & 63, w = tid >> 6;
    const int gw = blockIdx.x * NWV + w, nw = gridDim.x * NWV;
    bf16_t* O = (bf16_t*)(ws + WS_OMIX);
    for (int t = gw; t < T_TOK; t += nw) {
        bf16_t* row = O + (size_t)t * 1024 + lane * 8;
        float x[8], y[8];
        unpack8(*(const u32x4*)row, x);
        float s1 = 0.f, s2 = 0.f;
#pragma unroll
        for (int e = 0; e < 8; ++e) s1 += x[e] * x[e];
        s1 = wave_sum(s1);
        const float r1 = rsqrtf(s1 * (1.0f / 512.0f) + EPSN);
#pragma unroll
        for (int e = 0; e < 8; ++e) x[e] *= r1;
        *(u32x4*)row = pack8(x);
#if STAGE >= 2
        unpack8(*(const u32x4*)(row + 512), y);
#pragma unroll
        for (int e = 0; e < 8; ++e) s2 += y[e] * y[e];
        s2 = wave_sum(s2);
        const float r2 = rsqrtf(s2 * (1.0f / 512.0f) + EPSN);
#pragma unroll
        for (int e = 0; e < 8; ++e) y[e] *= r2;
#else
#pragma unroll
        for (int e = 0; e < 8; ++e) y[e] = 0.f;
        (void)s2;
#endif
        *(u32x4*)(row + 512) = pack8(y);
    }
}

#define N_PHASES 17
__global__ void __launch_bounds__(NT, 2) mega(Args a) {
    extern __shared__ __attribute__((aligned(16))) unsigned char lds[];
    unsigned char* ws = a.ws;
    const int tid = threadIdx.x;
    const int G = gridDim.x, bid = blockIdx.x;
    volatile unsigned* bst = (volatile unsigned*)(lds + LDS_BYTES - 16);
    XcdBarrier bar; bar.bar = (unsigned*)(ws + WS_BAR); bar.x = 0; bar.st = bst;
    const bool multi = (a.ph_hi - a.ph_lo) > 1;
    if (multi) {
        if (tid == 0) { bst[0] = 0u; bst[1] = 0u; }
        __syncthreads();
        bar = xcd_barrier_post((unsigned*)(ws + WS_BAR), bst);
    }
#define PH(k) (a.ph_lo <= (k) && (k) < a.ph_hi)
#define SEAM(k) do { if (PH(k) && PH((k) + 1)) { xcd_barrier(bar); if ((PROBE_MASK >> 22) & 1) { xcd_barrier(bar); xcd_barrier(bar); } } } while (0)
#define GEMM_BITS ((1 << 1) | (1 << 8) | (1 << 9) | (1 << 12))
#define PMASK2 (PROBE_MASK & ~GEMM_BITS & 0xFFFFF)
#define TREP(k) (1 + ((PROBE_MASK >> (k)) & 1))
#define FOR_TILES_XCD(nM, nN, m_, n_) for (int L_ = (bid >> 3); L_ < ((nM) >> 3) * (nN); L_ += (G >> 3)) { const int m_ = (bid & 7) + 8 * (L_ / (nN)); const int n_ = L_ % (nN);
#define PHREP(k) if (PH(k)) for (int rep_ = 0; rep_ <= ((PMASK2 >> (k)) & 1); ++rep_) if (rep_ ? (xcd_barrier(bar), true) : true)
#define LASTREP(k) (rep_ == ((PMASK2 >> (k)) & 1))

    PHREP(0) phase_prep(a, lds);
    SEAM(0);
    PHREP(1) {
        Epi8InProj e1{(const float*)(ws + WS_RSTD0), (bf16_t*)(ws + WS_P), (bf16_t*)(ws + WS_QN), (bf16_t*)(ws + WS_KS), (bf16_t*)(ws + WS_KW),
                     (bf16_t*)(ws + WS_KCIN), (bf16_t*)(ws + WS_VCIN), (float*)(ws + WS_GATE), (const f32x2*)(ws + WS_ROPEN), a.in[9], a.in[10], (float*)(ws + WS_CSSQ)};
        for (int rp = 0; rp < TREP(1); ++rp) {
            gemm8((const bf16_t*)(ws + WS_XB), 1024, (const bf16_t*)(ws + WS_WIN), 1024, 1024, 256, 7, e1, lds);
        }
        if (bid == G - 1 && tid < 256) {
            float s = 0.f;
            const float* bp = (const float*)(ws + WS_BIASP);
            const int kv = tid >> 7, j = tid & 127;
            for (int i = 0; i < 32; ++i) s += bp[(kv * 32 + i) * 128 + j];
            ((float*)(ws + WS_BIAS1))[tid] = s;
        }
    }
    SEAM(1);
    PHREP(3) {
        Epi8QUp eq{(bf16_t*)(ws + WS_QMRAW), 768, (const float*)(ws + WS_CSSQ)};
        Epi8KvUp ek{(const float*)(ws + WS_CSSQ), (const bf16_t*)(ws + WS_P), (const f32x2*)(ws + WS_ROPEM), a.in[8] + 96, (bf16_t*)(ws + WS_KM), (bf16_t*)(ws + WS_KVRAW)};
#if STAGE >= 2
        for (int it = bid; it < 256; it += G) {
            const int kv = it >> 7, mi = (it >> 2) & 31, ksl = it & 3;
            EpiF32 ep{(float*)(ws + WS_PARTC) + ((size_t)(ksl * 2 + kv) * 8192) * 128, 128, 128};
            gemm_tile<false>((const bf16_t*)(ws + (kv ? WS_VCIN : WS_KCIN)) + ksl * 512, 1024, (const bf16_t*)(ws + WS_W1C) + (size_t)kv * 128 * 2048 + ksl * 512, 2048, 512, mi * 256, 0, ep, lds);
        }
#endif
        gemm8((const bf16_t*)(ws + WS_P) + C_CQ, PLD, (const bf16_t*)(ws + WS_WUQ), 256, 256, 256, 3, eq, lds);
        gemm8((const bf16_t*)(ws + WS_P) + C_CKV, PLD, (const bf16_t*)(ws + WS_WUKV), 128, 128, 256, 4, ek, lds);
#if STAGE >= 2
        for (int id0 = 2 * bid; id0 < 2 * 32 * 64; id0 += 2 * G) {
            const int idr = id0 + (tid >> 8); const bool ok = idr < 2 * 32 * 64; const int id = ok ? idr : 0;
            const int which = id >> 11, bg = (id >> 6) & 31, st = id & 63, b = bg >> 1, g = bg & 1;
            const bf16_t* src = (const bf16_t*)(ws + WS_P) + ((size_t)b * SEQ + st * 64) * PLD + (which ? C_VW : C_VS) + g * 64;
            bf16_t* dst = (bf16_t*)(ws + (which ? WS_VWT : WS_VST)) + (size_t)bg * 64 * SEQ + st * 64;
            tr_tile(src, PLD, dst, SEQ, (bf16_t*)lds, ok);
        }
#endif
    }
    SEAM(3);
    PHREP(4) {
        const bool xa_wg = G > 64 && bid < 64;
        const int vb = G > 64 ? bid - 64 : bid, VG = G > 64 ? G - 64 : G;
#if STAGE >= 3
        {
            Epi8RowScaleBf16 e2{(bf16_t*)(ws + WS_KVX), 1024, (const float*)(ws + WS_RSTDMEM)};
            if (G > 64) gemm8((const bf16_t*)(ws + WS_MEMB), 1024, (const bf16_t*)(ws + WS_WXKV), 1024, 1024, 16, 4, e2, lds);
            else { EpiRowScaleBf16 e2o{(bf16_t*)(ws + WS_KVX), 1024, (const float*)(ws + WS_RSTDMEM), 1024}; gemm_tiles_xcd<false>((const bf16_t*)(ws + WS_MEMB), 1024, (const bf16_t*)(ws + WS_WXKV), 1024, 1024, 16, 4, e2o, lds); }
        }
#endif
        if (!xa_wg) for (int id0 = 2 * vb; id0 < 128 * 64; id0 += 2 * VG) {
            const int idr = id0 + (tid >> 8); const bool ok = idr < 128 * 64; const int id = ok ? idr : 0;
            const int bh = id >> 6, st = id & 63, b = bh >> 3, h = bh & 7;
            const bf16_t* src = (const bf16_t*)(ws + WS_KVRAW) + ((size_t)b * SEQ + st * 64) * 1024 + h * 128 + 64;
            bf16_t* dst = (bf16_t*)(ws + WS_VMT) + (size_t)bh * 64 * SEQ + st * 64;
            tr_tile(src, 1024, dst, SEQ, (bf16_t*)lds, ok);
        }
#if STAGE >= 2
        if (!xa_wg) for (int i = vb * NT + tid; i < 2 * 8192 * 128 / 4; i += VG * NT) {
            const float* pp = (const float*)(ws + WS_PARTC) + (size_t)i * 4;
            f32x4 s = *(const f32x4*)pp;
#pragma unroll
            for (int k = 1; k < 4; ++k) { const f32x4 p = *(const f32x4*)(pp + (size_t)k * 2 * 8192 * 128); s[0] += p[0]; s[1] += p[1]; s[2] += p[2]; s[3] += p[3]; }
            const int kv = i >> 18, col = (i * 4) & 127;
            const f32x4 bq = *(const f32x4*)((const float*)(ws + WS_BIAS1) + kv * 128 + col);
            float v[4];
#pragma unroll
            for (int e = 0; e < 4; ++e) v[e] = gelu_tanh(s[e] + bq[e]);
            *(u32x2*)((bf16_t*)(ws + WS_HID) + (size_t)i * 4) = pack4(v);
        }
#endif
    }
    SEAM(4);
#if STAGE >= 2
    PHREP(5) {
#if STAGE >= 3
        {
            const bool cmp_wg = G > 64 && bid < 64;
            const int vb = G > 64 ? bid - 64 : bid, VG = G > 64 ? G - 64 : G;
            if (!cmp_wg) {
                phase_xa_k(a, vb, VG);
                for (int id0 = 2 * vb; id0 < 16 * 4 * 8; id0 += 2 * VG) {
                    const int idr = id0 + (tid >> 8); const bool ok = idr < 16 * 4 * 8; const int id = ok ? idr : 0;
                    const int b = id >> 5, mt = (id >> 3) & 3, ct = id & 7;
                    const bf16_t* src = (const bf16_t*)(ws + WS_KVX) + ((size_t)b * 256 + mt * 64) * 1024 + 512 + ct * 64;
                    bf16_t* dst = (bf16_t*)(ws + WS_VXT) + ((size_t)b * 512 + ct * 64) * 256 + mt * 64;
                    tr_tile(src, 1024, dst, 256, (bf16_t*)lds, ok);
                }
            }
        }
#endif
        for (int it = bid; it < 64; it += G) {
            const int kv = it >> 5, mi = it & 31;
            EpiCmpFin ec{kv, (const f32x2*)(ws + WS_ROPEN), a.in[10], (bf16_t*)(ws + WS_KC), (bf16_t*)(ws + WS_VCT)};
            gemm_tile<false>((const bf16_t*)(ws + WS_HID) + (size_t)kv * 8192 * 128, 128, (const bf16_t*)(ws + WS_W2C) + (size_t)kv * 128 * 128, 128, 128, mi * 256, 0, ec, lds);
        }
    }
#endif
    SEAM(5);
    PHREP(6) {
        if (G == 256) {
            const int x = bid & 7, r = bid >> 3;
            for (int rp = 0; rp < TREP(20); ++rp)
                for (int i = 0; i < 8; ++i) {
                    const int bh = x + 8 * (2 * i + (r >> 4));
                    const int qt = (i & 1) ? 15 - (r & 15) : (r & 15);
                    mla_unit(a, bh >> 3, bh & 7, qt, lds);
                }
#if STAGE >= 2
            for (int rp = 0; rp < TREP(21); ++rp)
                for (int i = 0; i < 8; ++i) {
                    const int bg = x + 8 * (i >> 1);
                    const int jq = (i & 1) ? 63 - r : r;
                    nsa_unit(a, bg >> 1, bg & 1, jq, lds);
                }
#endif
        } else {
            for (int u = bid; u < 2048; u += G) {
                const int qt = 15 - (u >> 7), bh = u & 127;
                mla_unit(a, bh >> 3, bh & 7, qt, lds);
            }
#if STAGE >= 2
            for (int u = bid; u < 2048; u += G) {
                const int jq = 63 - (u >> 5), bg = u & 31;
                nsa_unit(a, bg >> 1, bg & 1, jq, lds);
            }
#endif
        }
    }
    SEAM(6);
    PHREP(8) {
        Epi8ResBf16S er{(const bf16_t*)(ws + WS_XB), (bf16_t*)(ws + WS_H1B), (float*)(ws + WS_H1SSQ)};
        for (int rp = 0; rp < TREP(8); ++rp) {
            gemm8<Epi8ResBf16S, true>((const bf16_t*)(ws + WS_OMIX), 1024, (const bf16_t*)(ws + WS_WOUT), 1024, 1024, 256, 4, er, lds, (const float*)(ws + WS_SSQ)); }
    }
    SEAM(8);
#if STAGE >= 3
    PHREP(9) {
        Epi8RssScaleBf16 eq{(bf16_t*)(ws + WS_QX), 512, (const float*)(ws + WS_H1SSQ), nullptr};
        for (int rp = 0; rp < TREP(9); ++rp) {
            gemm8((const bf16_t*)(ws + WS_H1B), 1024, (const bf16_t*)(ws + WS_WXQ), 1024, 1024, 256, 2, eq, lds); }
    }
    SEAM(9);
    PHREP(10) {
        for (int u = bid; u < 1024; u += G) xa_unit(a, u >> 6, (u >> 4) & 3, u & 15, lds);
    }
    SEAM(10);
    PHREP(11) {
        Epi8ResBf16Q er{(const bf16_t*)(ws + WS_H1B), (bf16_t*)(ws + WS_H2B), (unsigned*)(ws + WS_H2Q), (float*)(ws + WS_H2SSQ)};
        gemm8(( const bf16_t*)(ws + WS_OX), 512, (const bf16_t*)(ws + WS_WXO), 512, 512, 256, 4, er, lds);
    }
    SEAM(11);
#endif
#if STAGE >= 4
    PHREP(12) {
        Epi8RssScaleBf16 eq{(bf16_t*)(ws + WS_QP), 1024, (const float*)(ws + WS_H2SSQ), (float*)(ws + WS_RSTD2)};
        for (int rp = 0; rp < TREP(12); ++rp) {
            gemm8((const bf16_t*)(ws + WS_H2B), 1024, (const bf16_t*)(ws + WS_WPQ), 1024, 1024, 256, 4, eq, lds); }
    }
    SEAM(12);
    PHREP(13) phase_peer_route(a);
    SEAM(13);
    PHREP(14) phase_peer_sliced<0>(a, lds, rep_, false);
    SEAM(14);
    PHREP(15) phase_peer_weights(a);
    SEAM(15);
    PHREP(16) phase_peer_sliced<1>(a, lds, 2 + rep_, !LASTREP(16));
#endif
#undef PH
#undef SEAM
}

extern "C" void kernel_launch(void* const* d_in, const int* in_sizes, int n_in, void* d_out, int out_size, void* d_ws, size_t ws_size, hipStream_t stream) {
    static int grid = 0;
    if (grid == 0) {
        if (n_in != 27 || ws_size < WS_END) { fprintf(stderr, "kernel_launch: unexpected n_in %d or ws_size %zu (< %zu)\n", n_in, ws_size, (size_t)WS_END); grid = -1; return; }
        int dev = 0, cus = 0, per_cu = 0;
        hipGetDevice(&dev);
        hipDeviceGetAttribute(&cus, hipDeviceAttributeMultiprocessorCount, dev);
        hipFuncSetAttribute((const void*)mega, hipFuncAttributeMaxDynamicSharedMemorySize, LDS_BYTES);
        if (hipOccupancyMaxActiveBlocksPerMultiprocessor(&per_cu, (const void*)mega, NT, LDS_BYTES) != hipSuccess || per_cu < 1) per_cu = 1;
        (void)hipGetLastError();
        if (per_cu > 1) per_cu = 1;
        grid = cus * per_cu;
    }
    if (grid < 0) return;
    hipMemsetAsync((unsigned char*)d_ws + WS_BAR, 0, 16384, stream);
    Args a{};
    for (int i = 0; i < 27; ++i) a.in[i] = (const float*)d_in[i];
    a.out = (float*)d_out; a.ws = (unsigned char*)d_ws;
#if ONE_LAUNCH
    a.ph_lo = 0; a.ph_hi = N_PHASES;
    hipLaunchKernelGGL(mega, dim3(grid), dim3(NT), LDS_BYTES, stream, a);
#else
    for (int p = 0; p < N_PHASES; ++p) {
        a.ph_lo = p; a.ph_hi = p + 1;
        hipLaunchKernelGGL(mega, dim3(grid), dim3(NT), LDS_BYTES, stream, a);
    }
#endif
}
```

```cpp
#include <hip/hip_runtime.h>
#include <cstdio>
#include <cstdint>

#ifndef STAGE
#define STAGE 4
#endif
#ifndef ONE_LAUNCH
#define ONE_LAUNCH 1
#endif
#ifndef PROBE_MASK
#define PROBE_MASK 0
#endif

typedef unsigned short bf16_t;
typedef short bf16x8 __attribute__((ext_vector_type(8)));
typedef float f32x16 __attribute__((ext_vector_type(16)));
typedef float f32x4 __attribute__((ext_vector_type(4)));
typedef float f32x2 __attribute__((ext_vector_type(2)));
typedef unsigned u32x4 __attribute__((ext_vector_type(4)));
typedef unsigned u32x2 __attribute__((ext_vector_type(2)));

#define T_TOK 65536
#define SEQ 4096
#define NBATCH 16
#define DM 1024
#define INC 1720
#define PLD 1728
#define INP 1792
#define C_CQ 1280
#define C_CKV 1536
#define C_KPE 1664
#define C_QN 416
#define C_KC 928
#define C_VC 1056
#define C_KS 1184
#define C_VS 1024
#define C_KW 1440
#define C_VW 1152
#define C_GATE 1696
#define EPSN 1e-6f
#define LOG2E 1.4426950408889634f

#define MIB (1024ull * 1024ull)
constexpr size_t WS_R1   = 0;
constexpr size_t WS_R2   = WS_R1 + 128 * MIB;
constexpr size_t WS_R3   = WS_R2 + 216 * MIB;
constexpr size_t WS_R4   = WS_R3 + 96 * MIB;
constexpr size_t WS_R5   = WS_R4 + 128 * MIB;
constexpr size_t WS_R6   = WS_R5 + 96 * MIB;
constexpr size_t WS_R7   = WS_R6 + 64 * MIB;
constexpr size_t WS_KS   = WS_R7 + 64 * MIB;
constexpr size_t WS_KW   = WS_KS + 16 * MIB;
constexpr size_t WS_VST  = WS_KW + 16 * MIB;
constexpr size_t WS_VWT  = WS_VST + 16 * MIB;
constexpr size_t WS_KCIN = WS_VWT + 16 * MIB;
constexpr size_t WS_VCIN = WS_KCIN + 16 * MIB;
constexpr size_t WS_PAD0 = WS_VCIN + 16 * MIB;
constexpr size_t WS_HID  = WS_PAD0 + 65536;
constexpr size_t WS_CRAW = WS_HID + 4 * MIB;
constexpr size_t WS_KC   = WS_CRAW + 4 * MIB;
constexpr size_t WS_VCT  = WS_KC + 1 * MIB;
constexpr size_t WS_GATE = WS_VCT + 1 * MIB;
constexpr size_t WS_RSTD0 = WS_GATE + 6 * MIB;
constexpr size_t WS_RSTDCQ = WS_RSTD0 + 262144;
constexpr size_t WS_RSTDCKV = WS_RSTDCQ + 262144;
constexpr size_t WS_RSTD2 = WS_RSTDCKV + 262144;
constexpr size_t WS_RSTDMEM = WS_RSTD2 + 262144;
constexpr size_t WS_UB   = WS_RSTDMEM + 16384;
constexpr size_t WS_VB   = WS_UB + 16 * MIB;
constexpr size_t WS_PARTC = WS_UB + 32 * MIB;
constexpr size_t WS_WIN  = WS_UB + 64 * MIB;
constexpr size_t WS_WUQ  = WS_WIN + 1792 * 1024 * 2;
constexpr size_t WS_WUKV = WS_WUQ + 768 * 256 * 2;
constexpr size_t WS_W1C  = WS_WUKV + 1024 * 128 * 2;
constexpr size_t WS_W2C  = WS_W1C + 2 * 128 * 2048 * 2;
constexpr size_t WS_WOUT = WS_W2C + 2 * 128 * 128 * 2;
constexpr size_t WS_WXQ  = WS_WOUT + 2 * MIB;
constexpr size_t WS_WXKV = WS_WXQ + 1 * MIB;
constexpr size_t WS_WXO  = WS_WXKV + 2 * MIB;
constexpr size_t WS_WPQ  = WS_WXO + 1 * MIB;
constexpr size_t WS_KP   = WS_WPQ + 2 * MIB;
constexpr size_t WS_MEMB = WS_KP + 262144;
constexpr size_t WS_KVX  = WS_MEMB + 8 * MIB;
constexpr size_t WS_KX   = WS_KVX + 8 * MIB;
constexpr size_t WS_VXT  = WS_KX + 4 * MIB;
constexpr size_t WS_ROPEM = WS_VXT + 4 * MIB;
constexpr size_t WS_ROPEN = WS_ROPEM + 524288;
constexpr size_t WS_BIASP = WS_ROPEN + 262144;
constexpr size_t WS_BIAS1 = WS_BIASP + 32768;
constexpr size_t WS_BAR  = WS_BIAS1 + 1024;
constexpr size_t WS_END  = WS_BAR + 16384;
constexpr size_t WS_XB = WS_R1, WS_H1B = WS_R1;
constexpr size_t WS_P = WS_R2, WS_OMIX = WS_R2, WS_QP = WS_R2, WS_QX = WS_R2 + 128 * MIB;
constexpr size_t WS_QMRAW = WS_R3, WS_OX = WS_R3;
constexpr size_t WS_KVRAW = WS_R4, WS_H2B = WS_R4;
constexpr size_t WS_KM = WS_R5, WS_EIDX = WS_R5, WS_EG = WS_R5 + 32 * MIB;
constexpr size_t WS_VMT = WS_R6, WS_QN = WS_R7;
constexpr size_t WS_SSQ = WS_CRAW;
constexpr size_t WS_WF8 = WS_R6;
#define WF8_SCALE 64.0f
constexpr size_t WS_VSCALE = WS_RSTDCKV;
constexpr size_t WS_USCALE = WS_RSTDCQ;
constexpr size_t WS_H2Q = WS_R6;
constexpr size_t WS_H2SSQ = WS_GATE;
constexpr size_t WS_H1SSQ = WS_HID;
constexpr size_t WS_CSSQ = WS_R6;
constexpr size_t WS_PART = WS_R2;

#define NT 512
#define NWV 8
#define LDS_BYTES 151552

__device__ __forceinline__ unsigned f2bf(float f) { unsigned u = __float_as_uint(f); u += 0x7FFFu + ((u >> 16) & 1u); return u >> 16; }
typedef __bf16 bf2n_t __attribute__((ext_vector_type(2)));
__device__ __forceinline__ unsigned pack2(float lo, float hi) { bf2n_t v; v[0] = (__bf16)lo; v[1] = (__bf16)hi; return __builtin_bit_cast(unsigned, v); }
__device__ __forceinline__ float bflo(unsigned w) { return __uint_as_float(w << 16); }
__device__ __forceinline__ float bfhi(unsigned w) { return __uint_as_float(w & 0xFFFF0000u); }
__device__ __forceinline__ float bf2f(bf16_t b) { return __uint_as_float(((unsigned)b) << 16); }
__device__ __forceinline__ void unpack8(const u32x4& r, float (&v)[8]) {
    v[0] = bflo(r.x); v[1] = bfhi(r.x); v[2] = bflo(r.y); v[3] = bfhi(r.y);
    v[4] = bflo(r.z); v[5] = bfhi(r.z); v[6] = bflo(r.w); v[7] = bfhi(r.w);
}
__device__ __forceinline__ u32x4 pack8(const float (&v)[8]) {
    u32x4 r; r.x = pack2(v[0], v[1]); r.y = pack2(v[2], v[3]); r.z = pack2(v[4], v[5]); r.w = pack2(v[6], v[7]); return r;
}
__device__ __forceinline__ int kap(int p) { return (p & ~0xC) | ((p & 4) << 1) | ((p & 8) >> 1); }
__device__ __forceinline__ float wave_sum(float v) {
    v += __shfl_xor(v, 32); v += __shfl_xor(v, 16); v += __shfl_xor(v, 8); v += __shfl_xor(v, 4); v += __shfl_xor(v, 2); v += __shfl_xor(v, 1); return v;
}
__device__ __forceinline__ float gelu_tanh(float x) {
    const float u = 0.7978845608028654f * (x + 0.044715f * x * x * x);
    const float e = __expf(2.0f * u);
    const float t = 1.0f - 2.0f / (e + 1.0f);
    return 0.5f * x * (1.0f + t);
}
__device__ __forceinline__ bf16x8 as_bf16x8(const u32x4& r) { union { u32x4 u; bf16x8 b; } c; c.u = r; return c.b; }
#define DPP_ROR_ADD(v, n) ((v) + __builtin_bit_cast(float, __builtin_amdgcn_update_dpp(0, __builtin_bit_cast(int, (v)), 0x120 + (n), 0xf, 0xf, false)))
#define MFMA32(a, b, c) __builtin_amdgcn_mfma_f32_32x32x16_bf16((a), (b), (c), 0, 0, 0)

struct Args {
    const float* in[27];
    float* out;
    unsigned char* ws;
    int ph_lo, ph_hi;
};

#define XB_TMO      128
#define XB_XCNT(j)  (256  + 64 * (j))
#define XB_XSUB(j)  (1280 + 64 * (j))
#define XB_XGEN(j)  (2304 + 64 * (j))
#define XB_TOP      3328
#define XB_TOPGEN   3392
#define XCD_BAR_WORDS 3456
#define XB_SPIN_CAP (1u << 22)
#define LAS __attribute__((address_space(3)))
__device__ __forceinline__ unsigned xb_ld(unsigned* p)              { return __hip_atomic_load(p, __ATOMIC_RELAXED, __HIP_MEMORY_SCOPE_AGENT); }
__device__ __forceinline__ unsigned xb_add(unsigned* p, unsigned v) { return __hip_atomic_fetch_add(p, v, __ATOMIC_RELAXED, __HIP_MEMORY_SCOPE_AGENT); }
__device__ __forceinline__ unsigned xb_xcc_id() { return (unsigned)__builtin_amdgcn_s_getreg((3 << 11) | 20) & 0xFu; }
#define XB_SPIN(cond, bar) do { unsigned _sp = 0; while (cond) { __builtin_amdgcn_s_sleep(1); \
    if ((++_sp & 255u) == 0u) { if (xb_ld(&(bar)[XB_TMO])) break; if (_sp > XB_SPIN_CAP) { atomicAdd(&(bar)[XB_TMO], 1u); break; } } } } while (0)
struct XcdBarrier { unsigned* bar; unsigned x; volatile unsigned* st; };
__device__ __forceinline__ XcdBarrier xcd_barrier_post(unsigned* bar, volatile unsigned* st) {
    XcdBarrier b; b.bar = bar; b.x = xb_xcc_id(); b.st = st;
    if (threadIdx.x == 0) (void)xb_add(&bar[XB_XCNT(b.x)], 1u);
    return b;
}
__device__ __forceinline__ void xcd_barrier_complete(unsigned* bar, unsigned x, unsigned& nloc, unsigned& nx) {
    const unsigned G = gridDim.x;
    unsigned sum, cnt, mine, sp = 0u;
    for (;;) {
        sum = 0u; cnt = 0u; mine = 0u;
#pragma unroll
        for (unsigned j = 0; j < 16; ++j) { const unsigned c = xb_ld(&bar[XB_XCNT(j)]); sum += c; cnt += (c > 0u) ? 1u : 0u; mine = (j == x) ? c : mine; }
        if (sum == G) break;
        __builtin_amdgcn_s_sleep(1);
        if ((++sp & 255u) == 0u) { if (xb_ld(&bar[XB_TMO])) break; if (sp > XB_SPIN_CAP) { atomicAdd(&bar[XB_TMO], 1u); break; } }
    }
    nloc = mine > 0u ? mine : 1u; nx = cnt > 0u ? cnt : 1u;
}
__device__ __forceinline__ void xcd_barrier(const XcdBarrier& b) {
    asm volatile("s_waitcnt vmcnt(0)" ::: "memory");
    __syncthreads();
    if (threadIdx.x == 0) {
        unsigned* bar = b.bar;
        __builtin_amdgcn_s_waitcnt(0);
        unsigned nloc = b.st[0], nx = b.st[1];
        if (nloc == 0u) { xcd_barrier_complete(bar, b.x, nloc, nx); b.st[0] = nloc; b.st[1] = nx; }
        const unsigned old = xb_add(&bar[XB_XSUB(b.x)], 1u);
        const unsigned gen = old / nloc;
        if (old + 1u == (gen + 1u) * nloc) {
            __builtin_amdgcn_fence(__ATOMIC_RELEASE, "agent");
            asm volatile("s_waitcnt vmcnt(0)" ::: "memory");
            const unsigned og = xb_add(&bar[XB_TOP], 1u);
            const unsigned tg = og / nx;
            if (og + 1u == (tg + 1u) * nx) xb_add(&bar[XB_TOPGEN], 1u);
            else XB_SPIN(xb_ld(&bar[XB_TOPGEN]) == tg, bar);
            __builtin_amdgcn_fence(__ATOMIC_ACQUIRE, "agent");
            xb_add(&bar[XB_XGEN(b.x)], 1u);
            asm volatile("s_waitcnt vmcnt(0)" ::: "memory");
        } else {
            XB_SPIN(xb_ld(&bar[XB_XGEN(b.x)]) == gen, bar);
            __builtin_amdgcn_fence(__ATOMIC_ACQUIRE, "agent");
            asm volatile("s_waitcnt vmcnt(0)" ::: "memory");
        }
    }
    __syncthreads();
}

#define GEMM_XBYTES 36864
#define GEMM_STAGE_BYTES 73728
#define GEMM_MISC_OFF 147456
template <bool ROWSS, class Epi, bool MIXN = false>
__device__ __forceinline__ void gemm_tile(const bf16_t* __restrict__ A, int lda, const bf16_t* __restrict__ Bt, int ldb, int K,
                                          int m0, int n0, Epi& epi, unsigned char* lds, const float* __restrict__ ssq16 = nullptr) {
    int tid_ = threadIdx.x; asm volatile("" : "+v"(tid_));
    const int tid = tid_, lane = tid & 63, w = tid >> 6;
    const int wm = w & 1, wn = w >> 1, l31 = lane & 31, hh = lane >> 5;
    const int lrow = tid >> 3, lc = tid & 7;
    const bf16_t* ag = A + (size_t)(m0 + lrow) * lda + lc * 8;
    const bf16_t* bg = Bt + (size_t)(n0 + lrow) * ldb + lc * 8;
    u32x4 ra[4], rb[4];
    f32x16 acc[2][4];
#pragma unroll
    for (int i = 0; i < 2; ++i)
#pragma unroll
        for (int j = 0; j < 4; ++j)
#pragma unroll
            for (int r = 0; r < 16; ++r) acc[i][j][r] = 0.f;
    float ssq[4] = {0.f, 0.f, 0.f, 0.f};
    const int nk = K >> 6;
#pragma unroll
    for (int i = 0; i < 4; ++i) { ra[i] = *(const u32x4*)(ag + (size_t)i * 64 * lda); rb[i] = *(const u32x4*)(bg + (size_t)i * 64 * ldb); }
    float* rs = (float*)(lds + GEMM_MISC_OFF);
    float* rtab = (float*)(lds + GEMM_MISC_OFF + 1024);
    __syncthreads();
#define GEMM_STORE(stage_) do { \
        unsigned char* sb_ = lds + (stage_) * GEMM_STAGE_BYTES; \
        _Pragma("unroll") for (int i_ = 0; i_ < 4; ++i_) { \
            *(u32x4*)(sb_ + (lrow + 64 * i_) * 144 + lc * 16) = ra[i_]; \
            *(u32x4*)(sb_ + GEMM_XBYTES + (lrow + 64 * i_) * 144 + lc * 16) = rb[i_]; } \
        if (ROWSS) { _Pragma("unroll") for (int i_ = 0; i_ < 4; ++i_) { float v_[8]; unpack8(ra[i_], v_); \
            _Pragma("unroll") for (int e_ = 0; e_ < 8; ++e_) ssq[i_] += v_[e_] * v_[e_]; } } } while (0)
    GEMM_STORE(0);
    if (MIXN && tid < 256) {
        const float* sp = ssq16 + (size_t)(m0 + tid) * 16;
        const f32x4 a0 = *(const f32x4*)sp, a1 = *(const f32x4*)(sp + 4), b0 = *(const f32x4*)(sp + 8), b1 = *(const f32x4*)(sp + 12);
        const float s1 = ((a0[0] + a0[1]) + (a0[2] + a0[3])) + ((a1[0] + a1[1]) + (a1[2] + a1[3]));
        const float s2 = ((b0[0] + b0[1]) + (b0[2] + b0[3])) + ((b1[0] + b1[1]) + (b1[2] + b1[3]));
        const float r1 = rsqrtf(s1 * (1.0f / 512.0f) + EPSN), r2 = rsqrtf(s2 * (1.0f / 512.0f) + EPSN);
        rtab[tid] = r1 / r2; rtab[256 + tid] = r2;
    }
    __syncthreads();
    const int xoff = (wm * 128 + l31) * 144 + hh * 16;
    const int woff = GEMM_XBYTES + (wn * 64 + kap(l31)) * 144 + hh * 16;
#pragma unroll 1
    for (int kt = 0; kt < nk; ++kt) {
        const bool more = kt + 1 < nk;
        if (more) {
#pragma unroll
            for (int i = 0; i < 4; ++i) { ra[i] = *(const u32x4*)(ag + (size_t)i * 64 * lda + (kt + 1) * 64); rb[i] = *(const u32x4*)(bg + (size_t)i * 64 * ldb + (kt + 1) * 64); }
        }
        if (MIXN && kt == (nk >> 1)) {
#pragma unroll
            for (int mt = 0; mt < 4; ++mt) {
                const float f = rtab[wm * 128 + mt * 32 + l31];
#pragma unroll
                for (int nf = 0; nf < 2; ++nf)
#pragma unroll
                    for (int r = 0; r < 16; ++r) acc[nf][mt][r] *= f;
            }
        }
        const unsigned char* st = lds + (kt & 1) * GEMM_STAGE_BYTES;
#pragma unroll
        for (int ks = 0; ks < 4; ++ks) {
            bf16x8 xf[4], wf[2];
#pragma unroll
            for (int mt = 0; mt < 4; ++mt) xf[mt] = as_bf16x8(*(const u32x4*)(st + xoff + mt * 32 * 144 + ks * 32));
#pragma unroll
            for (int nf = 0; nf < 2; ++nf) wf[nf] = as_bf16x8(*(const u32x4*)(st + woff + nf * 32 * 144 + ks * 32));
#pragma unroll
            for (int nf = 0; nf < 2; ++nf)
#pragma unroll
                for (int mt = 0; mt < 4; ++mt) acc[nf][mt] = MFMA32(wf[nf], xf[mt], acc[nf][mt]);
        }
        if (more) GEMM_STORE((kt + 1) & 1);
        __syncthreads();
    }
#undef GEMM_STORE
    if (ROWSS) {
#pragma unroll
        for (int i = 0; i < 4; ++i) { float s = ssq[i]; s += __shfl_xor(s, 1); s += __shfl_xor(s, 2); s += __shfl_xor(s, 4); if (lc == 0) rs[lrow + 64 * i] = s; }
        __syncthreads();
    }
    unsigned char* stg = lds + w * 8704;
    const int rrow = lane >> 4, rch = lane & 15;
#pragma unroll
    for (int mt = 0; mt < 4; ++mt) {
#pragma unroll
        for (int nf = 0; nf < 2; ++nf)
#pragma unroll
            for (int j = 0; j < 2; ++j) {
                float* sp = (float*)(stg + l31 * 272 + (nf * 32 + 16 * j + 8 * hh) * 4);
                *(f32x4*)sp = (f32x4){acc[nf][mt][8 * j + 0], acc[nf][mt][8 * j + 1], acc[nf][mt][8 * j + 2], acc[nf][mt][8 * j + 3]};
                *(f32x4*)(sp + 4) = (f32x4){acc[nf][mt][8 * j + 4], acc[nf][mt][8 * j + 5], acc[nf][mt][8 * j + 6], acc[nf][mt][8 * j + 7]};
            }
#pragma unroll
        for (int i = 0; i < 8; ++i) {
            const int r = 4 * i + rrow;
            const f32x4 v4 = *(const f32x4*)(stg + r * 272 + rch * 16);
            const int rl = wm * 128 + mt * 32 + r;
            float v[4] = {v4[0], v4[1], v4[2], v4[3]};
            epi(m0 + rl, n0 + wn * 64 + rch * 4, v, ROWSS ? rs[rl] : (MIXN ? rtab[256 + rl] : 0.f));
        }
    }
}
template <bool ROWSS, class Epi, bool MIXN = false>
__device__ __forceinline__ void gemm_tiles_xcd(const bf16_t* __restrict__ A, int lda, const bf16_t* __restrict__ Bt, int ldb, int K, int nM, int nN,
                                               Epi& epi, unsigned char* lds, const float* __restrict__ ssq16 = nullptr) {
    const int bid = blockIdx.x, x = bid & 7, stride = gridDim.x >> 3, cnt = (nM >> 3) * nN;
    for (int L = bid >> 3; L < cnt; L += stride) {
        const int m = x + 8 * (L / nN), n = L % nN;
        gemm_tile<ROWSS, Epi, MIXN>(A, lda, Bt, ldb, K, m * 256, n * 256, epi, lds, ssq16);
    }
}

__device__ __forceinline__ u32x2 pack4(const float (&v)[4]) { u32x2 r; r.x = pack2(v[0], v[1]); r.y = pack2(v[2], v[3]); return r; }
struct EpiRowScaleBf16 {
    bf16_t* out; int ld; const float* scale; int ncol;
    __device__ __forceinline__ void operator()(int row, int col, float (&v)[4], float) const {
        if (col >= ncol) return;
        const float s = scale ? scale[row] : 1.0f;
#pragma unroll
        for (int e = 0; e < 4; ++e) v[e] *= s;
        *(u32x2*)(out + (size_t)row * ld + col) = pack4(v);
    }
};
struct EpiBiasGeluBf16 {
    bf16_t* out; int ld; const float* bias;
    __device__ __forceinline__ void operator()(int row, int col, float (&v)[4], float) const {
#pragma unroll
        for (int e = 0; e < 4; ++e) v[e] = gelu_tanh(v[e] + bias[col + e]);
        *(u32x2*)(out + (size_t)row * ld + col) = pack4(v);
    }
};
struct EpiF32 {
    float* out; int ld; int ncol;
    __device__ __forceinline__ void operator()(int row, int col, float (&v)[4], float) const {
        if (col >= ncol) return;
        *(f32x4*)(out + (size_t)row * ld + col) = (f32x4){v[0], v[1], v[2], v[3]};
    }
};
struct EpiResidual {
    const float* res_in; float* res_out; bf16_t* hb;
    __device__ __forceinline__ void operator()(int row, int col, float (&v)[4], float) const {
        const f32x4 a = *(const f32x4*)(res_in + (size_t)row * DM + col);
        v[0] += a[0]; v[1] += a[1]; v[2] += a[2]; v[3] += a[3];
        *(f32x4*)(res_out + (size_t)row * DM + col) = (f32x4){v[0], v[1], v[2], v[3]};
        if (hb) *(u32x2*)(hb + (size_t)row * DM + col) = pack4(v);
    }
};
struct EpiInProj {
    const float* rstd0; bf16_t* P; bf16_t* QN; bf16_t* KS; bf16_t* KW; bf16_t* KCIN; bf16_t* VCIN; float* GATE;
    const f32x2* ropen; const float* qg; const float* kg;
    __device__ __forceinline__ void operator()(int row, int col, float (&v)[4], float) const {
        const float rs = rstd0[row];
#pragma unroll
        for (int e = 0; e < 4; ++e) v[e] *= rs;
        const int seg = col >> 6, c64 = col & 63;
        const int b = row >> 12, s = row & 4095;
        if (seg < 12) {
            float ss = v[0] * v[0] + v[1] * v[1] + v[2] * v[2] + v[3] * v[3];
            ss = DPP_ROR_ADD(ss, 8); ss = DPP_ROR_ADD(ss, 4); ss = DPP_ROR_ADD(ss, 2); ss = DPP_ROR_ADD(ss, 1);
            const float rr = rsqrtf(ss * (1.0f / 64.0f) + EPSN);
            const float* g = seg < 8 ? qg : (seg < 10 ? kg + 64 : kg + 128);
            const f32x4 g4 = *(const f32x4*)(g + c64);
#pragma unroll
            for (int e = 0; e < 4; ++e) v[e] = v[e] * rr * g4[e];
            const bool lowhalf = c64 < 8, rot = c64 < 16;
            const float sc = seg < 8 ? 0.125f * LOG2E : 1.0f;
#pragma unroll
            for (int e = 0; e < 4; ++e) {
                const float o = __builtin_bit_cast(float, __builtin_amdgcn_update_dpp(0, __builtin_bit_cast(int, v[e]), 0x4E, 0xf, 0xf, false));
                const f32x2 c = ropen[(size_t)s * 8 + ((c64 & 7) + e)];
                const float r = lowhalf ? (v[e] * c[0] - o * c[1]) : (v[e] * c[0] + o * c[1]);
                v[e] = (rot ? r : v[e]) * sc;
            }
            bf16_t* dst = seg < 8 ? QN + ((size_t)(b * 8 + seg) * SEQ + s) * 64
                        : seg < 10 ? KS + ((size_t)(b * 2 + (seg - 8)) * SEQ + s) * 64 : KW + ((size_t)(b * 2 + (seg - 10)) * SEQ + s) * 64;
            *(u32x2*)(dst + c64) = pack4(v);
        } else if (seg < 16) {
            bf16_t* dst = seg < 14 ? KCIN + ((size_t)(b * 2 + (seg - 12)) * SEQ + s) * 64 : VCIN + ((size_t)(b * 2 + (seg - 14)) * SEQ + s) * 64;
            *(u32x2*)(dst + c64) = pack4(v);
        } else if (col < 1696) {
            *(u32x2*)(P + (size_t)row * PLD + col) = pack4(v);
        } else if (col < 1720) {
            float* gp = GATE + (size_t)row * 24 + (col - 1696);
#pragma unroll
            for (int e = 0; e < 4; ++e) gp[e] = 1.0f / (1.0f + __expf(-v[e]));
        }
    }
};
struct EpiRssNScaleBf16 {
    bf16_t* out; int ld; float inv_n;
    __device__ __forceinline__ void operator()(int row, int col, float (&v)[4], float rss) const {
        const float s = rsqrtf(rss * inv_n + EPSN);
#pragma unroll
        for (int e = 0; e < 4; ++e) v[e] *= s;
        *(u32x2*)(out + (size_t)row * ld + col) = pack4(v);
    }
};
struct EpiNull {
    __device__ __forceinline__ void operator()(int, int, float (&v)[4], float) const { asm volatile("" :: "v"(v[0]), "v"(v[1]), "v"(v[2]), "v"(v[3])); }
};
struct EpiCmpFin {
    int kv; const f32x2* ropen; const float* gain; bf16_t* KC; bf16_t* VCT;
    __device__ __forceinline__ void operator()(int row, int col, float (&v)[4], float) const {
        if (col >= 64) return;
        const int n = row & 255, bg = row >> 8;
        if (n == 255) { v[0] = 0.f; v[1] = 0.f; v[2] = 0.f; v[3] = 0.f; }
        if (kv == 0) {
            float ss = v[0] * v[0] + v[1] * v[1] + v[2] * v[2] + v[3] * v[3];
            ss = DPP_ROR_ADD(ss, 8); ss = DPP_ROR_ADD(ss, 4); ss = DPP_ROR_ADD(ss, 2); ss = DPP_ROR_ADD(ss, 1);
            const float rr = rsqrtf(ss * (1.0f / 64.0f) + EPSN);
            const f32x4 g4 = *(const f32x4*)(gain + col);
#pragma unroll
            for (int e = 0; e < 4; ++e) v[e] = v[e] * rr * g4[e];
            int pos = 16 * n + 31; if (pos > 4095) pos = 4095;
            const bool lowhalf = col < 8, rot = col < 16;
#pragma unroll
            for (int e = 0; e < 4; ++e) {
                const float o = __builtin_bit_cast(float, __builtin_amdgcn_update_dpp(0, __builtin_bit_cast(int, v[e]), 0x4E, 0xf, 0xf, false));
                const f32x2 c = ropen[(size_t)pos * 8 + ((col & 7) + e)];
                const float r = lowhalf ? (v[e] * c[0] - o * c[1]) : (v[e] * c[0] + o * c[1]);
                v[e] = rot ? r : v[e];
            }
            if (n == 255) { v[0] = 0.f; v[1] = 0.f; v[2] = 0.f; v[3] = 0.f; }
            *(u32x2*)(KC + ((size_t)bg * 256 + n) * 64 + col) = pack4(v);
        } else {
#pragma unroll
            for (int e = 0; e < 4; ++e) VCT[((size_t)bg * 64 + col + e) * 256 + n] = (bf16_t)f2bf(v[e]);
        }
    }
};
template <bool USE_RSS>
struct EpiResBf16T {
    const bf16_t* hb_in; bf16_t* hb_out;
    __device__ __forceinline__ void operator()(int row, int col, float (&v)[4], float rss) const {
        const u32x2 a = *(const u32x2*)(hb_in + (size_t)row * DM + col);
        const float sc = USE_RSS ? rss : 1.0f;
        v[0] = v[0] * sc + bflo(a.x); v[1] = v[1] * sc + bfhi(a.x); v[2] = v[2] * sc + bflo(a.y); v[3] = v[3] * sc + bfhi(a.y);
        *(u32x2*)(hb_out + (size_t)row * DM + col) = pack4(v);
    }
};
#define H2Q_CLIP 8.0f
struct EpiResBf16Q {
    const bf16_t* hb_in; bf16_t* hb_out; unsigned* hq;
    __device__ __forceinline__ void operator()(int row, int col, float (&v)[4], float) const {
        const u32x2 a = *(const u32x2*)(hb_in + (size_t)row * DM + col);
        v[0] += bflo(a.x); v[1] += bfhi(a.x); v[2] += bflo(a.y); v[3] += bfhi(a.y);
        *(u32x2*)(hb_out + (size_t)row * DM + col) = pack4(v);
        unsigned w = 0u;
#pragma unroll
        for (int e = 0; e < 4; ++e) {
            const int qi = (int)rintf(fminf(fmaxf(v[e] * (127.0f / H2Q_CLIP), -127.0f), 127.0f));
            w |= ((unsigned)qi & 0xFFu) << (8 * e);
        }
        hq[((size_t)row * DM + col) >> 2] = w;
    }
};
struct EpiRssScaleBf16 {
    bf16_t* out; int ld; float* rstd_out;
    __device__ __forceinline__ void operator()(int row, int col, float (&v)[4], float rss) const {
        const float s = rsqrtf(rss * (1.0f / 1024.0f) + EPSN);
#pragma unroll
        for (int e = 0; e < 4; ++e) v[e] *= s;
        *(u32x2*)(out + (size_t)row * ld + col) = pack4(v);
        if (rstd_out && col == 0) rstd_out[row] = s;
    }
};

#define G8_HTB 16384
#define G8_MISC_OFF 131072
__device__ __forceinline__ int g8_lds_byte(int r, int c) { const int st = (r >> 4) * 2 + (c >> 5), rr = r & 15, cc = c & 31, ob = rr * 64 + cc * 2; return st * 1024 + (ob ^ (((ob >> 9) & 1) << 5)); }
__device__ __forceinline__ void g8_stage_rc(int b, int& R, int& C) { const int st = b / 1024, sb = b % 1024, swz = sb ^ (((sb >> 9) & 1) << 5); R = (st >> 1) * 16 + swz / 64; C = (st & 1) * 32 + (swz % 64) / 2; }
__device__ __forceinline__ int g8_perm32(int rho) { const int n = rho >> 4, i = rho & 15; return 8 * (i >> 2) + 4 * n + (i & 3); }
typedef float f32x4a __attribute__((ext_vector_type(4)));
template <class Epi, bool MIXN = false>
__device__ __forceinline__ void gemm8(const bf16_t* __restrict__ A, int lda, const bf16_t* __restrict__ Bt, int ldb, int K, int nM, int nN,
                                      const Epi& E, unsigned char* lds_gen, const float* __restrict__ ssq16 = nullptr) {
    LAS unsigned char* lds = (LAS unsigned char*)lds_gen;
    const int tid = threadIdx.x, wid = __builtin_amdgcn_readfirstlane(tid >> 6), lane = tid & 63, wr = wid >> 2, wc = wid & 3, fr = lane & 15, fq = lane >> 4;
    int nt_ = K >> 6; asm volatile("" : "+s"(nt_));
    const int nt = nt_;
    const int bid = blockIdx.x, xg = bid & 7, ustride = gridDim.x >> 3, ucnt = (nM >> 3) * nN;
    int L = bid >> 3;
    if (L >= ucnt) return;
    __syncthreads();
    unsigned voffA[2], voffB[2];
#pragma unroll
    for (int i = 0; i < 2; ++i) { int R, C; g8_stage_rc(tid * 16 + i * 8192, R, C);
        voffA[i] = (unsigned)(R * lda + C) * 2u; voffB[i] = (unsigned)((64 * (R >> 5) + g8_perm32(R & 31)) * ldb + C) * 2u; }
    const size_t kstep = 128;
    const size_t hstepA = (size_t)128 * lda * 2, tstepA = 2 * hstepA;
    const size_t hstepB = (size_t)32 * ldb * 2, tstepB = (size_t)256 * ldb * 2;
    const unsigned ldsw = (unsigned)wid * 1024u;
    const int aoff = g8_lds_byte(wr * 64 + fr, fq * 8), boff = g8_lds_byte(wc * 32 + fr, fq * 8);
    LAS float* rtab = (LAS float*)(lds + G8_MISC_OFF);
#define G8_SA(b, h) (((b) * 2 + (h)) * G8_HTB)
#define G8_SB(b, h) ((4 + (b) * 2 + (h)) * G8_HTB)
#define G8_STAGE(bufoff, gbase, voff) do { _Pragma("unroll") for (int _i = 0; _i < 2; ++_i) \
        __builtin_amdgcn_global_load_lds((const unsigned*)((const char*)(gbase) + (voff)[_i]), (LAS unsigned*)(lds + (bufoff) + ldsw + _i * 8192), 16, 0, 0); } while (0)
#define G8_LDA(dst, b, h) do { _Pragma("unroll") for (int m = 0; m < 4; ++m) _Pragma("unroll") for (int k = 0; k < 2; ++k) dst[m][k] = *(const LAS bf16x8*)(lds + G8_SA(b, h) + aoff + m * 2048 + k * 1024); } while (0)
#define G8_LDB(dst, b, h) do { _Pragma("unroll") for (int n = 0; n < 2; ++n) _Pragma("unroll") for (int k = 0; k < 2; ++k) dst[n][k] = *(const LAS bf16x8*)(lds + G8_SB(b, h) + boff + n * 2048 + k * 1024); } while (0)
#define G8_MMA(ai, bj, At, Bt_) do { __builtin_amdgcn_s_setprio(1); _Pragma("unroll") for (int m = 0; m < 4; ++m) _Pragma("unroll") for (int n = 0; n < 2; ++n) _Pragma("unroll") for (int k = 0; k < 2; ++k) \
        acc[ai][bj][m][n] = __builtin_amdgcn_mfma_f32_16x16x32_bf16(Bt_[n][k], At[m][k], acc[ai][bj][m][n], 0, 0, 0); __builtin_amdgcn_s_setprio(0); } while (0)
#define G8_WAIT_V(n) asm volatile("s_waitcnt vmcnt(" #n ")" ::: "memory")
#define G8_WAIT_L(n) asm volatile("s_waitcnt lgkmcnt(" #n ")" ::: "memory")
#define G8_BAR __builtin_amdgcn_s_barrier()
#define G8_SCHED __builtin_amdgcn_sched_barrier(0)
#define G8_RTAB_FILL(pm_, par_) do { if (MIXN && tid < 256) { \
        const float* sp_ = ssq16 + (size_t)((pm_) * 256 + tid) * 16; \
        const f32x4 a0_ = *(const f32x4*)sp_, a1_ = *(const f32x4*)(sp_ + 4), b0_ = *(const f32x4*)(sp_ + 8), b1_ = *(const f32x4*)(sp_ + 12); \
        const float s1_ = ((a0_[0] + a0_[1]) + (a0_[2] + a0_[3])) + ((a1_[0] + a1_[1]) + (a1_[2] + a1_[3])); \
        const float s2_ = ((b0_[0] + b0_[1]) + (b0_[2] + b0_[3])) + ((b1_[0] + b1_[1]) + (b1_[2] + b1_[3])); \
        const float r1_ = rsqrtf(s1_ * (1.0f / 512.0f) + EPSN), r2_ = rsqrtf(s2_ * (1.0f / 512.0f) + EPSN); \
        rtab[(par_) * 512 + tid] = r1_ / r2_; rtab[(par_) * 512 + 256 + tid] = r2_; } } while (0)
    int pm = xg + 8 * (L / nN), pn = L % nN, npm = 0, npn = 0, ui = 0;
    f32x4a acc[2][2][4][2];
#pragma unroll
    for (int a = 0; a < 2; ++a)
#pragma unroll
        for (int b = 0; b < 2; ++b)
#pragma unroll
            for (int m = 0; m < 4; ++m)
#pragma unroll
                for (int n = 0; n < 2; ++n) acc[a][b][m][n] = (f32x4a){0.f, 0.f, 0.f, 0.f};
    bf16x8 At[4][2], B0[2][2], B1[2][2];
    const char* cA = (const char*)A + (size_t)pm * tstepA; const char* cB = (const char*)Bt + (size_t)pn * tstepB;
    G8_RTAB_FILL(pm, 0);
    G8_STAGE(G8_SB(0, 0), cB, voffB); G8_STAGE(G8_SA(0, 0), cA, voffA); G8_STAGE(G8_SB(0, 1), cB + hstepB, voffB); G8_STAGE(G8_SA(0, 1), cA + hstepA, voffA);
    if (wr == 1) G8_BAR;
    G8_WAIT_V(4); G8_BAR;
    G8_STAGE(G8_SB(1, 0), cB + kstep, voffB); G8_STAGE(G8_SA(1, 0), cA + kstep, voffA); G8_STAGE(G8_SB(1, 1), cB + hstepB + kstep, voffB);
    G8_WAIT_V(6); G8_BAR;
    for (;;) {
        const int Ln = L + ustride;
        const bool has_next = Ln < ucnt;
        if (has_next) { npm = xg + 8 * (Ln / nN); npn = Ln % nN; }
        const char* nA = has_next ? (const char*)A + (size_t)npm * tstepA : cA; const char* nB = has_next ? (const char*)Bt + (size_t)npn * tstepB : cB;
        for (int t = 0; t < nt; t += 2) {
            const bool last = (t == nt - 2);
            const char* a1 = cA + (size_t)(t + 1) * kstep;
            const char* a2 = last ? nA : cA + (size_t)(t + 2) * kstep; const char* b2 = last ? nB : cB + (size_t)(t + 2) * kstep;
            const char* a3 = a2 + kstep; const char* b3 = b2 + kstep;
            if (MIXN && t == (nt >> 1)) {
#pragma unroll
                for (int ai = 0; ai < 2; ++ai)
#pragma unroll
                    for (int m = 0; m < 4; ++m) { const float f = rtab[(ui & 1) * 512 + ai * 128 + wr * 64 + m * 16 + (tid & 15)];
#pragma unroll
                        for (int bj = 0; bj < 2; ++bj)
#pragma unroll
                            for (int n = 0; n < 2; ++n) acc[ai][bj][m][n] *= f; }
            }
            if (MIXN && last && has_next) G8_RTAB_FILL(npm, (ui + 1) & 1);
            G8_LDB(B0, 0, 0); G8_SCHED; G8_LDA(At, 0, 0); G8_STAGE(G8_SA(1, 1), a1 + hstepA, voffA);
            G8_WAIT_L(8); G8_BAR; G8_WAIT_L(0); G8_MMA(0, 0, At, B0); G8_BAR; G8_SCHED;
            G8_LDB(B1, 0, 1); G8_STAGE(G8_SB(0, 0), b2, voffB);
            G8_BAR; G8_WAIT_L(0); G8_MMA(0, 1, At, B1); G8_BAR;
            G8_LDA(At, 0, 1); G8_STAGE(G8_SA(0, 0), a2, voffA);
            G8_BAR; G8_WAIT_L(0); G8_MMA(1, 0, At, B0); G8_BAR; G8_SCHED;
            G8_STAGE(G8_SB(0, 1), b2 + hstepB, voffB);
            G8_WAIT_V(6); G8_BAR; G8_MMA(1, 1, At, B1); G8_BAR;
            G8_LDB(B0, 1, 0); G8_SCHED; G8_LDA(At, 1, 0); G8_STAGE(G8_SA(0, 1), a2 + hstepA, voffA);
            G8_WAIT_L(8); G8_BAR; G8_WAIT_L(0); G8_MMA(0, 0, At, B0); G8_BAR; G8_SCHED;
            G8_LDB(B1, 1, 1); G8_STAGE(G8_SB(1, 0), b3, voffB);
            G8_BAR; G8_WAIT_L(0); G8_MMA(0, 1, At, B1); G8_BAR;
            G8_LDA(At, 1, 1); G8_STAGE(G8_SA(1, 0), a3, voffA);
            G8_BAR; G8_WAIT_L(0); G8_MMA(1, 0, At, B0); G8_BAR; G8_SCHED;
            G8_STAGE(G8_SB(1, 1), b3 + hstepB, voffB);
            G8_WAIT_V(6); G8_BAR; G8_MMA(1, 1, At, B1); G8_BAR;
        }
        {
            const int col0 = pn * 256 + wc * 64;
            int tid_e = tid; asm volatile("" : "+v"(tid_e));
            const int fr_e = tid_e & 15, fq_e = (tid_e >> 4) & 3;
            typename Epi::Pre pre[2][4];
#pragma unroll
            for (int ai = 0; ai < 2; ++ai)
#pragma unroll
                for (int m = 0; m < 4; ++m) pre[ai][m] = E.pre(pm * 256 + ai * 128 + wr * 64 + m * 16 + fr_e, col0, fq_e);
#pragma unroll
            for (int ai = 0; ai < 2; ++ai)
#pragma unroll
                for (int m = 0; m < 4; ++m) {
                    const int rl = ai * 128 + wr * 64 + m * 16 + fr_e;
                    float v[2][8];
#pragma unroll
                    for (int bj = 0; bj < 2; ++bj)
#pragma unroll
                        for (int n = 0; n < 2; ++n)
#pragma unroll
                            for (int e = 0; e < 4; ++e) v[bj][4 * n + e] = acc[ai][bj][m][n][e];
                    E(pm * 256 + rl, col0, fq_e, v, MIXN ? rtab[(ui & 1) * 512 + 256 + rl] : 0.f, pre[ai][m]);
                }
        }
        if (!has_next) break;
#pragma unroll
        for (int a = 0; a < 2; ++a)
#pragma unroll
            for (int b = 0; b < 2; ++b)
#pragma unroll
                for (int m = 0; m < 4; ++m)
#pragma unroll
                    for (int n = 0; n < 2; ++n) acc[a][b][m][n] = (f32x4a){0.f, 0.f, 0.f, 0.f};
        pm = npm; pn = npn; cA = nA; cB = nB; L = Ln; ++ui;
    }
    G8_WAIT_V(0);
    if (wr == 0) G8_BAR;
    G8_BAR;
#undef G8_SA
#undef G8_SB
#undef G8_STAGE
#undef G8_LDA
#undef G8_LDB
#undef G8_MMA
#undef G8_WAIT_V
#undef G8_WAIT_L
#undef G8_BAR
#undef G8_SCHED
#undef G8_RTAB_FILL
}

#ifndef FULL_LINE
#define FULL_LINE 0
#endif
__device__ __forceinline__ void rows16_xchg(u32x4& a0, u32x4& a1, bool hi) {
    if (!FULL_LINE) return;
    u32x4 send, recv;
#pragma unroll
    for (int q = 0; q < 4; ++q) send[q] = hi ? a0[q] : a1[q];
#pragma unroll
    for (int q = 0; q < 4; ++q) recv[q] = (unsigned)__builtin_amdgcn_update_dpp(0, (int)send[q], 0x128, 0xf, 0xf, false);
#pragma unroll
    for (int q = 0; q < 4; ++q) { a0[q] = hi ? recv[q] : a0[q]; a1[q] = hi ? a1[q] : recv[q]; }
}
__device__ __forceinline__ void rows16_xchg2(u32x2& a0, u32x2& a1, bool hi) {
    if (!FULL_LINE) return;
    u32x2 send, recv;
#pragma unroll
    for (int q = 0; q < 2; ++q) send[q] = hi ? a0[q] : a1[q];
#pragma unroll
    for (int q = 0; q < 2; ++q) recv[q] = (unsigned)__builtin_amdgcn_update_dpp(0, (int)send[q], 0x128, 0xf, 0xf, false);
#pragma unroll
    for (int q = 0; q < 2; ++q) { a0[q] = hi ? recv[q] : a0[q]; a1[q] = hi ? a1[q] : recv[q]; }
}
__device__ __forceinline__ bf16_t* rows16_ptr(bf16_t* own, size_t ld, int fr, int fq) { return FULL_LINE ? own - (size_t)(fr & 8) * ld + 32 * (fr >> 3) + 8 * fq : own + 8 * fq; }
__device__ __forceinline__ const bf16_t* rows16_ptr(const bf16_t* own, size_t ld, int fr, int fq) { return FULL_LINE ? own - (size_t)(fr & 8) * ld + 32 * (fr >> 3) + 8 * fq : own + 8 * fq; }
__device__ __forceinline__ size_t rows16_step(size_t ld) { return FULL_LINE ? 8 * ld : 32; }
__device__ __forceinline__ void st_rows16(bf16_t* own, size_t ld, int fr, int fq, u32x4 a0, u32x4 a1) {
    rows16_xchg(a0, a1, fr >= 8);
    bf16_t* p = rows16_ptr(own, ld, fr, fq);
    *(u32x4*)p = a0; *(u32x4*)(p + rows16_step(ld)) = a1;
}
__device__ __forceinline__ float fq_sum(float x) {
    u32x2 s = __builtin_amdgcn_permlane16_swap(__float_as_uint(x), __float_as_uint(x), false, false);
    x = __uint_as_float(s.x) + __uint_as_float(s.y);
    s = __builtin_amdgcn_permlane32_swap(__float_as_uint(x), __float_as_uint(x), false, false);
    return __uint_as_float(s.x) + __uint_as_float(s.y);
}
__device__ __forceinline__ float fq_xor1(float x, int fq) {
    const u32x2 s = __builtin_amdgcn_permlane16_swap(__float_as_uint(x), __float_as_uint(x), false, false);
    return __uint_as_float((fq & 1) ? s.x : s.y);
}
__device__ __forceinline__ void fq_bcast23(float x, float& r2, float& r3) {
    const u32x2 s = __builtin_amdgcn_permlane32_swap(__float_as_uint(x), __float_as_uint(x), false, false);
    const u32x2 t = __builtin_amdgcn_permlane16_swap(s.y, s.y, false, false);
    r2 = __uint_as_float(t.x); r3 = __uint_as_float(t.y);
}
struct Epi8ResBf16Q {
    const bf16_t* hb_in; bf16_t* hb_out; unsigned* hq; float* ssq;
    struct Pre { u32x4 r[2]; };
    __device__ __forceinline__ Pre pre(int row, int col0, int fq) const {
        Pre p; const bf16_t* s = rows16_ptr(hb_in + (size_t)row * DM + col0, DM, row & 15, fq); p.r[0] = *(const u32x4*)s; p.r[1] = *(const u32x4*)(s + rows16_step(DM)); return p; }
    __device__ __forceinline__ void operator()(int row, int col0, int fq, float (&v)[2][8], float, const Pre& p) const {
        float ss = 0.f;
        const int fr = row & 15;
        u32x4 hin[2] = {p.r[0], p.r[1]};
        rows16_xchg(hin[0], hin[1], fr >= 8);
        u32x4 ob[2]; u32x2 oq[2];
#pragma unroll
        for (int bj = 0; bj < 2; ++bj) {
            float x[8]; unpack8(hin[bj], x);
#pragma unroll
            for (int e = 0; e < 8; ++e) { v[bj][e] += x[e]; ss += v[bj][e] * v[bj][e]; }
            ob[bj] = pack8(v[bj]);
            unsigned w[2] = {0u, 0u};
#pragma unroll
            for (int e = 0; e < 8; ++e) {
                const int qi = (int)rintf(fminf(fmaxf(v[bj][e] * (127.0f / H2Q_CLIP), -127.0f), 127.0f));
                w[e >> 2] |= ((unsigned)qi & 0xFFu) << (8 * (e & 3));
            }
            oq[bj] = (u32x2){w[0], w[1]};
        }
        st_rows16(hb_out + (size_t)row * DM + col0, DM, fr, fq, ob[0], ob[1]);
        rows16_xchg2(oq[0], oq[1], fr >= 8);
        {
            unsigned char* qp = FULL_LINE ? (unsigned char*)hq + (size_t)(row - (fr & 8)) * DM + col0 + 32 * (fr >> 3) + 8 * fq : (unsigned char*)hq + (size_t)row * DM + col0 + 8 * fq;
            *(u32x2*)qp = oq[0]; *(u32x2*)(qp + rows16_step(DM)) = oq[1];
        }
        ss = fq_sum(ss);
        if (fq == 0) ssq[(size_t)row * 16 + (col0 >> 6)] = ss;
    }
};
struct Epi8RssScaleBf16 {
    bf16_t* out; int ld; const float* ssq; float* rstd_out;
    struct Pre { f32x4 s; };
    __device__ __forceinline__ Pre pre(int row, int, int fq) const { Pre p; p.s = *(const f32x4*)(ssq + (size_t)row * 16 + 4 * fq); return p; }
    __device__ __forceinline__ void operator()(int row, int col0, int fq, float (&v)[2][8], float, const Pre& p) const {
        float t = (p.s[0] + p.s[1]) + (p.s[2] + p.s[3]);
        t = fq_sum(t);
        const float s = rsqrtf(t * (1.0f / 1024.0f) + EPSN);
#pragma unroll
        for (int bj = 0; bj < 2; ++bj)
#pragma unroll
            for (int e = 0; e < 8; ++e) v[bj][e] *= s;
        st_rows16(out + (size_t)row * ld + col0, ld, row & 15, fq, pack8(v[0]), pack8(v[1]));
        if (rstd_out && col0 == 0 && fq == 0) rstd_out[row] = s;
    }
};
struct Epi8ResBf16S {
    const bf16_t* hb_in; bf16_t* hb_out; float* ssq;
    struct Pre { u32x4 r[2]; };
    __device__ __forceinline__ Pre pre(int row, int col0, int fq) const {
        Pre p; const bf16_t* s = rows16_ptr(hb_in + (size_t)row * DM + col0, DM, row & 15, fq); p.r[0] = *(const u32x4*)s; p.r[1] = *(const u32x4*)(s + rows16_step(DM)); return p; }
    __device__ __forceinline__ void operator()(int row, int col0, int fq, float (&v)[2][8], float aux, const Pre& p) const {
        float ss = 0.f;
        const int fr = row & 15;
        u32x4 hin[2] = {p.r[0], p.r[1]};
        rows16_xchg(hin[0], hin[1], fr >= 8);
#pragma unroll
        for (int bj = 0; bj < 2; ++bj) {
            float x[8]; unpack8(hin[bj], x);
#pragma unroll
            for (int e = 0; e < 8; ++e) { v[bj][e] = v[bj][e] * aux + x[e]; ss += v[bj][e] * v[bj][e]; }
        }
        st_rows16(hb_out + (size_t)row * DM + col0, DM, fr, fq, pack8(v[0]), pack8(v[1]));
        ss = fq_sum(ss);
        if (fq == 0) ssq[(size_t)row * 16 + (col0 >> 6)] = ss;
    }
};
struct Epi8RowScaleBf16 {
    bf16_t* out; int ld; const float* scale;
    struct Pre { float s; };
    __device__ __forceinline__ Pre pre(int row, int, int) const { Pre p; p.s = scale[row]; return p; }
    __device__ __forceinline__ void operator()(int row, int col0, int fq, float (&v)[2][8], float, const Pre& p) const {
#pragma unroll
        for (int bj = 0; bj < 2; ++bj)
#pragma unroll
            for (int e = 0; e < 8; ++e) v[bj][e] *= p.s;
        st_rows16(out + (size_t)row * ld + col0, ld, row & 15, fq, pack8(v[0]), pack8(v[1]));
    }
};
struct Epi8InProj {
    const float* rstd0; bf16_t* P; bf16_t* QN; bf16_t* KS; bf16_t* KW; bf16_t* KCIN; bf16_t* VCIN; float* GATE;
    const f32x2* ropen; const float* qg; const float* kg; float* CSSQ;
    struct Pre { float rs; };
    __device__ __forceinline__ Pre pre(int row, int, int) const { Pre p; p.rs = rstd0[row]; return p; }
    __device__ __forceinline__ void operator()(int row, int col0, int fq, float (&v)[2][8], float, const Pre& p) const {
        const int seg = col0 >> 6;
        const int b = row >> 12, s = row & 4095;
#pragma unroll
        for (int bj = 0; bj < 2; ++bj)
#pragma unroll
            for (int e = 0; e < 8; ++e) v[bj][e] *= p.rs;
        if (seg < 12) {
            float ss = 0.f;
#pragma unroll
            for (int bj = 0; bj < 2; ++bj)
#pragma unroll
                for (int e = 0; e < 8; ++e) ss += v[bj][e] * v[bj][e];
            ss = fq_sum(ss);
            const float rr = rsqrtf(ss * (1.0f / 64.0f) + EPSN);
            const float* g = seg < 8 ? qg : (seg < 10 ? kg + 64 : kg + 128);
#pragma unroll
            for (int bj = 0; bj < 2; ++bj) {
                const f32x4 g0 = *(const f32x4*)(g + 32 * bj + 8 * fq), g1 = *(const f32x4*)(g + 32 * bj + 8 * fq + 4);
#pragma unroll
                for (int e = 0; e < 4; ++e) { v[bj][e] *= rr * g0[e]; v[bj][4 + e] *= rr * g1[e]; }
            }
            const f32x4* rp = (const f32x4*)(ropen + (size_t)s * 8);
            const f32x4 c01 = rp[0], c23 = rp[1], c45 = rp[2], c67 = rp[3];
            const float cs[8] = {c01[0], c01[2], c23[0], c23[2], c45[0], c45[2], c67[0], c67[2]};
            const float sn[8] = {c01[1], c01[3], c23[1], c23[3], c45[1], c45[3], c67[1], c67[3]};
            const float sc = seg < 8 ? 0.125f * LOG2E : 1.0f;
#pragma unroll
            for (int j = 0; j < 8; ++j) {
                const float o = fq_xor1(v[0][j], fq);
                const float r = fq == 0 ? (v[0][j] * cs[j] - o * sn[j]) : (v[0][j] * cs[j] + o * sn[j]);
                v[0][j] = fq < 2 ? r : v[0][j];
            }
#pragma unroll
            for (int bj = 0; bj < 2; ++bj)
#pragma unroll
                for (int e = 0; e < 8; ++e) v[bj][e] *= sc;
            bf16_t* dst = seg < 8 ? QN + ((size_t)(b * 8 + seg) * SEQ + s) * 64
                        : seg < 10 ? KS + ((size_t)(b * 2 + (seg - 8)) * SEQ + s) * 64 : KW + ((size_t)(b * 2 + (seg - 10)) * SEQ + s) * 64;
            st_rows16(dst, 64, row & 15, fq, pack8(v[0]), pack8(v[1]));
        } else if (seg < 16) {
            bf16_t* dst = seg < 14 ? KCIN + ((size_t)(b * 2 + (seg - 12)) * SEQ + s) * 64 : VCIN + ((size_t)(b * 2 + (seg - 14)) * SEQ + s) * 64;
            st_rows16(dst, 64, row & 15, fq, pack8(v[0]), pack8(v[1]));
        } else if (seg < 26) {
            bf16_t* dst = P + (size_t)row * PLD + col0;
            st_rows16(dst, PLD, row & 15, fq, pack8(v[0]), pack8(v[1]));
            if (seg >= 20) {
                float ss = 0.f;
#pragma unroll
                for (int bj = 0; bj < 2; ++bj)
#pragma unroll
                    for (int e = 0; e < 8; ++e) ss += v[bj][e] * v[bj][e];
                ss = fq_sum(ss);
                if (fq == 0) CSSQ[(size_t)row * 8 + (seg - 20)] = ss;
            }
        } else if (seg == 26) {
            *(u32x4*)(P + (size_t)row * PLD + col0 + 8 * fq) = pack8(v[0]);
            {
                float ss = 0.f;
#pragma unroll
                for (int e = 0; e < 8; ++e) ss += v[0][e] * v[0][e];
                ss = fq_sum(ss);
                if (fq == 0) CSSQ[(size_t)row * 8 + 6] = ss;
            }
            if (fq < 3) {
                float* gp = GATE + (size_t)row * 24 + 8 * fq;
                f32x4 a, c;
#pragma unroll
                for (int e = 0; e < 4; ++e) { a[e] = 1.0f / (1.0f + __expf(-v[1][e])); c[e] = 1.0f / (1.0f + __expf(-v[1][4 + e])); }
                *(f32x4*)gp = a; *(f32x4*)(gp + 4) = c;
            }
        }
    }
};
struct Epi8QUp {
    bf16_t* out; int ld; const float* cssq;
    struct Pre { float s; };
    __device__ __forceinline__ Pre pre(int row, int, int fq) const { Pre p; p.s = cssq[(size_t)row * 8 + fq]; return p; }
    __device__ __forceinline__ void operator()(int row, int col0, int fq, float (&v)[2][8], float, const Pre& p) const {
        const float t = fq_sum(p.s);
        const float s = rsqrtf(t * (1.0f / 256.0f) + EPSN);
#pragma unroll
        for (int bj = 0; bj < 2; ++bj)
#pragma unroll
            for (int e = 0; e < 8; ++e) v[bj][e] *= s;
        st_rows16(out + (size_t)row * ld + col0, ld, row & 15, fq, pack8(v[0]), pack8(v[1]));
    }
};
struct Epi8KvUp {
    const float* cssq; const bf16_t* P; const f32x2* ropem; const float* kg; bf16_t* KM; bf16_t* KVR;
    struct Pre { f32x2 s; };
    __device__ __forceinline__ Pre pre(int row, int, int fq) const { Pre p; p.s = *(const f32x2*)(cssq + (size_t)row * 8 + 2 * fq); return p; }
    __device__ __forceinline__ void operator()(int row, int col0, int fq, float (&v)[2][8], float, const Pre& p) const {
        float ckv, kpe, dummy;
        fq_bcast23(p.s[0] + p.s[1], ckv, dummy);
        fq_bcast23(p.s[0], dummy, kpe);
        const float rc = rsqrtf(ckv * (1.0f / 128.0f) + EPSN);
#pragma unroll
        for (int bj = 0; bj < 2; ++bj)
#pragma unroll
            for (int e = 0; e < 8; ++e) v[bj][e] *= rc;
        const int seg = col0 >> 6, head = seg >> 1;
        if (seg & 1) {
            bf16_t* dst = KVR + (size_t)row * 1024 + head * 128 + 64;
            st_rows16(dst, 1024, row & 15, fq, pack8(v[0]), pack8(v[1]));
        } else {
            const int b = row >> 12, s = row & 4095;
            float ss = 0.f;
#pragma unroll
            for (int bj = 0; bj < 2; ++bj)
#pragma unroll
                for (int e = 0; e < 8; ++e) ss += v[bj][e] * v[bj][e];
            ss = fq_sum(ss);
            const float r = rsqrtf((ss + kpe) * (1.0f / 96.0f) + EPSN);
            bf16_t* kp = KM + ((size_t)(b * 8 + head) * SEQ + s) * 96;
#pragma unroll
            for (int bj = 0; bj < 2; ++bj) {
                const f32x4 g0 = *(const f32x4*)(kg + 32 * bj + 8 * fq), g1 = *(const f32x4*)(kg + 32 * bj + 8 * fq + 4);
#pragma unroll
                for (int e = 0; e < 4; ++e) { v[bj][e] *= r * g0[e]; v[bj][4 + e] *= r * g1[e]; }
            }
            st_rows16(kp, 96, row & 15, fq, pack8(v[0]), pack8(v[1]));
            const u32x2 x1w = *(const u32x2*)(P + (size_t)row * PLD + C_KPE + 4 * fq), x2w = *(const u32x2*)(P + (size_t)row * PLD + C_KPE + 16 + 4 * fq);
            const f32x4 cs0 = *(const f32x4*)(ropem + (size_t)s * 16 + 4 * fq), cs1 = *(const f32x4*)(ropem + (size_t)s * 16 + 4 * fq + 2);
            const f32x4 ga = *(const f32x4*)(kg + 64 + 4 * fq), gb = *(const f32x4*)(kg + 80 + 4 * fq);
            const float x1[4] = {bflo(x1w.x), bfhi(x1w.x), bflo(x1w.y), bfhi(x1w.y)}, x2[4] = {bflo(x2w.x), bfhi(x2w.x), bflo(x2w.y), bfhi(x2w.y)};
            const float cc[4] = {cs0[0], cs0[2], cs1[0], cs1[2]}, sn[4] = {cs0[1], cs0[3], cs1[1], cs1[3]};
            float y1[4], y2[4];
#pragma unroll
            for (int e = 0; e < 4; ++e) { const float a1 = x1[e] * r * ga[e], a2 = x2[e] * r * gb[e]; y1[e] = a1 * cc[e] - a2 * sn[e]; y2[e] = a2 * cc[e] + a1 * sn[e]; }
            *(u32x2*)(kp + 64 + 4 * fq) = pack4(y1); *(u32x2*)(kp + 80 + 4 * fq) = pack4(y2);
        }
    }
};

__device__ __forceinline__ int inproj_src_col(int n) {
    if (n < 512) return 416 + n;
    if (n < 640) return 1184 + (n - 512);
    if (n < 768) return 1440 + (n - 640);
    if (n < 896) return 928 + (n - 768);
    if (n < 1024) return 1056 + (n - 896);
    if (n < 1152) return 1312 + (n - 1024);
    if (n < 1280) return 1568 + (n - 1152);
    if (n < 1536) return n - 1280;
    if (n < 1664) return 256 + (n - 1536);
    if (n < 1696) return 384 + (n - 1664);
    if (n < 1720) return n;
    return -1;
}
template <bool PERM = false>
__device__ __forceinline__ void wt_tile(const float* __restrict__ W, int N, const float* __restrict__ gain, bf16_t* __restrict__ Wt, int ldt,
                                        int kt, int nt, float* tile, bool valid) {
    const int tid = threadIdx.x & 255;
    tile += (threadIdx.x >> 8) * (64 * 65);
    __syncthreads();
    if (valid) {
        const int i = tid >> 4, j4 = (tid & 15) * 4;
#pragma unroll
        for (int rr = 0; rr < 4; ++rr) {
            const int k = kt * 64 + i + 16 * rr, nd = nt * 64 + j4;
            const int n = PERM ? inproj_src_col(nd) : (nd < N ? nd : -1);
            f32x4 v = (f32x4){0.f, 0.f, 0.f, 0.f};
            if (n >= 0) v = *(const f32x4*)(W + (size_t)k * N + n);
            const float g = gain ? gain[k] : 1.0f;
            float* tp = tile + (i + 16 * rr) * 65 + j4;
            tp[0] = v[0] * g; tp[1] = v[1] * g; tp[2] = v[2] * g; tp[3] = v[3] * g;
        }
    }
    __syncthreads();
    if (valid) {
        const int j = tid >> 2, ic = (tid & 3) * 16;
        float a[8], b[8];
#pragma unroll
        for (int e = 0; e < 8; ++e) { a[e] = tile[(ic + e) * 65 + j]; b[e] = tile[(ic + 8 + e) * 65 + j]; }
        bf16_t* dp = Wt + (size_t)(nt * 64 + j) * ldt + kt * 64 + ic;
        *(u32x4*)dp = pack8(a); *(u32x4*)(dp + 8) = pack8(b);
    }
    __syncthreads();
}

__device__ __forceinline__ void tr_tile(const bf16_t* __restrict__ src, size_t src_ld, bf16_t* __restrict__ dst, size_t dst_ld, bf16_t* tile, bool valid) {
    const int tid = threadIdx.x & 255;
    tile += (threadIdx.x >> 8) * (64 * 66);
    __syncthreads();
    if (valid) {
        const int r = tid >> 2, c = (tid & 3) * 16;
        const u32x4 a = *(const u32x4*)(src + (size_t)r * src_ld + c), b = *(const u32x4*)(src + (size_t)r * src_ld + c + 8);
        unsigned* tp = (unsigned*)(tile + r * 66 + c);
        tp[0] = a.x; tp[1] = a.y; tp[2] = a.z; tp[3] = a.w; tp[4] = b.x; tp[5] = b.y; tp[6] = b.z; tp[7] = b.w;
    }
    __syncthreads();
    if (valid) {
        const int c = tid >> 2, r0 = (tid & 3) * 16;
        unsigned o[8];
#pragma unroll
        for (int e = 0; e < 8; ++e) o[e] = (unsigned)tile[(r0 + 2 * e) * 66 + c] | ((unsigned)tile[(r0 + 2 * e + 1) * 66 + c] << 16);
        bf16_t* dp = dst + (size_t)c * dst_ld + r0;
        *(u32x4*)dp = (u32x4){o[0], o[1], o[2], o[3]}; *(u32x4*)(dp + 8) = (u32x4){o[4], o[5], o[6], o[7]};
    }
    __syncthreads();
}

static __device__ const double INV_MLA[16] = {1.0, 0.44036660267178046, 0.19392274474868576, 0.08539710028576561, 0.03760603093086393, 0.016560440080994446,
    0.007292664737217109, 0.003211445994752591, 0.001414213562373095, 0.000622772421914596, 0.0002742481756762073, 0.00012076973741146504,
    5.318295896944988e-05, 2.341999896140934e-05, 1.031338537721246e-05, 4.5416704806078695e-06};
__device__ __forceinline__ f32x2 rope_cs(int pos, double inv) {
    double rev = (double)pos * inv * 0.15915494309189535;
    rev -= __builtin_floor(rev);
    const float rf = (float)rev;
    return (f32x2){__builtin_amdgcn_cosf(rf), __builtin_amdgcn_sinf(rf)};
}

__device__ __forceinline__ void rows_to_bf16(const float* __restrict__ x, bf16_t* __restrict__ xb, float* __restrict__ rstd, const float* __restrict__ gain,
                                             int nrows, int gw, int nw, int lane) {
    for (int r = gw; r < nrows; r += nw) {
        const float* xp = x + (size_t)r * 1024 + lane * 8;
        const f32x4 a = *(const f32x4*)xp, b = *(const f32x4*)(xp + 4), c = *(const f32x4*)(xp + 512), d = *(const f32x4*)(xp + 516);
        float v0[8] = {a[0], a[1], a[2], a[3], b[0], b[1], b[2], b[3]}, v1[8] = {c[0], c[1], c[2], c[3], d[0], d[1], d[2], d[3]};
        if (rstd) {
            float s = 0.f;
#pragma unroll
            for (int e = 0; e < 8; ++e) s += v0[e] * v0[e] + v1[e] * v1[e];
            s = wave_sum(s);
            if (lane == 0) rstd[r] = rsqrtf(s * (1.0f / 1024.0f) + EPSN);
        }
        if (gain) {
            const f32x4 ga = *(const f32x4*)(gain + lane * 8), gb = *(const f32x4*)(gain + lane * 8 + 4), gc = *(const f32x4*)(gain + 512 + lane * 8), gd = *(const f32x4*)(gain + 516 + lane * 8);
#pragma unroll
            for (int e = 0; e < 4; ++e) { v0[e] *= ga[e]; v0[4 + e] *= gb[e]; v1[e] *= gc[e]; v1[4 + e] *= gd[e]; }
        }
        bf16_t* op = xb + (size_t)r * 1024 + lane * 8;
        *(u32x4*)op = pack8(v0); *(u32x4*)(op + 512) = pack8(v1);
    }
}

#define U_SCALE 64.0f
#define V_SCALE 8.0f
__device__ __forceinline__ void rows_to_slices(const float* __restrict__ x, unsigned char* __restrict__ dst, const float* __restrict__ gain, float scale, int gw, int nw, int lane) {
    for (int r = gw; r < 16384; r += nw) {
        const float* xp = x + (size_t)r * 1024 + lane * 8;
        const f32x4 a = *(const f32x4*)xp, b = *(const f32x4*)(xp + 4), c = *(const f32x4*)(xp + 512), d = *(const f32x4*)(xp + 516);
        float v0[8] = {a[0], a[1], a[2], a[3], b[0], b[1], b[2], b[3]}, v1[8] = {c[0], c[1], c[2], c[3], d[0], d[1], d[2], d[3]};
        if (gain) {
            const f32x4 ga = *(const f32x4*)(gain + lane * 8), gb = *(const f32x4*)(gain + lane * 8 + 4), gc = *(const f32x4*)(gain + 512 + lane * 8), gd = *(const f32x4*)(gain + 516 + lane * 8);
#pragma unroll
            for (int e = 0; e < 4; ++e) { v0[e] *= ga[e]; v0[4 + e] *= gb[e]; v1[e] *= gc[e]; v1[4 + e] *= gd[e]; }
        }
#pragma unroll
        for (int e = 0; e < 8; ++e) { v0[e] *= scale; v1[e] *= scale; }
        u32x2 p0, p1;
        { int t = __builtin_amdgcn_cvt_pk_fp8_f32(v0[0], v0[1], 0, false); t = __builtin_amdgcn_cvt_pk_fp8_f32(v0[2], v0[3], t, true); p0.x = (unsigned)t;
          t = __builtin_amdgcn_cvt_pk_fp8_f32(v0[4], v0[5], 0, false); t = __builtin_amdgcn_cvt_pk_fp8_f32(v0[6], v0[7], t, true); p0.y = (unsigned)t;
          t = __builtin_amdgcn_cvt_pk_fp8_f32(v1[0], v1[1], 0, false); t = __builtin_amdgcn_cvt_pk_fp8_f32(v1[2], v1[3], t, true); p1.x = (unsigned)t;
          t = __builtin_amdgcn_cvt_pk_fp8_f32(v1[4], v1[5], 0, false); t = __builtin_amdgcn_cvt_pk_fp8_f32(v1[6], v1[7], t, true); p1.y = (unsigned)t; }
        const int sl = lane >> 4, off = (lane & 15) * 8;
        *(u32x2*)(dst + ((size_t)sl * 16384 + r) * 128 + off) = p0;
        *(u32x2*)(dst + ((size_t)(4 + sl) * 16384 + r) * 128 + off) = p1;
    }
}

__device__ __forceinline__ unsigned fp4_code(float y) {
    const float ay = fabsf(y);
    const unsigned c = (ay >= 0.25f ? 1u : 0u) + (ay >= 0.75f ? 1u : 0u) + (ay >= 1.25f ? 1u : 0u) + (ay >= 1.75f ? 1u : 0u) + (ay >= 2.5f ? 1u : 0u) + (ay >= 3.5f ? 1u : 0u) + (ay >= 5.0f ? 1u : 0u);
    return c | (y < 0.f ? 8u : 0u);
}
__device__ __forceinline__ void rows_to_slices_fp4(const float* __restrict__ x, unsigned char* __restrict__ dst, float* __restrict__ row_scale, int gw, int nw, int lane) {
    for (int r = gw; r < 16384; r += nw) {
        const float* xp = x + (size_t)r * 1024 + lane * 8;
        const f32x4 a = *(const f32x4*)xp, b = *(const f32x4*)(xp + 4), c = *(const f32x4*)(xp + 512), d = *(const f32x4*)(xp + 516);
        const float v0[8] = {a[0], a[1], a[2], a[3], b[0], b[1], b[2], b[3]}, v1[8] = {c[0], c[1], c[2], c[3], d[0], d[1], d[2], d[3]};
        float mx = 0.f;
#pragma unroll
        for (int e = 0; e < 8; ++e) mx = fmaxf(mx, fmaxf(fabsf(v0[e]), fabsf(v1[e])));
        mx = fmaxf(mx, __shfl_xor(mx, 32)); mx = fmaxf(mx, __shfl_xor(mx, 16)); mx = fmaxf(mx, __shfl_xor(mx, 8));
        mx = fmaxf(mx, __shfl_xor(mx, 4)); mx = fmaxf(mx, __shfl_xor(mx, 2)); mx = fmaxf(mx, __shfl_xor(mx, 1));
        const float inv = mx > 0.f ? 6.0f / mx : 0.f;
        unsigned w0 = 0u, w1 = 0u;
#pragma unroll
        for (int e = 0; e < 8; ++e) { w0 |= fp4_code(v0[e] * inv) << (4 * e); w1 |= fp4_code(v1[e] * inv) << (4 * e); }
        const int sl = lane >> 5, off = (lane & 31) * 4;
        *(unsigned*)(dst + ((size_t)sl * 16384 + r) * 128 + off) = w0;
        *(unsigned*)(dst + ((size_t)(2 + sl) * 16384 + r) * 128 + off) = w1;
        if (lane == 0) row_scale[r] = mx * (1.0f / 6.0f);
    }
}
__device__ __forceinline__ void rows_to_slices_i8(const float* __restrict__ x, unsigned char* __restrict__ dst, const float* __restrict__ gain, float* __restrict__ row_scale,
                                                  int gw, int nw, int lane) {
    for (int r = gw; r < 16384; r += nw) {
        const float* xp = x + (size_t)r * 1024 + lane * 8;
        const f32x4 a = *(const f32x4*)xp, b = *(const f32x4*)(xp + 4), c = *(const f32x4*)(xp + 512), d = *(const f32x4*)(xp + 516);
        float v0[8] = {a[0], a[1], a[2], a[3], b[0], b[1], b[2], b[3]}, v1[8] = {c[0], c[1], c[2], c[3], d[0], d[1], d[2], d[3]};
        const f32x4 ga = *(const f32x4*)(gain + lane * 8), gb = *(const f32x4*)(gain + lane * 8 + 4), gc = *(const f32x4*)(gain + 512 + lane * 8), gd = *(const f32x4*)(gain + 516 + lane * 8);
        float mx = 0.f;
#pragma unroll
        for (int e = 0; e < 4; ++e) { v0[e] *= ga[e]; v0[4 + e] *= gb[e]; v1[e] *= gc[e]; v1[4 + e] *= gd[e]; }
#pragma unroll
        for (int e = 0; e < 8; ++e) mx = fmaxf(mx, fmaxf(fabsf(v0[e]), fabsf(v1[e])));
        mx = fmaxf(mx, __shfl_xor(mx, 32)); mx = fmaxf(mx, __shfl_xor(mx, 16)); mx = fmaxf(mx, __shfl_xor(mx, 8));
        mx = fmaxf(mx, __shfl_xor(mx, 4)); mx = fmaxf(mx, __shfl_xor(mx, 2)); mx = fmaxf(mx, __shfl_xor(mx, 1));
        const float inv = mx > 0.f ? 7.0f / mx : 0.f;
        unsigned w0 = 0u, w1 = 0u;
#pragma unroll
        for (int e = 0; e < 4; ++e) {
            const int a0 = (int)rintf(v0[e] * inv), a1 = (int)rintf(v0[4 + e] * inv), b0 = (int)rintf(v1[e] * inv), b1 = (int)rintf(v1[4 + e] * inv);
            w0 |= (((unsigned)a0 & 0xFu) | (((unsigned)a1 & 0xFu) << 4)) << (8 * e);
            w1 |= (((unsigned)b0 & 0xFu) | (((unsigned)b1 & 0xFu) << 4)) << (8 * e);
        }
        const int sl = lane >> 5, off = (lane & 31) * 4;
        *(unsigned*)(dst + ((size_t)sl * 16384 + r) * 128 + off) = w0;
        *(unsigned*)(dst + ((size_t)(2 + sl) * 16384 + r) * 128 + off) = w1;
        if (lane == 0) row_scale[r] = mx * (1.0f / 7.0f);
    }
}

struct WtJob { const float* W; int K, N, Npad; const float* gain; bf16_t* Wt; int ldt; };

__device__ __forceinline__ void phase_prep(const Args& a, unsigned char* lds) {
    unsigned char* ws = a.ws;
    const int tid = threadIdx.x, lane = tid & 63, w = tid >> 6;
    const int gw = blockIdx.x * NWV + w, nw = gridDim.x * NWV;
    rows_to_bf16(a.in[0], (bf16_t*)(ws + WS_XB), (float*)(ws + WS_RSTD0), nullptr, T_TOK, gw, nw, lane);
    rows_to_bf16(a.in[1], (bf16_t*)(ws + WS_MEMB), (float*)(ws + WS_RSTDMEM), nullptr, 4096, gw, nw, lane);
    rows_to_slices_i8(a.in[25], ws + WS_UB, a.in[22], (float*)(ws + WS_USCALE), gw, nw, lane);
    rows_to_slices_fp4(a.in[26], ws + WS_VB, (float*)(ws + WS_VSCALE), gw, nw, lane);
    for (int i = blockIdx.x * NT + tid; i < 131072 / 8; i += gridDim.x * NT) {
        const float* kp = a.in[24] + (size_t)i * 8;
        const f32x4 p = *(const f32x4*)kp, q = *(const f32x4*)(kp + 4);
        float v[8] = {p[0], p[1], p[2], p[3], q[0], q[1], q[2], q[3]};
        *(u32x4*)((bf16_t*)(ws + WS_KP) + (size_t)i * 8) = pack8(v);
    }
    for (int i = blockIdx.x * NT + tid; i < 4096 * 16; i += gridDim.x * NT) {
        const int pos = i >> 4, f = i & 15;
        ((f32x2*)(ws + WS_ROPEM))[i] = rope_cs(pos, INV_MLA[f]);
        if (f < 8) ((f32x2*)(ws + WS_ROPEN))[pos * 8 + f] = rope_cs(pos, INV_MLA[2 * f]);
    }
    for (int it = blockIdx.x; it < 32; it += gridDim.x) {
        const int kv = it >> 4, s16 = it & 15;
        if (tid >= 256) continue;
        const int j = tid & 127, kh = tid >> 7;
        const int sl = s16 * 2 + kh;
        const float* pe = a.in[11] + (size_t)kv * 2048 + sl * 64;
        const float* w1 = a.in[12] + ((size_t)kv * 2048 + sl * 64) * 128 + j;
        float s = 0.f;
        for (int k = 0; k < 64; ++k) s += pe[k] * w1[(size_t)k * 128];
        ((float*)(ws + WS_BIASP))[(kv * 32 + sl) * 128 + j] = s;
    }
    {
        float* tile = (float*)lds;
        const WtJob jobs[11] = {
            {a.in[3],  1024, INC,  INP,  a.in[2],  (bf16_t*)(ws + WS_WIN),  1024},
            {a.in[6],  256,  768,  768,  a.in[4],  (bf16_t*)(ws + WS_WUQ),  256},
            {a.in[7],  128,  1024, 1024, a.in[5],  (bf16_t*)(ws + WS_WUKV), 128},
            {a.in[12], 2048, 128,  128,  nullptr,  (bf16_t*)(ws + WS_W1C),  2048},
            {a.in[12] + 2048 * 128, 2048, 128, 128, nullptr, (bf16_t*)(ws + WS_W1C) + 128 * 2048, 2048},
            {a.in[13], 128,  64,   128,  nullptr,  (bf16_t*)(ws + WS_W2C),  128},
            {a.in[13] + 128 * 64, 128, 64, 128, nullptr, (bf16_t*)(ws + WS_W2C) + 128 * 128, 128},
            {a.in[15], 1024, 1024, 1024, a.in[14], (bf16_t*)(ws + WS_WOUT), 1024},
            {a.in[18], 1024, 512,  512,  a.in[16], (bf16_t*)(ws + WS_WXQ),  1024},
            {a.in[19], 1024, 1024, 1024, a.in[17], (bf16_t*)(ws + WS_WXKV), 1024},
            {a.in[21], 512,  1024, 1024, nullptr,  (bf16_t*)(ws + WS_WXO),  512},
        };
        int base = 0;
#pragma unroll
        for (int jb = 0; jb < 12; ++jb) {
            WtJob J;
            if (jb < 11) J = jobs[jb]; else J = WtJob{a.in[23], 1024, 1024, 1024, a.in[22], (bf16_t*)(ws + WS_WPQ), 1024};
            const int nkt = J.K / 64, nnt = J.Npad / 64, ntile = nkt * nnt;
            const int half = tid >> 8;
            for (int t0 = 2 * (int)blockIdx.x; t0 < ntile; t0 += 2 * (int)gridDim.x) {
                const int t = t0 + half; const bool ok = t < ntile; const int tt = ok ? t : 0;
                if (jb == 0) wt_tile<true>(J.W, J.N, J.gain, J.Wt, J.ldt, tt % nkt, tt / nkt, tile, ok); else wt_tile<false>(J.W, J.N, J.gain, J.Wt, J.ldt, tt % nkt, tt / nkt, tile, ok);
            }
            base += ntile;
        }
    }
}

__device__ __forceinline__ void norm_rope64(float (&v)[8], int p, const float* __restrict__ gain, const f32x2* __restrict__ cs, float scale, bool do_norm) {
    float s = 0.f;
#pragma unroll
    for (int e = 0; e < 8; ++e) s += v[e] * v[e];
    s += __shfl_xor(s, 1); s += __shfl_xor(s, 2); s += __shfl_xor(s, 4);
    const float r = rsqrtf(s * (1.0f / 64.0f) + EPSN);
    float g[8];
    { const f32x4 g0 = *(const f32x4*)(gain + p * 8), g1 = *(const f32x4*)(gain + p * 8 + 4);
      g[0] = g0[0]; g[1] = g0[1]; g[2] = g0[2]; g[3] = g0[3]; g[4] = g1[0]; g[5] = g1[1]; g[6] = g1[2]; g[7] = g1[3]; }
    if (do_norm) {
#pragma unroll
        for (int e = 0; e < 8; ++e) v[e] = v[e] * r * g[e];
    }
    float o[8];
#pragma unroll
    for (int e = 0; e < 8; ++e) o[e] = __shfl_xor(v[e], 1);
    if (do_norm && p < 2) {
#pragma unroll
        for (int e = 0; e < 8; ++e) {
            const f32x2 c = cs[e];
            v[e] = (p == 0) ? (v[e] * c[0] - o[e] * c[1]) : (v[e] * c[0] + o[e] * c[1]);
        }
    }
#pragma unroll
    for (int e = 0; e < 8; ++e) v[e] *= scale;
}

__device__ __forceinline__ void phase_tokpass(const Args& a) {
    unsigned char* ws = a.ws;
    const int tid = threadIdx.x, lane = tid & 63, w = tid >> 6;
    const int gw = blockIdx.x * NWV + w, nw = gridDim.x * NWV;
    const bf16_t* P = (const bf16_t*)(ws + WS_P);
    const f32x2* ropen = (const f32x2*)(ws + WS_ROPEN);
    const float* qn_gain = a.in[9];
    const float* kn_gain = a.in[10];
    for (int t = gw; t < T_TOK; t += nw) {
        const bf16_t* pr = P + (size_t)t * PLD;
        const int b = t >> 12, s = t & 4095;
        {
            const u32x2 q = *(const u32x2*)(pr + C_CQ + lane * 4);
            const unsigned kk = *(const unsigned*)(pr + C_CKV + lane * 2);
            float s1 = bflo(q.x) * bflo(q.x) + bfhi(q.x) * bfhi(q.x) + bflo(q.y) * bflo(q.y) + bfhi(q.y) * bfhi(q.y);
            float s2 = bflo(kk) * bflo(kk) + bfhi(kk) * bfhi(kk);
            s1 = wave_sum(s1); s2 = wave_sum(s2);
            if (lane == 0) { ((float*)(ws + WS_RSTDCQ))[t] = rsqrtf(s1 * (1.0f / 256.0f) + EPSN); ((float*)(ws + WS_RSTDCKV))[t] = rsqrtf(s2 * (1.0f / 128.0f) + EPSN); }
        }
        const f32x2* cs = ropen + (size_t)s * 8;
        {
            const int head = lane >> 3, p = lane & 7;
            float v[8]; unpack8(*(const u32x4*)(pr + C_QN + lane * 8), v);
            norm_rope64(v, p, qn_gain, cs, 0.125f * LOG2E, true);
            *(u32x4*)((bf16_t*)(ws + WS_QN) + ((size_t)(b * 8 + head) * SEQ + s) * 64 + p * 8) = pack8(v);
        }
        {
            const int which = lane >> 4, g = (lane >> 3) & 1, p = lane & 7;
            const int col = (which == 0 ? C_KS : which == 1 ? C_KW : which == 2 ? C_KC : C_VC) + g * 64 + p * 8;
            float v[8]; unpack8(*(const u32x4*)(pr + col), v);
            const float* gain = kn_gain + (which == 1 ? 128 : 64);
            norm_rope64(v, p, gain, cs, 1.0f, which < 2);
            bf16_t* dst = (bf16_t*)(ws + (which == 0 ? WS_KS : which == 1 ? WS_KW : which == 2 ? WS_KCIN : WS_VCIN));
            *(u32x4*)(dst + ((size_t)(b * 2 + g) * SEQ + s) * 64 + p * 8) = pack8(v);
        }
        if (lane < 24) {
            const float x = bf2f(pr[C_GATE + lane]);
            ((float*)(ws + WS_GATE))[(size_t)t * 24 + lane] = 1.0f / (1.0f + __expf(-x));
        }
    }
}

__device__ __forceinline__ void phase_mla_k(const Args& a) {
    unsigned char* ws = a.ws;
    const int tid = threadIdx.x, lane = tid & 63, w = tid >> 6;
    const int gw = blockIdx.x * NWV + w, nw = gridDim.x * NWV;
    const bf16_t* P = (const bf16_t*)(ws + WS_P);
    const bf16_t* KV = (const bf16_t*)(ws + WS_KVRAW);
    const f32x2* ropem = (const f32x2*)(ws + WS_ROPEM);
    const float* kg = a.in[8] + 96;
    const int head = lane >> 3, p = lane & 7;
    for (int t = gw; t < T_TOK; t += nw) {
        const int b = t >> 12, s = t & 4095;
        float v[8]; unpack8(*(const u32x4*)(KV + (size_t)t * 1024 + head * 128 + p * 8), v);
        const unsigned x1w = *(const unsigned*)(P + (size_t)t * PLD + C_KPE + 2 * p);
        const unsigned x2w = *(const unsigned*)(P + (size_t)t * PLD + C_KPE + 16 + 2 * p);
        float x1[2] = {bflo(x1w), bfhi(x1w)}, x2[2] = {bflo(x2w), bfhi(x2w)};
        float ss = x1[0] * x1[0] + x1[1] * x1[1] + x2[0] * x2[0] + x2[1] * x2[1];
#pragma unroll
        for (int e = 0; e < 8; ++e) ss += v[e] * v[e];
        ss += __shfl_xor(ss, 1); ss += __shfl_xor(ss, 2); ss += __shfl_xor(ss, 4);
        const float r = rsqrtf(ss * (1.0f / 96.0f) + EPSN);
#pragma unroll
        for (int e = 0; e < 8; ++e) v[e] = v[e] * r * kg[p * 8 + e];
        const f32x4 cs = *(const f32x4*)(ropem + (size_t)s * 16 + 2 * p);
        float y1[2], y2[2];
#pragma unroll
        for (int e = 0; e < 2; ++e) {
            const float a1 = x1[e] * r * kg[64 + 2 * p + e], a2 = x2[e] * r * kg[80 + 2 * p + e];
            const float c = cs[2 * e], sn = cs[2 * e + 1];
            y1[e] = a1 * c - a2 * sn; y2[e] = a2 * c + a1 * sn;
        }
        bf16_t* kp = (bf16_t*)(ws + WS_KM) + ((size_t)(b * 8 + head) * SEQ + s) * 96;
        *(u32x4*)(kp + p * 8) = pack8(v);
        *(unsigned*)(kp + 64 + 2 * p) = pack2(y1[0], y1[1]);
        *(unsigned*)(kp + 80 + 2 * p) = pack2(y2[0], y2[1]);
    }
}

__device__ __forceinline__ void phase_xa_k(const Args& a, int vb, int VG) {
    unsigned char* ws = a.ws;
    const int tid = threadIdx.x, lane = tid & 63, w = tid >> 6;
    const int gw = vb * NWV + w, nw = VG * NWV;
    const bf16_t* KVX = (const bf16_t*)(ws + WS_KVX);
    const float* kg = a.in[20] + 128;
    const int head = lane >> 4, p = lane & 15;
    for (int r = gw; r < 4096; r += nw) {
        const int b = r >> 8, m = r & 255;
        float v[8]; unpack8(*(const u32x4*)(KVX + (size_t)r * 1024 + head * 128 + p * 8), v);
        float ss = 0.f;
#pragma unroll
        for (int e = 0; e < 8; ++e) ss += v[e] * v[e];
        ss += __shfl_xor(ss, 1); ss += __shfl_xor(ss, 2); ss += __shfl_xor(ss, 4); ss += __shfl_xor(ss, 8);
        const float rr = rsqrtf(ss * (1.0f / 128.0f) + EPSN);
#pragma unroll
        for (int e = 0; e < 8; ++e) v[e] = v[e] * rr * kg[p * 8 + e];
        *(u32x4*)((bf16_t*)(ws + WS_KX) + ((size_t)(b * 4 + head) * 256 + m) * 128 + p * 8) = pack8(v);
    }
}

__device__ __forceinline__ void phase_cmp_fin(const Args& a) {
    unsigned char* ws = a.ws;
    const int tid = threadIdx.x, lane = tid & 63, w = tid >> 6;
    const int gw = blockIdx.x * NWV + w, nw = gridDim.x * NWV;
    const float* CR = (const float*)(ws + WS_CRAW);
    const f32x2* ropen = (const f32x2*)(ws + WS_ROPEN);
    const float* kg = a.in[10];
    for (int r = gw; r < 16384; r += nw) {
        const int kv = r >> 13, row = r & 8191, bg = row >> 8, n = row & 255;
        float x = CR[(size_t)r * 64 + lane];
        if (n == 255) x = 0.f;
        if (kv == 0) {
            float ss = wave_sum(x * x);
            const float rr = rsqrtf(ss * (1.0f / 64.0f) + EPSN);
            x = x * rr * kg[lane];
            const float o = __shfl_xor(x, 8);
            int pos = 16 * n + 31; if (pos > 4095) pos = 4095;
            if (lane < 16) {
                const f32x2 c = ropen[(size_t)pos * 8 + (lane & 7)];
                x = (lane < 8) ? (x * c[0] - o * c[1]) : (x * c[0] + o * c[1]);
            }
            if (n == 255) x = 0.f;
            ((bf16_t*)(ws + WS_KC))[((size_t)bg * 256 + n) * 64 + lane] = (bf16_t)f2bf(x);
        } else {
            ((bf16_t*)(ws + WS_VCT))[((size_t)bg * 64 + lane) * 256 + n] = (bf16_t)f2bf(x);
        }
    }
}

template <int KS, int DVT>
struct AttnRegs { u32x4 k[(KS * 128 + NT - 1) / NT]; u32x4 v[(DVT * 256 + NT - 1) / NT]; };

template <int KS, int DVT>
__device__ __forceinline__ void attn_prefetch(AttnRegs<KS, DVT>& R, const bf16_t* __restrict__ ktile  , const bf16_t* __restrict__ vt  , size_t ldv) {
    const int tid = threadIdx.x;
#pragma unroll
    for (int i = 0; i < (KS * 128 + NT - 1) / NT; ++i) { const int id = tid + NT * i; if (id < KS * 128) R.k[i] = *(const u32x4*)(ktile + (size_t)id * 8); }
#pragma unroll
    for (int i = 0; i < (DVT * 256 + NT - 1) / NT; ++i) { const int id = tid + NT * i; if (id < DVT * 256) R.v[i] = *(const u32x4*)(vt + (size_t)(id >> 3) * ldv + (id & 7) * 8); }
}
template <int KS, int DVT>
__device__ __forceinline__ void attn_store(const AttnRegs<KS, DVT>& R, unsigned char* kl, unsigned char* vl) {
    constexpr int KP = KS * 32 + 16;
    const int tid = threadIdx.x;
#pragma unroll
    for (int i = 0; i < (KS * 128 + NT - 1) / NT; ++i) { const int id = tid + NT * i; if (id < KS * 128) { const int row = id / (2 * KS), c = id % (2 * KS); *(u32x4*)(kl + row * KP + c * 16) = R.k[i]; } }
#pragma unroll
    for (int i = 0; i < (DVT * 256 + NT - 1) / NT; ++i) { const int id = tid + NT * i; if (id < DVT * 256) *(u32x4*)(vl + (id >> 3) * 144 + (id & 7) * 16) = R.v[i]; }
}

template <int KS>
__device__ __forceinline__ void attn_scores(const unsigned char* kl, const bf16x8 (&qf)[KS], f32x16 (&s)[2], int l31, int hh, float sinit = 0.f) {
    constexpr int KP = KS * 32 + 16;
    if (KS <= 6) {
        bf16x8 kf[2][KS];
#pragma unroll
        for (int kt2 = 0; kt2 < 2; ++kt2) {
            const unsigned char* kr = kl + (32 * kt2 + kap(l31)) * KP + hh * 16;
#pragma unroll
            for (int ks = 0; ks < KS; ++ks) kf[kt2][ks] = as_bf16x8(*(const u32x4*)(kr + ks * 32));
        }
        __builtin_amdgcn_sched_barrier(0);
#pragma unroll
        for (int kt2 = 0; kt2 < 2; ++kt2) {
#pragma unroll
            for (int r = 0; r < 16; ++r) s[kt2][r] = sinit;
#pragma unroll
            for (int ks = 0; ks < KS; ++ks) s[kt2] = MFMA32(kf[kt2][ks], qf[ks], s[kt2]);
        }
    } else {
#pragma unroll
        for (int kt2 = 0; kt2 < 2; ++kt2) {
            bf16x8 kf[KS];
            const unsigned char* kr = kl + (32 * kt2 + kap(l31)) * KP + hh * 16;
#pragma unroll
            for (int ks = 0; ks < KS; ++ks) kf[ks] = as_bf16x8(*(const u32x4*)(kr + ks * 32));
            __builtin_amdgcn_sched_barrier(0);
#pragma unroll
            for (int r = 0; r < 16; ++r) s[kt2][r] = sinit;
#pragma unroll
            for (int ks = 0; ks < KS; ++ks) s[kt2] = MFMA32(kf[ks], qf[ks], s[kt2]);
        }
    }
}

template <int KS, int DVT, bool MASKED = true, class MaskF>
__device__ __forceinline__ void flash_tile(const unsigned char* kl, const unsigned char* vl, const bf16x8 (&qf)[KS], f32x16 (&o)[DVT], float& m, float& l,
                                           int l31, int hh, MaskF valid, float sinit = 0.f) {
    f32x16 s[2];
    attn_scores<KS>(kl, qf, s, l31, hh, sinit);
    f32x2 ps2 = (f32x2){0.f, 0.f};
#pragma unroll
    for (int kt2 = 0; kt2 < 2; ++kt2) {
#pragma unroll
        for (int r = 0; r < 16; r += 2) {
            float p0 = __builtin_amdgcn_exp2f(s[kt2][r]), p1 = __builtin_amdgcn_exp2f(s[kt2][r + 1]);
            if (MASKED) {
                const int key = 32 * kt2 + 16 * (r >> 3) + 8 * hh + (r & 7);
                p0 = valid(key) ? p0 : 0.f; p1 = valid(key + 1) ? p1 : 0.f;
            }
            s[kt2][r] = p0; s[kt2][r + 1] = p1;
            ps2 += (f32x2){p0, p1};
        }
        bf16x8 pf[2];
#pragma unroll
        for (int s2 = 0; s2 < 2; ++s2) {
            u32x4 w;
            w.x = pack2(s[kt2][8 * s2 + 0], s[kt2][8 * s2 + 1]); w.y = pack2(s[kt2][8 * s2 + 2], s[kt2][8 * s2 + 3]);
            w.z = pack2(s[kt2][8 * s2 + 4], s[kt2][8 * s2 + 5]); w.w = pack2(s[kt2][8 * s2 + 6], s[kt2][8 * s2 + 7]);
            pf[s2] = as_bf16x8(w);
        }
#pragma unroll
        for (int d = 0; d < DVT; ++d) {
            const unsigned char* vr = vl + (32 * d + kap(l31)) * 144 + hh * 16 + (32 * kt2) * 2;
            const bf16x8 vf0 = as_bf16x8(*(const u32x4*)vr), vf1 = as_bf16x8(*(const u32x4*)(vr + 32));
            o[d] = MFMA32(vf0, pf[0], o[d]);
            o[d] = MFMA32(vf1, pf[1], o[d]);
        }
    }
    l += ps2[0] + ps2[1];
    (void)m;
}

template <int DVT>
__device__ __forceinline__ float flash_final(f32x16 (&o)[DVT], float l) {
    const float lt = l + __shfl_xor(l, 32);
    const float inv = lt > 0.f ? 1.0f / lt : 0.f;
#pragma unroll
    for (int d = 0; d < DVT; ++d)
#pragma unroll
        for (int r = 0; r < 16; ++r) o[d][r] *= inv;
    return inv;
}

#define ATT_K_OFF 0
#define ATT_V_OFF 17408
#define ATT_X_OFF 36864
#define ATT_MISC_OFF 103424

__device__ __forceinline__ void mla_unit(const Args& a, int b, int h, int qt, unsigned char* lds) {
    unsigned char* ws = a.ws;
    int tid_ = threadIdx.x; asm volatile("" : "+v"(tid_));
    const int tid = tid_, lane = tid & 63, w = tid >> 6, l31 = lane & 31, hh = lane >> 5;
    const int qw0 = qt * 256 + 32 * w, q = qw0 + l31;
    const size_t t = (size_t)b * SEQ + q;
    const bf16_t* kb = (const bf16_t*)(ws + WS_KM) + (size_t)(b * 8 + h) * SEQ * 96;
    const bf16_t* vb = (const bf16_t*)(ws + WS_VMT) + (size_t)(b * 8 + h) * 64 * SEQ;
    AttnRegs<6, 2> R;
    attn_prefetch<6, 2>(R, kb, vb, SEQ);
    bf16x8 qf[6];
    {
        const bf16_t* qr = (const bf16_t*)(ws + WS_QMRAW) + t * 768 + h * 96 + 8 * hh;
        const float* qg = a.in[8];
        float v[6][8]; float ss = 0.f;
#pragma unroll
        for (int ks = 0; ks < 6; ++ks) { unpack8(*(const u32x4*)(qr + 16 * ks), v[ks]);
#pragma unroll
            for (int e = 0; e < 8; ++e) ss += v[ks][e] * v[ks][e]; }
        ss += __shfl_xor(ss, 32);
        const float r = rsqrtf(ss * (1.0f / 96.0f) + EPSN);
#pragma unroll
        for (int ks = 0; ks < 6; ++ks)
#pragma unroll
            for (int e = 0; e < 8; ++e) v[ks][e] = v[ks][e] * r * qg[16 * ks + 8 * hh + e];
        const f32x2* cs = (const f32x2*)(ws + WS_ROPEM) + (size_t)q * 16 + 8 * hh;
#pragma unroll
        for (int e = 0; e < 8; ++e) {
            const f32x2 c = cs[e]; const float x1 = v[4][e], x2 = v[5][e];
            v[4][e] = x1 * c[0] - x2 * c[1]; v[5][e] = x2 * c[0] + x1 * c[1];
        }
        const float sc = 0.10206207261596577f * LOG2E;
#pragma unroll
        for (int ks = 0; ks < 6; ++ks) {
#pragma unroll
            for (int e = 0; e < 8; ++e) v[ks][e] *= sc;
            qf[ks] = as_bf16x8(pack8(v[ks]));
        }
    }
    f32x16 o[2];
#pragma unroll
    for (int d = 0; d < 2; ++d)
#pragma unroll
        for (int r = 0; r < 16; ++r) o[d][r] = 0.f;
    float m = -1e30f, l = 0.f;
    const int nkt = 4 * qt + 4;
    __syncthreads();
    attn_store<6, 2>(R, lds, lds + 13312);
    __syncthreads();
    for (int it = 0; it < nkt; ++it) {
        const int k0 = it * 64;
        const unsigned char* klc = lds + (it & 1) * 22528; const unsigned char* vlc = klc + 13312;
        if (it + 1 < nkt) attn_prefetch<6, 2>(R, kb + (size_t)(k0 + 64) * 96, vb + k0 + 64, SEQ);
        if (k0 + 63 <= qw0)
            flash_tile<6, 2, false>(klc, vlc, qf, o, m, l, l31, hh, [&](int) { return true; });
        else if (k0 <= qw0 + 31)
            flash_tile<6, 2>(klc, vlc, qf, o, m, l, l31, hh, [&](int key) { return k0 + key <= q; });
        if (it + 1 < nkt) attn_store<6, 2>(R, lds + ((it + 1) & 1) * 22528, lds + ((it + 1) & 1) * 22528 + 13312);
        __syncthreads();
    }
    flash_final<2>(o, l);
    {
        float sq = 0.f;
#pragma unroll
        for (int d = 0; d < 2; ++d)
#pragma unroll
            for (int r = 0; r < 16; ++r) sq += o[d][r] * o[d][r];
        sq += __shfl_xor(sq, 32);
        if (hh == 0) ((float*)(ws + WS_SSQ))[t * 16 + h] = sq;
    }
    bf16_t* op = (bf16_t*)(ws + WS_OMIX) + t * 1024 + h * 64 + 8 * hh;
#pragma unroll
    for (int d = 0; d < 2; ++d)
#pragma unroll
        for (int j = 0; j < 2; ++j) {
            float v[8];
#pragma unroll
            for (int e = 0; e < 8; ++e) v[e] = o[d][8 * j + e];
            *(u32x4*)(op + 32 * d + 16 * j) = pack8(v);
        }
}


#define PS_PITCH 260
__device__ __forceinline__ void nsa_unit(const Args& a, int b, int g, int j, unsigned char* lds) {
    unsigned char* ws = a.ws;
    int tid_ = threadIdx.x; asm volatile("" : "+v"(tid_));
    const int tid = tid_, lane = tid & 63, w = tid >> 6, l31 = lane & 31, hh = lane >> 5;
    const int posl = lane & 7, r4 = (lane >> 3) & 3;
    const int s0 = 64 * j, qpos = s0 + 8 * w + posl, hq = 4 * g + r4, bg = b * 2 + g;
    const size_t t = (size_t)b * SEQ + qpos;
    const int cur = j;
    unsigned char* kl = lds; unsigned char* vl = lds + 9216;
    float* psum = (float*)(lds + ATT_X_OFF);
    AttnRegs<4, 2> R;
    const int ntc = (4 * j + 2) / 64 + 1;
    const bf16_t* kcb = (const bf16_t*)(ws + WS_KC) + (size_t)bg * 256 * 64;
    const bf16_t* vcb = (const bf16_t*)(ws + WS_VCT) + (size_t)bg * 64 * 256;
    attn_prefetch<4, 2>(R, kcb, vcb, 256);
    bf16x8 qf[4];
    {
        const bf16_t* qr = (const bf16_t*)(ws + WS_QN) + ((size_t)(b * 8 + hq) * SEQ + qpos) * 64 + 8 * hh;
#pragma unroll
        for (int ks = 0; ks < 4; ++ks) qf[ks] = as_bf16x8(*(const u32x4*)(qr + 16 * ks));
    }
    const float* gate = (const float*)(ws + WS_GATE) + t * 24 + hq * 3;
    const float g_c = gate[0], g_s = gate[1], g_w = gate[2];
    f32x16 acc[2];
#pragma unroll
    for (int d = 0; d < 2; ++d)
#pragma unroll
        for (int r = 0; r < 16; ++r) acc[d][r] = 0.f;
    float m_c, inv_c;
    {
        f32x16 o[2];
#pragma unroll
        for (int d = 0; d < 2; ++d)
#pragma unroll
            for (int r = 0; r < 16; ++r) o[d][r] = 0.f;
        float m = -1e30f, l = 0.f;
        __syncthreads();
        attn_store<4, 2>(R, kl, vl);
        __syncthreads();
        for (int it = 0; it < ntc; ++it) {
            const int k0 = it * 64;
            const unsigned char* klc = kl + (it & 1) * 18432; const unsigned char* vlc = klc + 9216;
            if (it + 1 < ntc) attn_prefetch<4, 2>(R, kcb + (size_t)(k0 + 64) * 64, vcb + k0 + 64, 256);
            flash_tile<4, 2>(klc, vlc, qf, o, m, l, l31, hh, [&](int key) { return 16 * (k0 + key) + 31 <= qpos; });
            if (it + 1 < ntc) attn_store<4, 2>(R, kl + ((it + 1) & 1) * 18432, kl + ((it + 1) & 1) * 18432 + 9216);
            __syncthreads();
        }
        inv_c = flash_final<2>(o, l); m_c = m;
#pragma unroll
        for (int d = 0; d < 2; ++d)
#pragma unroll
            for (int r = 0; r < 16; ++r) acc[d][r] += g_c * o[d][r];
    }
    {
        attn_prefetch<4, 2>(R, kcb, vcb, 256);
        __syncthreads();
        attn_store<4, 2>(R, kl, vl);
        __syncthreads();
        for (int it = 0; it < ntc; ++it) {
            const int k0 = it * 64;
            const unsigned char* klc = kl + (it & 1) * 18432;
            if (it + 1 < ntc) attn_prefetch<4, 2>(R, kcb + (size_t)(k0 + 64) * 64, vcb + k0 + 64, 256);
            f32x16 s[2];
            attn_scores<4>(klc, qf, s, l31, hh);
#pragma unroll
            for (int kt2 = 0; kt2 < 2; ++kt2)
#pragma unroll
                for (int r = 0; r < 16; ++r) {
                    const int key = 32 * kt2 + 16 * (r >> 3) + 8 * hh + (r & 7);
                    const bool ok = 16 * (k0 + key) + 31 <= qpos;
                    float p = ok ? __builtin_amdgcn_exp2f(s[kt2][r]) * inv_c : 0.f;
                    p += __shfl_xor(p, 8); p += __shfl_xor(p, 16);
                    s[kt2][r] = p;
                }
            if (r4 == 0) {
                float* pr = psum + (8 * w + posl) * PS_PITCH + k0 + 8 * hh;
#pragma unroll
                for (int kt2 = 0; kt2 < 2; ++kt2)
#pragma unroll
                    for (int j2 = 0; j2 < 2; ++j2) {
                        *(f32x4*)(pr + 32 * kt2 + 16 * j2) = (f32x4){s[kt2][8 * j2 + 0], s[kt2][8 * j2 + 1], s[kt2][8 * j2 + 2], s[kt2][8 * j2 + 3]};
                        *(f32x4*)(pr + 32 * kt2 + 16 * j2 + 4) = (f32x4){s[kt2][8 * j2 + 4], s[kt2][8 * j2 + 5], s[kt2][8 * j2 + 6], s[kt2][8 * j2 + 7]};
                    }
            }
            if (it + 1 < ntc) attn_store<4, 2>(R, kl + ((it + 1) & 1) * 18432, kl + ((it + 1) & 1) * 18432 + 9216);
            __syncthreads();
        }
    }
    __syncthreads();
    unsigned long long mymask, unionmask;
    {
        const int mg = lane >> 3;
        float* impb = (float*)kl + (w * 8 + posl) * 64;
        const float* pr = psum + (8 * w + posl) * PS_PITCH;
        const int nvis = (64 * ntc < 255) ? 64 * ntc : 255;
        float imp[8];
#pragma unroll
        for (int e = 0; e < 8; ++e) {
            const int m = mg * 8 + e;
            float sacc = 0.f;
#pragma unroll
            for (int d = -1; d <= 3; ++d) { const int n = 4 * m + d; if (n >= 0 && n < nvis) sacc += pr[n]; }
            imp[e] = sacc; impb[m] = sacc;
        }
        __syncthreads();
        int cnt[8];
#pragma unroll
        for (int e = 0; e < 8; ++e) cnt[e] = 0;
        const float* ib = (const float*)kl + (w * 8 + posl) * 64;
        for (int mp = 1; mp <= cur - 2; ++mp) {
            const float v = ib[mp];
#pragma unroll
            for (int e = 0; e < 8; ++e) { const int m = mg * 8 + e; cnt[e] += ((v > imp[e]) || (v == imp[e] && mp < m)) ? 1 : 0; }
        }
        const int nf = cur == 0 ? 1 : (cur == 1 ? 2 : 3);
        const int nsel = 16 - nf;
        unsigned m8 = 0;
#pragma unroll
        for (int e = 0; e < 8; ++e) {
            const int m = mg * 8 + e;
            const bool forced = (m == 0) || (m == cur) || (m == cur - 1);
            const bool sel = (m <= cur) && (forced || (m >= 1 && m <= cur - 2 && cnt[e] < nsel));
            m8 |= sel ? (1u << e) : 0u;
        }
        unsigned lo = (mg < 4) ? (m8 << (8 * mg)) : 0u, hi = (mg >= 4) ? (m8 << (8 * (mg - 4))) : 0u;
        lo |= __shfl_xor(lo, 8); hi |= __shfl_xor(hi, 8);
        lo |= __shfl_xor(lo, 16); hi |= __shfl_xor(hi, 16);
        lo |= __shfl_xor(lo, 32); hi |= __shfl_xor(hi, 32);
        mymask = ((unsigned long long)hi << 32) | lo;
        unsigned ulo = lo, uhi = hi;
        ulo |= __shfl_xor(ulo, 1); uhi |= __shfl_xor(uhi, 1);
        ulo |= __shfl_xor(ulo, 2); uhi |= __shfl_xor(uhi, 2);
        ulo |= __shfl_xor(ulo, 4); uhi |= __shfl_xor(uhi, 4);
        unsigned* misc = (unsigned*)(lds + ATT_MISC_OFF);
        if (lane == 0) { misc[2 * w] = ulo; misc[2 * w + 1] = uhi; }
        __syncthreads();
        ulo = misc[0] | misc[2] | misc[4] | misc[6] | misc[8] | misc[10] | misc[12] | misc[14]; uhi = misc[1] | misc[3] | misc[5] | misc[7] | misc[9] | misc[11] | misc[13] | misc[15];
        unionmask = ((unsigned long long)uhi << 32) | ulo;
    }
    {
        f32x16 o[2];
#pragma unroll
        for (int d = 0; d < 2; ++d)
#pragma unroll
            for (int r = 0; r < 16; ++r) o[d][r] = 0.f;
        float m = -1e30f, l = 0.f;
        const bf16_t* kb = (const bf16_t*)(ws + WS_KS) + (size_t)bg * SEQ * 64;
        const bf16_t* vb = (const bf16_t*)(ws + WS_VST) + (size_t)bg * 64 * SEQ;
        unsigned long long rem = unionmask;
        int mb = __builtin_ctzll(rem); rem &= rem - 1;
        attn_prefetch<4, 2>(R, kb + (size_t)mb * 64 * 64, vb + mb * 64, SEQ);
        __syncthreads();
        attn_store<4, 2>(R, kl, vl);
        __syncthreads();
        int cbuf = 0;
        for (;;) {
            const int k0 = mb * 64;
            const bool more = rem != 0ull;
            int mnext = 0;
            if (more) { mnext = __builtin_ctzll(rem); rem &= rem - 1; }
            const unsigned char* klc = kl + cbuf * 18432; const unsigned char* vlc = klc + 9216;
            if (more) attn_prefetch<4, 2>(R, kb + (size_t)mnext * 64 * 64, vb + mnext * 64, SEQ);
            const bool mine = (mymask >> mb) & 1ull;
            if (mb < cur) {
                if (__all(mine)) flash_tile<4, 2, false>(klc, vlc, qf, o, m, l, l31, hh, [&](int) { return true; });
                else if (__any(mine)) flash_tile<4, 2, false>(klc, vlc, qf, o, m, l, l31, hh, [&](int) { return true; }, mine ? 0.f : -1e30f);
            } else
                flash_tile<4, 2>(klc, vlc, qf, o, m, l, l31, hh, [&](int key) { return mine && (k0 + key <= qpos); });
            if (more) attn_store<4, 2>(R, kl + (cbuf ^ 1) * 18432, kl + (cbuf ^ 1) * 18432 + 9216);
            __syncthreads();
            if (!more) break;
            mb = mnext; cbuf ^= 1;
        }
        flash_final<2>(o, l);
#pragma unroll
        for (int d = 0; d < 2; ++d)
#pragma unroll
            for (int r = 0; r < 16; ++r) acc[d][r] += g_s * o[d][r];
    }
    {
        f32x16 o[2];
#pragma unroll
        for (int d = 0; d < 2; ++d)
#pragma unroll
            for (int r = 0; r < 16; ++r) o[d][r] = 0.f;
        float m = -1e30f, l = 0.f;
        const bf16_t* kb = (const bf16_t*)(ws + WS_KW) + (size_t)bg * SEQ * 64;
        const bf16_t* vb = (const bf16_t*)(ws + WS_VWT) + (size_t)bg * 64 * SEQ;
        const int lo = s0 - 511;
        const int m0 = lo <= 0 ? 0 : (lo >> 6);
        attn_prefetch<4, 2>(R, kb + (size_t)m0 * 64 * 64, vb + m0 * 64, SEQ);
        __syncthreads();
        attn_store<4, 2>(R, kl, vl);
        __syncthreads();
        for (int mb = m0; mb <= cur; ++mb) {
            const int k0 = mb * 64;
            const int cb2 = (mb - m0) & 1;
            const unsigned char* klc = kl + cb2 * 18432; const unsigned char* vlc = klc + 9216;
            if (mb + 1 <= cur) attn_prefetch<4, 2>(R, kb + (size_t)(mb + 1) * 64 * 64, vb + (mb + 1) * 64, SEQ);
            if (k0 + 63 <= s0 + 8 * w && s0 + 8 * w + 7 - k0 < 512)
                flash_tile<4, 2, false>(klc, vlc, qf, o, m, l, l31, hh, [&](int) { return true; });
            else
                flash_tile<4, 2>(klc, vlc, qf, o, m, l, l31, hh, [&](int key) { const int kp = k0 + key; return (kp <= qpos) && (qpos - kp < 512); });
            if (mb + 1 <= cur) attn_store<4, 2>(R, kl + (cb2 ^ 1) * 18432, kl + (cb2 ^ 1) * 18432 + 9216);
            __syncthreads();
        }
        flash_final<2>(o, l);
#pragma unroll
        for (int d = 0; d < 2; ++d)
#pragma unroll
            for (int r = 0; r < 16; ++r) acc[d][r] += g_w * o[d][r];
    }
    {
        float sq = 0.f;
#pragma unroll
        for (int d = 0; d < 2; ++d)
#pragma unroll
            for (int r = 0; r < 16; ++r) sq += acc[d][r] * acc[d][r];
        sq += __shfl_xor(sq, 32);
        if (hh == 0) ((float*)(ws + WS_SSQ))[t * 16 + 8 + hq] = sq;
    }
    bf16_t* op = (bf16_t*)(ws + WS_OMIX) + t * 1024 + 512 + hq * 64 + 8 * hh;
#pragma unroll
    for (int d = 0; d < 2; ++d)
#pragma unroll
        for (int j2 = 0; j2 < 2; ++j2) {
            float v[8];
#pragma unroll
            for (int e = 0; e < 8; ++e) v[e] = acc[d][8 * j2 + e];
            *(u32x4*)(op + 32 * d + 16 * j2) = pack8(v);
        }
}


__device__ __forceinline__ void xa_unit(const Args& a, int b, int head, int qt, unsigned char* lds) {
    unsigned char* ws = a.ws;
    int tid_ = threadIdx.x; asm volatile("" : "+v"(tid_));
    const int tid = tid_, lane = tid & 63, w = tid >> 6, l31 = lane & 31, hh = lane >> 5;
    const int q = qt * 256 + 32 * w + l31;
    const size_t t = (size_t)b * SEQ + q;
    unsigned char* kl = lds + ATT_K_OFF; unsigned char* vl = lds + ATT_V_OFF;
    bf16x8 qf[8];
    {
        const bf16_t* qr = (const bf16_t*)(ws + WS_QX) + t * 512 + head * 128 + 8 * hh;
        const float* qg = a.in[20];
        float ss = 0.f;
        u32x4 raw[8];
#pragma unroll
        for (int ks = 0; ks < 8; ++ks) { raw[ks] = *(const u32x4*)(qr + 16 * ks); float v[8]; unpack8(raw[ks], v);
#pragma unroll
            for (int e = 0; e < 8; ++e) ss += v[e] * v[e]; }
        ss += __shfl_xor(ss, 32);
        const float r = rsqrtf(ss * (1.0f / 128.0f) + EPSN) * 0.08838834764831845f * LOG2E;
#pragma unroll
        for (int ks = 0; ks < 8; ++ks) { float v[8]; unpack8(raw[ks], v);
#pragma unroll
            for (int e = 0; e < 8; ++e) v[e] = v[e] * r * qg[16 * ks + 8 * hh + e];
            qf[ks] = as_bf16x8(pack8(v)); }
    }
    f32x16 o[4];
#pragma unroll
    for (int d = 0; d < 4; ++d)
#pragma unroll
        for (int r = 0; r < 16; ++r) o[d][r] = 0.f;
    float m = -1e30f, l = 0.f;
    const bf16_t* kb = (const bf16_t*)(ws + WS_KX) + (size_t)(b * 4 + head) * 256 * 128;
    const bf16_t* vb = (const bf16_t*)(ws + WS_VXT) + (size_t)(b * 4 + head) * 128 * 256;
#pragma unroll 1
    for (int it = 0; it < 4; ++it) {
        const int k0 = it * 64;
        __syncthreads();
        { AttnRegs<8, 4> R; attn_prefetch<8, 4>(R, kb + (size_t)k0 * 128, vb + k0, 256); attn_store<8, 4>(R, kl, vl); }
        __syncthreads();
        flash_tile<8, 4, false>(kl, vl, qf, o, m, l, l31, hh, [&](int) { return true; });
    }
    flash_final<4>(o, l);
    bf16_t* op = (bf16_t*)(ws + WS_OX) + t * 512 + head * 128 + 8 * hh;
#pragma unroll
    for (int d = 0; d < 4; ++d)
#pragma unroll
        for (int j2 = 0; j2 < 2; ++j2) {
            float v[8];
#pragma unroll
            for (int e = 0; e < 8; ++e) v[e] = o[d][8 * j2 + e];
            *(u32x4*)(op + 32 * d + 16 * j2) = pack8(v);
        }
}

__device__ __forceinline__ int f2ord(float x) { const int b = __float_as_int(x); return b ^ ((b >> 31) & 0x7FFFFFFF); }
__device__ __forceinline__ float ord2f(int k) { return __int_as_float(k ^ ((k >> 31) & 0x7FFFFFFF)); }
#define IMIN ((int)0x80000000)

#define CEX_DESC(a_, b_) do { const int hi_ = max((a_), (b_)), lo_ = min((a_), (b_)); (a_) = hi_; (b_) = lo_; } while (0)
__device__ __forceinline__ void bitonic_sort_desc16(int (&a)[16]) {
#pragma unroll
    for (int k = 2; k <= 16; k <<= 1)
#pragma unroll
        for (int j = k >> 1; j > 0; j >>= 1)
#pragma unroll
            for (int i = 0; i < 16; ++i) {
                const int l = i ^ j;
                if (l > i) { if ((i & k) == 0) CEX_DESC(a[i], a[l]); else CEX_DESC(a[l], a[i]); }
            }
}
__device__ __forceinline__ void merge_top16(int (&a)[16], const int (&b)[16]) {
#pragma unroll
    for (int i = 0; i < 16; ++i) a[i] = max(a[i], b[15 - i]);
#pragma unroll
    for (int j = 8; j > 0; j >>= 1)
#pragma unroll
        for (int i = 0; i < 16; ++i) { const int l = i ^ j; if (l > i) CEX_DESC(a[i], a[l]); }
}
__device__ __forceinline__ void peer_top16_of_128(const bf16_t* __restrict__ kp  , const bf16x8 (&qf)[4]  , int (&lst)[16], int l31, int hh) {
    int key[4][16];
#pragma unroll
    for (int kt = 0; kt < 4; ++kt) {
        f32x16 s;
#pragma unroll
        for (int r = 0; r < 16; ++r) s[r] = 0.f;
        const bf16_t* kr = kp + (size_t)(32 * kt + kap(l31)) * 64 + 8 * hh;
#pragma unroll
        for (int ks = 0; ks < 4; ++ks) { const bf16x8 kf = as_bf16x8(*(const u32x4*)(kr + 16 * ks)); s = MFMA32(kf, qf[ks], s); }
#pragma unroll
        for (int r = 0; r < 16; ++r) {
            const int idx = 32 * kt + 16 * (r >> 3) + 8 * hh + (r & 7);
            key[kt][r] = (__float_as_int(s[r] + 64.0f) & ~0x7F) | (127 - idx);
        }
    }
    bitonic_sort_desc16(key[0]); bitonic_sort_desc16(key[1]); bitonic_sort_desc16(key[2]); bitonic_sort_desc16(key[3]);
    merge_top16(key[0], key[1]); merge_top16(key[2], key[3]); merge_top16(key[0], key[2]);
#pragma unroll
    for (int i = 0; i < 16; ++i) lst[i] = key[0][i];
}

__device__ __forceinline__ void phase_peer_route(const Args& a) {
    unsigned char* ws = a.ws;
    int tid_ = threadIdx.x; asm volatile("" : "+v"(tid_));
    const int tid = tid_, lane = tid & 63, w = tid >> 6, l31 = lane & 31, hh = lane >> 5;
    const int gw = blockIdx.x * NWV + w, nw = gridDim.x * NWV;
    const bf16_t* QP = (const bf16_t*)(ws + WS_QP);
    const bf16_t* KP = (const bf16_t*)(ws + WS_KP);
    int* EIDX = (int*)(ws + WS_EIDX);
    float* EG = (float*)(ws + WS_EG);
    for (int it = gw; it < (T_TOK / 32) * 4; it += nw) {
        const int hp = it & 3, t = (it >> 2) * 32 + l31;
        const int h = 2 * hp + hh;
        int l1[16], l2[16];
        bf16x8 qA0[4], qB0[4], qA1[4], qB1[4];
        {
            const bf16_t* qr = QP + (size_t)t * 1024 + (2 * hp) * 128 + 8 * hh;
#pragma unroll
            for (int ks = 0; ks < 4; ++ks) {
                qA0[ks] = as_bf16x8(*(const u32x4*)(qr + 16 * ks)); qA1[ks] = as_bf16x8(*(const u32x4*)(qr + 64 + 16 * ks));
                qB0[ks] = as_bf16x8(*(const u32x4*)(qr + 128 + 16 * ks)); qB1[ks] = as_bf16x8(*(const u32x4*)(qr + 192 + 16 * ks));
            }
        }
        {
            int pA[16], pB[16];
            peer_top16_of_128(KP + (size_t)((2 * hp) * 2 + 0) * 128 * 64, qA0, pA, l31, hh);
            peer_top16_of_128(KP + (size_t)((2 * hp + 1) * 2 + 0) * 128 * 64, qB0, pB, l31, hh);
#pragma unroll
            for (int i = 0; i < 16; ++i) { const u32x2 sw = __builtin_amdgcn_permlane32_swap((unsigned)pA[i], (unsigned)pB[i], false, false); l1[i] = (int)sw.x; pB[i] = (int)sw.y; }
            merge_top16(l1, pB);
        }
        {
            int pA[16], pB[16];
            peer_top16_of_128(KP + (size_t)((2 * hp) * 2 + 1) * 128 * 64, qA1, pA, l31, hh);
            peer_top16_of_128(KP + (size_t)((2 * hp + 1) * 2 + 1) * 128 * 64, qB1, pB, l31, hh);
#pragma unroll
            for (int i = 0; i < 16; ++i) { const u32x2 sw = __builtin_amdgcn_permlane32_swap((unsigned)pA[i], (unsigned)pB[i], false, false); l2[i] = (int)sw.x; pB[i] = (int)sw.y; }
            merge_top16(l2, pB);
        }
        float f1[16], f2[16];
        unsigned i1p[4] = {0u, 0u, 0u, 0u}, i2p[4] = {0u, 0u, 0u, 0u};
#pragma unroll
        for (int i = 0; i < 16; ++i) {
            f1[i] = __int_as_float(l1[i] & ~0x7F); f2[i] = __int_as_float(l2[i] & ~0x7F) - 64.0f;
            i1p[i >> 2] |= (unsigned)(127 - (l1[i] & 0x7F)) << (8 * (i & 3));
            i2p[i >> 2] |= (unsigned)(127 - (l2[i] & 0x7F)) << (8 * (i & 3));
        }
        int cg[4][16];
#pragma unroll
        for (int gq = 0; gq < 4; ++gq)
#pragma unroll
            for (int i = 0; i < 16; ++i) cg[gq][i] = IMIN;
        {
            int n0 = 0, n1 = 0, n2 = 0, n3 = 0;
#pragma unroll
            for (int ca = 0; ca < 16; ++ca)
#pragma unroll
                for (int cb = 0; cb < 16; ++cb)
                    if ((ca + 1) * (cb + 1) <= 16) {
                        const int kc = (__float_as_int(f1[ca] + f2[cb]) & ~0xFF) | (255 - (ca * 16 + cb));
                        if (ca == 0) { cg[0][n0] = kc; ++n0; }
                        else if (ca <= 2) { cg[1][n1] = kc; ++n1; }
                        else if (ca <= 7) { cg[2][n2] = kc; ++n2; }
                        else { cg[3][n3] = kc; ++n3; }
                    }
        }
        bitonic_sort_desc16(cg[1]); bitonic_sort_desc16(cg[2]); bitonic_sort_desc16(cg[3]);
        merge_top16(cg[0], cg[1]); merge_top16(cg[2], cg[3]); merge_top16(cg[0], cg[2]);
        float tv[16]; int te[16];
#pragma unroll
        for (int rd = 0; rd < 16; ++rd) {
            const int mx = cg[0][rd];
            const int code = 255 - (mx & 0xFF), ca = code >> 4, cb = code & 15;
            const unsigned wa = (ca >> 2) == 0 ? i1p[0] : (ca >> 2) == 1 ? i1p[1] : (ca >> 2) == 2 ? i1p[2] : i1p[3];
            const unsigned wb = (cb >> 2) == 0 ? i2p[0] : (cb >> 2) == 1 ? i2p[1] : (cb >> 2) == 2 ? i2p[2] : i2p[3];
            const int i1 = (wa >> (8 * (ca & 3))) & 0xFF, i2 = (wb >> (8 * (cb & 3))) & 0xFF;
            te[rd] = i1 * 128 + i2;
            tv[rd] = __int_as_float(mx & ~0xFF);
        }
        {
            const float t0 = tv[0];
            float den = 0.f;
#pragma unroll
            for (int i = 0; i < 16; ++i) { tv[i] = __expf(tv[i] - t0); den += tv[i]; }
            const float rden = 1.0f / den;
#pragma unroll
            for (int i = 0; i < 16; ++i) tv[i] *= rden;
        }
        {
            int* ep = EIDX + (size_t)t * 128 + h * 16;
            float* gp = EG + (size_t)t * 128 + h * 16;
#pragma unroll
            for (int i = 0; i < 16; i += 4) {
                *(int __attribute__((ext_vector_type(4)))*)(ep + i) = (int __attribute__((ext_vector_type(4)))){te[i], te[i + 1], te[i + 2], te[i + 3]};
                *(f32x4*)(gp + i) = (f32x4){tv[i], tv[i + 1], tv[i + 2], tv[i + 3]};
            }
        }
    }
}

#define QCTR_WORD(ph, j) (3520 + ((ph) * 8 + (j)) * 16)
#define PEER_CHUNK_TOK 128
typedef __bf16 bf2_t __attribute__((ext_vector_type(2)));
__device__ __forceinline__ float dot2bf(unsigned a, unsigned b, float c) {
    union { unsigned u; bf2_t v; } x, y; x.u = a; y.u = b;
    return __builtin_amdgcn_fdot2_f32_bf16(x.v, y.v, c, false);
}
__device__ __forceinline__ float row16_sum(float v) { v = DPP_ROR_ADD(v, 8); v = DPP_ROR_ADD(v, 4); v = DPP_ROR_ADD(v, 2); v = DPP_ROR_ADD(v, 1); return v; }
__device__ __forceinline__ int queue_grab(unsigned* ctr, volatile int* slot) {
    __syncthreads();
    if (threadIdx.x == 0) *slot = (int)__hip_atomic_fetch_add(ctr, 1u, __ATOMIC_RELAXED, __HIP_MEMORY_SCOPE_AGENT);
    __syncthreads();
    return *slot;
}

#define DPP_ADD(v, ctrl) ((v) + __builtin_bit_cast(float, __builtin_amdgcn_update_dpp(0, __builtin_bit_cast(int, (v)), (ctrl), 0xf, 0xf, false)))
template <int WHICH>
__device__ __forceinline__ void phase_peer_sliced(const Args& a, unsigned char* lds, int qph, bool dry) {
    unsigned char* ws = a.ws;
    int tid_ = threadIdx.x; asm volatile("" : "+v"(tid_));
    const int tid = tid_, lane = tid & 63, c8 = lane & 7, g8 = lane >> 3;
    const int w = __builtin_amdgcn_readfirstlane(tid >> 6);
    const bf16_t* H2B = (const bf16_t*)(ws + WS_H2B);
    const int* EIDX = (const int*)(ws + WS_EIDX);
    const unsigned* W32 = (const unsigned*)(ws + WS_EG);
    float* PART = (float*)(ws + WS_PART);
    unsigned* bar = (unsigned*)(ws + WS_BAR);
    volatile int* slot = (volatile int*)(lds + LDS_BYTES - 32);
    const int myx = (int)(xb_xcc_id() & 7u);
    constexpr int NSL = 4;
    for (int qq = 0; qq < NSL; ++qq) {
        const int j = (myx + qq) & (NSL - 1);
        const unsigned char* TB = ws + (WHICH == 0 ? WS_UB : WS_VB) + (size_t)j * 16384 * 128;
        const unsigned lofs = (unsigned)c8 * 16u;
        for (;;) {
            int ch = 0;
            if (lane == 0) ch = (int)__hip_atomic_fetch_add(bar + QCTR_WORD(qph, j), 1u, __ATOMIC_RELAXED, __HIP_MEMORY_SCOPE_AGENT);
            ch = __builtin_amdgcn_readfirstlane(ch);
            if (ch >= T_TOK / (PEER_CHUNK_TOK / 4)) break;
            const int tbase = ch * (PEER_CHUNK_TOK / 4);
            constexpr int NTOK = PEER_CHUNK_TOK / 4;
            if (WHICH == 0) {
#define E1_ISSUE(ud_, esrc_) do { \
                    _Pragma("unroll") for (int i = 0; i < 8; ++i) { \
                        const int idx = __shfl(esrc_, 8 * i + g8); \
                        ud_[i] = *(const u32x4*)(TB + ((unsigned)idx * 128u + lofs)); } } while (0)
#define E1_DOT(ud_, res_) do { \
                    _Pragma("unroll") for (int i = 0; i < 8; ++i) { \
                        int d = 0; \
                        _Pragma("unroll") for (int q = 0; q < 4; ++q) { \
                            const unsigned wq_ = ud_[i][q]; \
                            d = __builtin_amdgcn_sdot4((int)((wq_ << 4) & 0xF0F0F0F0u), hq[2 * q], d, false); \
                            d = __builtin_amdgcn_sdot4((int)(wq_ & 0xF0F0F0F0u), hq[2 * q + 1], d, false); } \
                        d += __builtin_amdgcn_update_dpp(0, d, 0xB1, 0xf, 0xf, false); \
                        d += __builtin_amdgcn_update_dpp(0, d, 0x4E, 0xf, 0xf, false); \
                        d += __builtin_amdgcn_update_dpp(0, d, 0x141, 0xf, 0xf, false); \
                        if (c8 == i) res_ = d; } } while (0)
                int e0 = EIDX[(size_t)tbase * 128 + lane], e1 = EIDX[(size_t)tbase * 128 + 64 + lane];
                const unsigned char* H2Q = ws + WS_H2Q;
                u32x4 h0 = *(const u32x4*)(H2Q + (size_t)tbase * 1024 + j * 256 + c8 * 32), h1 = *(const u32x4*)(H2Q + (size_t)tbase * 1024 + j * 256 + c8 * 32 + 16);
                u32x4 udA[8], udB[8];
                E1_ISSUE(udA, e0);
#pragma unroll 1
                for (int tt = 0; tt < NTOK; ++tt) {
                    const int t = tbase + tt;
                    E1_ISSUE(udB, e1);
                    const int hq[8] = {(int)h0.x, (int)h0.y, (int)h0.z, (int)h0.w, (int)h1.x, (int)h1.y, (int)h1.z, (int)h1.w};
                    if (tt + 1 < NTOK) {
                        e0 = EIDX[(size_t)(t + 1) * 128 + lane]; e1 = EIDX[(size_t)(t + 1) * 128 + 64 + lane];
                        h0 = *(const u32x4*)(H2Q + (size_t)(t + 1) * 1024 + j * 256 + c8 * 32); h1 = *(const u32x4*)(H2Q + (size_t)(t + 1) * 1024 + j * 256 + c8 * 32 + 16);
                    }
                    int res0 = 0, res1 = 0;
                    E1_DOT(udA, res0);
                    if (tt + 1 < NTOK) E1_ISSUE(udA, e0);
                    E1_DOT(udB, res1);
                    int* pp = (int*)PART + ((size_t)j * T_TOK + t) * 128 + 8 * c8 + g8;
                    pp[0] = res0; pp[64] = res1;
                }
#undef E1_ISSUE
#undef E1_DOT
            } else {
                typedef int i32x2 __attribute__((ext_vector_type(2)));
                typedef int i32x8 __attribute__((ext_vector_type(8)));
                LAS unsigned char* wl = (LAS unsigned char*)lds + w * 16640;
                const int n16 = lane & 15, kb = lane >> 4;
                const unsigned char* WF8 = ws + WS_WF8;
#define E3M_ISSUE(wa_, wb_) do { \
                    _Pragma("unroll") for (int i = 0; i < 16; ++i) { \
                        const int ks = 32 * (g8 >> 1) + 16 * (i >> 3) + 2 * (i & 7) + (g8 & 1);        \
                        const unsigned pka = (unsigned)__shfl((int)(wa_), ks & 63), pkb = (unsigned)__shfl((int)(wb_), ks & 63); \
                        const unsigned pk = ks < 64 ? pka : pkb; \
                        __builtin_amdgcn_global_load_lds((const unsigned*)(TB + ((pk & 0xFFFFu) * 128u + lofs)), (LAS unsigned*)(wl + i * 1040), 16, 0, 0); } \
                    asm volatile("" ::: "memory"); } while (0)
                unsigned wa = W32[(size_t)tbase * 128 + lane], wb = W32[(size_t)tbase * 128 + 64 + lane];
                u32x4 a0 = *(const u32x4*)(WF8 + (size_t)tbase * 128 + 16 * kb), a1 = *(const u32x4*)(WF8 + (size_t)tbase * 128 + 64 + 16 * kb);
                E3M_ISSUE(wa, wb);
                if (NTOK > 1) {
                    wa = W32[(size_t)(tbase + 1) * 128 + lane]; wb = W32[(size_t)(tbase + 1) * 128 + 64 + lane];
                }
                u32x4 na0 = a0, na1 = a1;
                if (NTOK > 1) { na0 = *(const u32x4*)(WF8 + (size_t)(tbase + 1) * 128 + 16 * kb); na1 = *(const u32x4*)(WF8 + (size_t)(tbase + 1) * 128 + 64 + 16 * kb); }
#pragma unroll 1
                for (int tt = 0; tt < NTOK; ++tt) {
                    const int t = tbase + tt;
                    const bf16_t* hp = H2B + (size_t)t * 1024 + j * 256 + 64 * kb + n16;
                    bf16_t hr[4];
#pragma unroll
                    for (int b2 = 0; b2 < 4; ++b2) hr[b2] = hp[16 * b2];
                    asm volatile("s_waitcnt vmcnt(8)" ::: "memory");
                    const i32x8 A = {(int)a0.x, (int)a0.y, (int)a0.z, (int)a0.w, (int)a1.x, (int)a1.y, (int)a1.z, (int)a1.w};
                    float res[4] = {0.f, 0.f, 0.f, 0.f};
#pragma unroll
                    for (int blk = 0; blk < 16; ++blk) {
                        const i32x2 t0 = __builtin_amdgcn_ds_read_tr4_b64_v2i32((LAS i32x2*)(wl + (n16 >> 1) * 1040 + (2 * kb + (n16 & 1)) * 128 + blk * 8));
                        const i32x2 t1 = __builtin_amdgcn_ds_read_tr4_b64_v2i32((LAS i32x2*)(wl + (8 + (n16 >> 1)) * 1040 + (2 * kb + (n16 & 1)) * 128 + blk * 8));
                        const i32x8 B = {t0.x, t0.y, t1.x, t1.y, 0, 0, 0, 0};
                        const f32x4 d = __builtin_amdgcn_mfma_scale_f32_16x16x128_f8f6f4(A, B, (f32x4){0.f, 0.f, 0.f, 0.f}, 0  , 4  , 0, 0x7F7F7F7F, 0, 0x7F7F7F7F);
                        res[blk & 3] = (kb == (blk >> 2)) ? d[0] : res[blk & 3];
                    }
                    asm volatile("s_waitcnt lgkmcnt(0)" ::: "memory");
                    if (tt + 1 < NTOK) E3M_ISSUE(wa, wb);
                    if (dry) {
                        asm volatile("" :: "v"(res[0]), "v"(res[1]), "v"(res[2]), "v"(res[3]), "v"(hr[0]), "v"(hr[1]), "v"(hr[2]), "v"(hr[3]));
                    } else {
                        float* op = a.out + (size_t)t * 1024 + j * 256 + 64 * kb + n16;
#pragma unroll
                        for (int b2 = 0; b2 < 4; ++b2) op[16 * b2] = bf2f(hr[b2]) + res[b2] * (1.0f / WF8_SCALE);
                    }
                    asm volatile("" ::: "memory");
                    a0 = na0; a1 = na1;
                    if (tt + 2 < NTOK) {
                        wa = W32[(size_t)(t + 2) * 128 + lane]; wb = W32[(size_t)(t + 2) * 128 + 64 + lane];
                        na0 = *(const u32x4*)(WF8 + (size_t)(t + 2) * 128 + 16 * kb); na1 = *(const u32x4*)(WF8 + (size_t)(t + 2) * 128 + 64 + 16 * kb);
                    }
                    asm volatile("" ::: "memory");
                }
#undef E3M_ISSUE
            }
        }
    }
}

__device__ __forceinline__ void phase_peer_weights(const Args& a) {
    unsigned char* ws = a.ws;
    float* EG = (float*)(ws + WS_EG);
    const int* EIDX = (const int*)(ws + WS_EIDX);
    const float* PART = (const float*)(ws + WS_PART);
    const float* RSTD2 = (const float*)(ws + WS_RSTD2);
    typedef int i32x4 __attribute__((ext_vector_type(4)));
    const float* USC = (const float*)(ws + WS_USCALE);
    const float* VSC = (const float*)(ws + WS_VSCALE);
    for (size_t i = (size_t)blockIdx.x * NT + threadIdx.x; i < (size_t)T_TOK * 128 / 4; i += (size_t)gridDim.x * NT) {
        i32x4 s = *(const i32x4*)((const int*)PART + i * 4);
#pragma unroll
        for (int j = 1; j < 4; ++j) { const i32x4 p = *(const i32x4*)((const int*)PART + (size_t)j * T_TOK * 128 + i * 4); s[0] += p[0]; s[1] += p[1]; s[2] += p[2]; s[3] += p[3]; }
        const f32x4 gq = *(const f32x4*)(EG + i * 4);
        const i32x4 ev = *(const i32x4*)(EIDX + i * 4);
        const float rs2 = RSTD2[(i * 4) >> 7];
        u32x4 o; float wv4[4];
#pragma unroll
        for (int e = 0; e < 4; ++e) {
            const float z = (float)s[e] * USC[ev[e]] * (H2Q_CLIP / (127.0f * 16.0f)) * rs2;
            wv4[e] = gq[e] * gelu_tanh(z) * VSC[ev[e]];
            o[e] = (f2bf(wv4[e]) << 16) | (unsigned)ev[e];
        }
        *(u32x4*)(EG + i * 4) = o;
        {
            int pk = __builtin_amdgcn_cvt_pk_fp8_f32(wv4[0] * WF8_SCALE, wv4[1] * WF8_SCALE, 0, false);
            pk = __builtin_amdgcn_cvt_pk_fp8_f32(wv4[2] * WF8_SCALE, wv4[3] * WF8_SCALE, pk, true);
            ((int*)(ws + WS_WF8))[i] = pk;
        }
    }
}

__device__ __forceinline__ void phase_mixnorm(const Args& a) {
    unsigned char* ws = a.ws;
    const int tid = threadIdx.x, lane = tid & 63, w = tid >> 6;
    const int gw = blockIdx.x * NWV + w, nw = gridDim.x * NWV;
    bf16_t* O = (bf16_t*)(ws + WS_OMIX);
    for (int t = gw; t < T_TOK; t += nw) {
        bf16_t* row = O + (size_t)t * 1024 + lane * 8;
        float x[8], y[8];
        unpack8(*(const u32x4*)row, x);
        float s1 = 0.f, s2 = 0.f;
#pragma unroll
        for (int e = 0; e < 8; ++e) s1 += x[e] * x[e];
        s1 = wave_sum(s1);
        const float r1 = rsqrtf(s1 * (1.0f / 512.0f) + EPSN);
#pragma unroll
        for (int e = 0; e < 8; ++e) x[e] *= r1;
        *(u32x4*)row = pack8(x);
#if STAGE >= 2
        unpack8(*(const u32x4*)(row + 512), y);
#pragma unroll
        for (int e = 0; e < 8; ++e) s2 += y[e] * y[e];
        s2 = wave_sum(s2);
        const float r2 = rsqrtf(s2 * (1.0f / 512.0f) + EPSN);
#pragma unroll
        for (int e = 0; e < 8; ++e) y[e] *= r2;
#else
#pragma unroll
        for (int e = 0; e < 8; ++e) y[e] = 0.f;
        (void)s2;
#endif
        *(u32x4*)(row + 512) = pack8(y);
    }
}

#define N_PHASES 17
__global__ void __launch_bounds__(NT, 2) mega(Args a) {
    extern __shared__ __attribute__((aligned(16))) unsigned char lds[];
    unsigned char* ws = a.ws;
    const int tid = threadIdx.x;
    const int G = gridDim.x, bid = blockIdx.x;
    volatile unsigned* bst = (volatile unsigned*)(lds + LDS_BYTES - 16);
    XcdBarrier bar; bar.bar = (unsigned*)(ws + WS_BAR); bar.x = 0; bar.st = bst;
    const bool multi = (a.ph_hi - a.ph_lo) > 1;
    if (multi) {
        if (tid == 0) { bst[0] = 0u; bst[1] = 0u; }
        __syncthreads();
        bar = xcd_barrier_post((unsigned*)(ws + WS_BAR), bst);
    }
#define PH(k) (a.ph_lo <= (k) && (k) < a.ph_hi)
#define SEAM(k) do { if (PH(k) && PH((k) + 1)) { xcd_barrier(bar); if ((PROBE_MASK >> 22) & 1) { xcd_barrier(bar); xcd_barrier(bar); } } } while (0)
#define GEMM_BITS ((1 << 1) | (1 << 8) | (1 << 9) | (1 << 12))
#define PMASK2 (PROBE_MASK & ~GEMM_BITS & 0xFFFFF)
#define TREP(k) (1 + ((PROBE_MASK >> (k)) & 1))
#define FOR_TILES_XCD(nM, nN, m_, n_) for (int L_ = (bid >> 3); L_ < ((nM) >> 3) * (nN); L_ += (G >> 3)) { const int m_ = (bid & 7) + 8 * (L_ / (nN)); const int n_ = L_ % (nN);
#define PHREP(k) if (PH(k)) for (int rep_ = 0; rep_ <= ((PMASK2 >> (k)) & 1); ++rep_) if (rep_ ? (xcd_barrier(bar), true) : true)
#define LASTREP(k) (rep_ == ((PMASK2 >> (k)) & 1))

    PHREP(0) phase_prep(a, lds);
    SEAM(0);
    PHREP(1) {
        Epi8InProj e1{(const float*)(ws + WS_RSTD0), (bf16_t*)(ws + WS_P), (bf16_t*)(ws + WS_QN), (bf16_t*)(ws + WS_KS), (bf16_t*)(ws + WS_KW),
                     (bf16_t*)(ws + WS_KCIN), (bf16_t*)(ws + WS_VCIN), (float*)(ws + WS_GATE), (const f32x2*)(ws + WS_ROPEN), a.in[9], a.in[10], (float*)(ws + WS_CSSQ)};
        for (int rp = 0; rp < TREP(1); ++rp) {
            gemm8((const bf16_t*)(ws + WS_XB), 1024, (const bf16_t*)(ws + WS_WIN), 1024, 1024, 256, 7, e1, lds);
        }
        if (bid == G - 1 && tid < 256) {
            float s = 0.f;
            const float* bp = (const float*)(ws + WS_BIASP);
            const int kv = tid >> 7, j = tid & 127;
            for (int i = 0; i < 32; ++i) s += bp[(kv * 32 + i) * 128 + j];
            ((float*)(ws + WS_BIAS1))[tid] = s;
        }
    }
    SEAM(1);
    PHREP(3) {
        Epi8QUp eq{(bf16_t*)(ws + WS_QMRAW), 768, (const float*)(ws + WS_CSSQ)};
        Epi8KvUp ek{(const float*)(ws + WS_CSSQ), (const bf16_t*)(ws + WS_P), (const f32x2*)(ws + WS_ROPEM), a.in[8] + 96, (bf16_t*)(ws + WS_KM), (bf16_t*)(ws + WS_KVRAW)};
#if STAGE >= 2
        for (int it = bid; it < 256; it += G) {
            const int kv = it >> 7, mi = (it >> 2) & 31, ksl = it & 3;
            EpiF32 ep{(float*)(ws + WS_PARTC) + ((size_t)(ksl * 2 + kv) * 8192) * 128, 128, 128};
            gemm_tile<false>((const bf16_t*)(ws + (kv ? WS_VCIN : WS_KCIN)) + ksl * 512, 1024, (const bf16_t*)(ws + WS_W1C) + (size_t)kv * 128 * 2048 + ksl * 512, 2048, 512, mi * 256, 0, ep, lds);
        }
#endif
        gemm8((const bf16_t*)(ws + WS_P) + C_CQ, PLD, (const bf16_t*)(ws + WS_WUQ), 256, 256, 256, 3, eq, lds);
        gemm8((const bf16_t*)(ws + WS_P) + C_CKV, PLD, (const bf16_t*)(ws + WS_WUKV), 128, 128, 256, 4, ek, lds);
#if STAGE >= 2
        for (int id0 = 2 * bid; id0 < 2 * 32 * 64; id0 += 2 * G) {
            const int idr = id0 + (tid >> 8); const bool ok = idr < 2 * 32 * 64; const int id = ok ? idr : 0;
            const int which = id >> 11, bg = (id >> 6) & 31, st = id & 63, b = bg >> 1, g = bg & 1;
            const bf16_t* src = (const bf16_t*)(ws + WS_P) + ((size_t)b * SEQ + st * 64) * PLD + (which ? C_VW : C_VS) + g * 64;
            bf16_t* dst = (bf16_t*)(ws + (which ? WS_VWT : WS_VST)) + (size_t)bg * 64 * SEQ + st * 64;
            tr_tile(src, PLD, dst, SEQ, (bf16_t*)lds, ok);
        }
#endif
    }
    SEAM(3);
    PHREP(4) {
        const bool xa_wg = G > 64 && bid < 64;
        const int vb = G > 64 ? bid - 64 : bid, VG = G > 64 ? G - 64 : G;
#if STAGE >= 3
        {
            Epi8RowScaleBf16 e2{(bf16_t*)(ws + WS_KVX), 1024, (const float*)(ws + WS_RSTDMEM)};
            if (G > 64) gemm8((const bf16_t*)(ws + WS_MEMB), 1024, (const bf16_t*)(ws + WS_WXKV), 1024, 1024, 16, 4, e2, lds);
            else { EpiRowScaleBf16 e2o{(bf16_t*)(ws + WS_KVX), 1024, (const float*)(ws + WS_RSTDMEM), 1024}; gemm_tiles_xcd<false>((const bf16_t*)(ws + WS_MEMB), 1024, (const bf16_t*)(ws + WS_WXKV), 1024, 1024, 16, 4, e2o, lds); }
        }
#endif
        if (!xa_wg) for (int id0 = 2 * vb; id0 < 128 * 64; id0 += 2 * VG) {
            const int idr = id0 + (tid >> 8); const bool ok = idr < 128 * 64; const int id = ok ? idr : 0;
            const int bh = id >> 6, st = id & 63, b = bh >> 3, h = bh & 7;
            const bf16_t* src = (const bf16_t*)(ws + WS_KVRAW) + ((size_t)b * SEQ + st * 64) * 1024 + h * 128 + 64;
            bf16_t* dst = (bf16_t*)(ws + WS_VMT) + (size_t)bh * 64 * SEQ + st * 64;
            tr_tile(src, 1024, dst, SEQ, (bf16_t*)lds, ok);
        }
#if STAGE >= 2
        if (!xa_wg) for (int i = vb * NT + tid; i < 2 * 8192 * 128 / 4; i += VG * NT) {
            const float* pp = (const float*)(ws + WS_PARTC) + (size_t)i * 4;
            f32x4 s = *(const f32x4*)pp;
#pragma unroll
            for (int k = 1; k < 4; ++k) { const f32x4 p = *(const f32x4*)(pp + (size_t)k * 2 * 8192 * 128); s[0] += p[0]; s[1] += p[1]; s[2] += p[2]; s[3] += p[3]; }
            const int kv = i >> 18, col = (i * 4) & 127;
            const f32x4 bq = *(const f32x4*)((const float*)(ws + WS_BIAS1) + kv * 128 + col);
            float v[4];
#pragma unroll
            for (int e = 0; e < 4; ++e) v[e] = gelu_tanh(s[e] + bq[e]);
            *(u32x2*)((bf16_t*)(ws + WS_HID) + (size_t)i * 4) = pack4(v);
        }
#endif
    }
    SEAM(4);
#if STAGE >= 2
    PHREP(5) {
#if STAGE >= 3
        {
            const bool cmp_wg = G > 64 && bid < 64;
            const int vb = G > 64 ? bid - 64 : bid, VG = G > 64 ? G - 64 : G;
            if (!cmp_wg) {
                phase_xa_k(a, vb, VG);
                for (int id0 = 2 * vb; id0 < 16 * 4 * 8; id0 += 2 * VG) {
                    const int idr = id0 + (tid >> 8); const bool ok = idr < 16 * 4 * 8; const int id = ok ? idr : 0;
                    const int b = id >> 5, mt = (id >> 3) & 3, ct = id & 7;
                    const bf16_t* src = (const bf16_t*)(ws + WS_KVX) + ((size_t)b * 256 + mt * 64) * 1024 + 512 + ct * 64;
                    bf16_t* dst = (bf16_t*)(ws + WS_VXT) + ((size_t)b * 512 + ct * 64) * 256 + mt * 64;
                    tr_tile(src, 1024, dst, 256, (bf16_t*)lds, ok);
                }
            }
        }
#endif
        for (int it = bid; it < 64; it += G) {
            const int kv = it >> 5, mi = it & 31;
            EpiCmpFin ec{kv, (const f32x2*)(ws + WS_ROPEN), a.in[10], (bf16_t*)(ws + WS_KC), (bf16_t*)(ws + WS_VCT)};
            gemm_tile<false>((const bf16_t*)(ws + WS_HID) + (size_t)kv * 8192 * 128, 128, (const bf16_t*)(ws + WS_W2C) + (size_t)kv * 128 * 128, 128, 128, mi * 256, 0, ec, lds);
        }
    }
#endif
    SEAM(5);
    PHREP(6) {
        if (G == 256) {
            const int x = bid & 7, r = bid >> 3;
            for (int rp = 0; rp < TREP(20); ++rp)
                for (int i = 0; i < 8; ++i) {
                    const int bh = x + 8 * (2 * i + (r >> 4));
                    const int qt = (i & 1) ? 15 - (r & 15) : (r & 15);
                    mla_unit(a, bh >> 3, bh & 7, qt, lds);
                }
#if STAGE >= 2
            for (int rp = 0; rp < TREP(21); ++rp)
                for (int i = 0; i < 8; ++i) {
                    const int bg = x + 8 * (i >> 1);
                    const int jq = (i & 1) ? 63 - r : r;
                    nsa_unit(a, bg >> 1, bg & 1, jq, lds);
                }
#endif
        } else {
            for (int u = bid; u < 2048; u += G) {
                const int qt = 15 - (u >> 7), bh = u & 127;
                mla_unit(a, bh >> 3, bh & 7, qt, lds);
            }
#if STAGE >= 2
            for (int u = bid; u < 2048; u += G) {
                const int jq = 63 - (u >> 5), bg = u & 31;
                nsa_unit(a, bg >> 1, bg & 1, jq, lds);
            }
#endif
        }
    }
    SEAM(6);
    PHREP(8) {
        Epi8ResBf16S er{(const bf16_t*)(ws + WS_XB), (bf16_t*)(ws + WS_H1B), (float*)(ws + WS_H1SSQ)};
        for (int rp = 0; rp < TREP(8); ++rp) {
            gemm8<Epi8ResBf16S, true>((const bf16_t*)(ws + WS_OMIX), 1024, (const bf16_t*)(ws + WS_WOUT), 1024, 1024, 256, 4, er, lds, (const float*)(ws + WS_SSQ)); }
    }
    SEAM(8);
#if STAGE >= 3
    PHREP(9) {
        Epi8RssScaleBf16 eq{(bf16_t*)(ws + WS_QX), 512, (const float*)(ws + WS_H1SSQ), nullptr};
        for (int rp = 0; rp < TREP(9); ++rp) {
            gemm8((const bf16_t*)(ws + WS_H1B), 1024, (const bf16_t*)(ws + WS_WXQ), 1024, 1024, 256, 2, eq, lds); }
    }
    SEAM(9);
    PHREP(10) {
        for (int u = bid; u < 1024; u += G) xa_unit(a, u >> 6, (u >> 4) & 3, u & 15, lds);
    }
    SEAM(10);
    PHREP(11) {
        Epi8ResBf16Q er{(const bf16_t*)(ws + WS_H1B), (bf16_t*)(ws + WS_H2B), (unsigned*)(ws + WS_H2Q), (float*)(ws + WS_H2SSQ)};
        gemm8(( const bf16_t*)(ws + WS_OX), 512, (const bf16_t*)(ws + WS_WXO), 512, 512, 256, 4, er, lds);
    }
    SEAM(11);
#endif
#if STAGE >= 4
    PHREP(12) {
        Epi8RssScaleBf16 eq{(bf16_t*)(ws + WS_QP), 1024, (const float*)(ws + WS_H2SSQ), (float*)(ws + WS_RSTD2)};
        for (int rp = 0; rp < TREP(12); ++rp) {
            gemm8((const bf16_t*)(ws + WS_H2B), 1024, (const bf16_t*)(ws + WS_WPQ), 1024, 1024, 256, 4, eq, lds); }
    }
    SEAM(12);
    PHREP(13) phase_peer_route(a);
    SEAM(13);
    PHREP(14) phase_peer_sliced<0>(a, lds, rep_, false);
    SEAM(14);
    PHREP(15) phase_peer_weights(a);
    SEAM(15);
    PHREP(16) phase_peer_sliced<1>(a, lds, 2 + rep_, !LASTREP(16));
#endif
#undef PH
#undef SEAM
}

extern "C" void kernel_launch(void* const* d_in, const int* in_sizes, int n_in, void* d_out, int out_size, void* d_ws, size_t ws_size, hipStream_t stream) {
    static int grid = 0;
    if (grid == 0) {
        if (n_in != 27 || ws_size < WS_END) { fprintf(stderr, "kernel_launch: unexpected n_in %d or ws_size %zu (< %zu)\n", n_in, ws_size, (size_t)WS_END); grid = -1; return; }
        int dev = 0, cus = 0, per_cu = 0;
        hipGetDevice(&dev);
        hipDeviceGetAttribute(&cus, hipDeviceAttributeMultiprocessorCount, dev);
        hipFuncSetAttribute((const void*)mega, hipFuncAttributeMaxDynamicSharedMemorySize, LDS_BYTES);
        if (hipOccupancyMaxActiveBlocksPerMultiprocessor(&per_cu, (const void*)mega, NT, LDS_BYTES) != hipSuccess || per_cu < 1) per_cu = 1;
        (void)hipGetLastError();
        if (per_cu > 1) per_cu = 1;
        grid = cus * per_cu;
    }
    if (grid < 0) return;
    hipMemsetAsync((unsigned char*)d_ws + WS_BAR, 0, 16384, stream);
    Args a{};
    for (int i = 0; i < 27; ++i) a.in[i] = (const float*)d_in[i];
    a.out = (float*)d_out; a.ws = (unsigned char*)d_ws;
#if ONE_LAUNCH
    a.ph_lo = 0; a.ph_hi = N_PHASES;
    hipLaunchKernelGGL(mega, dim3(grid), dim3(NT), LDS_BYTES, stream, a);
#else
    for (int p = 0; p < N_PHASES; ++p) {
        a.ph_lo = p; a.ph_hi = p + 1;
        hipLaunchKernelGGL(mega, dim3(grid), dim3(NT), LDS_BYTES, stream, a);
    }
#endif
}
```
